# Optimizing an MI355X kernel written in HIP

```python
import math
import jax, jax.numpy as jnp
from jax import lax
import numpy as np

D_MODEL = 1024
BATCH = 4
SEQ = 8192
DEPTH = 2

GRID_W = 64
CTX_LEN = 256
D_FF = 4 * D_MODEL
N_MOD = 6

MLA_HEADS = 8
QK_NOPE = 64
QK_ROPE = 32
QK_DIM = QK_NOPE + QK_ROPE
V_DIM = 64
MLA_WIDTH = MLA_HEADS * V_DIM
Q_LORA = 256
KV_LORA = 128
AXIS_DIM = QK_ROPE // 2
ROPE_THETA = 10000.0
Q_BLOCK = 128
SM_SCALE = 1.0 / math.sqrt(QK_DIM)

CONF_WIDTH = 256
CONF_K = 31
SC_WIDTH = 256
SC_K = 3

MIX_WIDTH = MLA_WIDTH + CONF_WIDTH + SC_WIDTH

Q_END = Q_LORA
KV_START = Q_END
KV_END = KV_START + KV_LORA
ROPE_END = KV_END + QK_ROPE
CONF_END = ROPE_END + 2 * CONF_WIDTH
IN_WIDTH = CONF_END + 3 * SC_WIDTH

EPS = 1e-6

kernel_name = "hybrid_mla_conformer_shortconv_dit"


def rmsnorm(u, g):
    uf = u.astype(jnp.float32)
    y = uf * lax.rsqrt(jnp.mean(uf * uf, axis=-1, keepdims=True) + EPS)
    return (y * g.astype(jnp.float32)).astype(u.dtype)


def layernorm(u, g, b):
    uf = u.astype(jnp.float32)
    mu = jnp.mean(uf, axis=-1, keepdims=True)
    d = uf - mu
    y = d * lax.rsqrt(jnp.mean(d * d, axis=-1, keepdims=True) + EPS)
    return (y * g.astype(jnp.float32) + b.astype(jnp.float32)).astype(u.dtype)


def modulation(cvec, w_mod, b_mod):
    m = jax.nn.silu(cvec) @ w_mod + b_mod
    return jnp.split(m[:, None, :], N_MOD, axis=-1)


def modulate(h, shift, scale):
    return h * (1.0 + scale) + shift


def axial_rope_tables(rows):
    row = jnp.broadcast_to(jnp.arange(rows)[:, None], (rows, GRID_W)).reshape(-1).astype(jnp.float32)
    col = jnp.broadcast_to(jnp.arange(GRID_W)[None, :], (rows, GRID_W)).reshape(-1).astype(jnp.float32)
    inv = 1.0 / (ROPE_THETA ** (jnp.arange(0, AXIS_DIM, 2, dtype=jnp.float32) / AXIS_DIM))
    ar = row[:, None] * inv
    ac = col[:, None] * inv
    ang = jnp.concatenate([ar, ar, ac, ac], axis=-1)
    return jnp.cos(ang), jnp.sin(ang)


def apply_axial_rope(u, cos, sin):
    def rot(p):
        h = p.shape[-1] // 2
        return jnp.concatenate([-p[..., h:], p[..., :h]], axis=-1)
    rotated = jnp.concatenate([rot(u[..., :AXIS_DIM]), rot(u[..., AXIS_DIM:])], axis=-1)
    return (u.astype(jnp.float32) * cos + rotated.astype(jnp.float32) * sin).astype(u.dtype)


def mla_queries(zq, g_q, w_q_b, rope):
    b, s, _ = zq.shape
    q = (rmsnorm(zq, g_q) @ w_q_b).reshape(b, s, MLA_HEADS, QK_DIM)
    if rope is None:
        return q
    cos, sin = rope
    q_rope = apply_axial_rope(q[..., QK_NOPE:], cos[:, None, :], sin[:, None, :])
    return jnp.concatenate([q[..., :QK_NOPE], q_rope], axis=-1)


def mla_keys_values(zkv, g_kv, w_kv_b, rope):
    b, s, _ = zkv.shape
    ckv, k_rope = zkv[..., :KV_LORA], zkv[..., KV_LORA:]
    kv = (rmsnorm(ckv, g_kv) @ w_kv_b).reshape(b, s, MLA_HEADS, QK_NOPE + V_DIM)
    k_nope, v = kv[..., :QK_NOPE], kv[..., QK_NOPE:]
    if rope is not None:
        cos, sin = rope
        k_rope = apply_axial_rope(k_rope, cos, sin)
    k_rope = jnp.broadcast_to(k_rope[:, :, None, :], (b, s, MLA_HEADS, QK_ROPE))
    return jnp.concatenate([k_nope, k_rope], axis=-1), v


def block_attention(q, k, v):
    b, s, h, dq = q.shape
    dv = v.shape[-1]
    nb = s // Q_BLOCK
    qb = jnp.moveaxis(q.reshape(b, nb, Q_BLOCK, h, dq), 1, 0)

    def attend(qblk):
        logits = jnp.einsum('bqhd,bkhd->bhqk', qblk, k).astype(jnp.float32) * SM_SCALE
        p = jax.nn.softmax(logits, axis=-1).astype(v.dtype)
        return jnp.einsum('bhqk,bkhd->bqhd', p, v)

    o = lax.map(attend, qb)
    return jnp.moveaxis(o, 0, 1).reshape(b, s, h * dv)


def depthwise_conv(u, w):
    k, ch = w.shape
    return lax.conv_general_dilated(
        u, w[:, None, :].astype(u.dtype), window_strides=(1,),
        padding=[(k // 2, k // 2)], dimension_numbers=('NWC', 'WIO', 'NWC'),
        feature_group_count=ch)


def conformer_branch(z, dw_w, dw_b, ln_g, ln_b):
    a, g = jnp.split(z, 2, axis=-1)
    u = a * jax.nn.sigmoid(g)
    u = depthwise_conv(u, dw_w) + dw_b
    u = layernorm(u, ln_g, ln_b)
    return jax.nn.silu(u)


def shortconv_branch(z, w):
    b_gate, c_gate, h = jnp.split(z, 3, axis=-1)
    return b_gate * depthwise_conv(c_gate * h, w)


def mix_stream(z, k, v, rope, g_q, w_q_b, conf_dw_w, conf_dw_b, conf_ln_g, conf_ln_b,
               sc_dw_w, g_branch, w_o):
    q = mla_queries(z[..., :Q_END], g_q, w_q_b, rope)
    attn = block_attention(q, k, v)
    conf = conformer_branch(z[..., ROPE_END:CONF_END], conf_dw_w, conf_dw_b, conf_ln_g, conf_ln_b)
    sc = shortconv_branch(z[..., CONF_END:], sc_dw_w)
    merged = jnp.concatenate([
        rmsnorm(attn, g_branch[:MLA_WIDTH]),
        rmsnorm(conf, g_branch[MLA_WIDTH:MLA_WIDTH + CONF_WIDTH]),
        rmsnorm(sc, g_branch[MLA_WIDTH + CONF_WIDTH:])], axis=-1)
    return merged @ w_o


def sqrelu_mlp(h, w1, w2):
    a = jax.nn.relu(h @ w1)
    return (a * a) @ w2


def setup_inputs(seed: int = 0) -> dict:
    key = jax.random.key(seed)
    ks = jax.random.split(key, 32)
    f32 = jnp.float32

    def nrm(k, shape, scale):
        return jax.random.normal(k, shape, f32) * scale

    def gain(k, shape):
        return 1.0 + 0.05 * jax.random.normal(k, shape, f32)

    L, D = DEPTH, D_MODEL
    return {
        "x": nrm(ks[0], (BATCH, SEQ, D), 1.0),
        "c": nrm(ks[1], (BATCH, D), 1.0),
        "ctx": nrm(ks[2], (BATCH, CTX_LEN, D), 1.0),
        "c_ctx": nrm(ks[3], (D,), 1.0),
        "w_mod": nrm(ks[4], (L, D, N_MOD * D), 0.5 * D ** -0.5),
        "b_mod": nrm(ks[5], (L, N_MOD * D), 0.02),
        "g_pre_mix": gain(ks[6], (L, D)),
        "g_post_mix": gain(ks[7], (L, D)),
        "g_pre_mlp": gain(ks[8], (L, D)),
        "g_post_mlp": gain(ks[9], (L, D)),
        "w_in": nrm(ks[10], (L, D, IN_WIDTH), D ** -0.5),
        "g_q": gain(ks[11], (L, Q_LORA)),
        "w_q_b": nrm(ks[12], (L, Q_LORA, MLA_HEADS * QK_DIM), Q_LORA ** -0.5),
        "g_kv": gain(ks[13], (L, KV_LORA)),
        "w_kv_b": nrm(ks[14], (L, KV_LORA, MLA_HEADS * (QK_NOPE + V_DIM)), KV_LORA ** -0.5),
        "conf_dw_w": nrm(ks[15], (L, CONF_K, CONF_WIDTH), CONF_K ** -0.5),
        "conf_dw_b": nrm(ks[16], (L, CONF_WIDTH), 0.02),
        "conf_ln_g": gain(ks[17], (L, CONF_WIDTH)),
        "conf_ln_b": nrm(ks[18], (L, CONF_WIDTH), 0.02),
        "sc_dw_w": nrm(ks[19], (L, SC_K, SC_WIDTH), SC_K ** -0.5),
        "g_branch": gain(ks[20], (L, MIX_WIDTH)),
        "w_o": nrm(ks[21], (L, MIX_WIDTH, D), MIX_WIDTH ** -0.5),
        "w_mlp_in": nrm(ks[22], (L, D, D_FF), D ** -0.5),
        "w_mlp_out": nrm(ks[23], (L, D_FF, D), D_FF ** -0.5),
    }


def reference(x, c, ctx, c_ctx, w_mod, b_mod, g_pre_mix, g_post_mix, g_pre_mlp, g_post_mlp,
              w_in, g_q, w_q_b, g_kv, w_kv_b, conf_dw_w, conf_dw_b, conf_ln_g, conf_ln_b,
              sc_dw_w, g_branch, w_o, w_mlp_in, w_mlp_out):
    n_lat = x.shape[1]
    rows = n_lat // GRID_W
    rope = axial_rope_tables(rows)
    xl, xc = x, ctx
    for i in range(DEPTH):
        last = i == DEPTH - 1
        ml = modulation(c, w_mod[i], b_mod[i])
        mc = modulation(c_ctx[None, :], w_mod[i], b_mod[i])

        hl = modulate(rmsnorm(xl, g_pre_mix[i]), ml[0], ml[1])
        hc = modulate(rmsnorm(xc, g_pre_mix[i]), mc[0], mc[1])
        zl = hl @ w_in[i]
        if last:
            zc_kv = hc @ w_in[i][:, KV_START:ROPE_END]
        else:
            zc = hc @ w_in[i]
            zc_kv = zc[..., KV_START:ROPE_END]

        k_c, v_c = mla_keys_values(zc_kv, g_kv[i], w_kv_b[i], None)
        k_l, v_l = mla_keys_values(zl[..., KV_START:ROPE_END], g_kv[i], w_kv_b[i], rope)
        y_l = mix_stream(zl, jnp.concatenate([k_c, k_l], axis=1), jnp.concatenate([v_c, v_l], axis=1),
                         rope, g_q[i], w_q_b[i], conf_dw_w[i], conf_dw_b[i], conf_ln_g[i],
                         conf_ln_b[i], sc_dw_w[i], g_branch[i], w_o[i])
        xl_new = xl + ml[2] * rmsnorm(y_l, g_post_mix[i])

        h2 = modulate(rmsnorm(xl_new, g_pre_mlp[i]), ml[3], ml[4])
        xl_new = xl_new + ml[5] * rmsnorm(sqrelu_mlp(h2, w_mlp_in[i], w_mlp_out[i]), g_post_mlp[i])

        if not last:
            y_c = mix_stream(zc, k_c, v_c, None, g_q[i], w_q_b[i], conf_dw_w[i], conf_dw_b[i],
                             conf_ln_g[i], conf_ln_b[i], sc_dw_w[i], g_branch[i], w_o[i])
            xc_new = xc + mc[2] * rmsnorm(y_c, g_post_mix[i])
            h2c = modulate(rmsnorm(xc_new, g_pre_mlp[i]), mc[3], mc[4])
            xc = xc_new + mc[5] * rmsnorm(sqrelu_mlp(h2c, w_mlp_in[i], w_mlp_out[i]), g_post_mlp[i])
        xl = xl_new
    return xl
```

```cpp
#include <hip/hip_runtime.h>
#include <hip/hip_cooperative_groups.h>
#include <cstdio>
#include <cstdint>
namespace cg = cooperative_groups;
namespace pg8 {
#define PG8_LAS __attribute__((address_space(3)))
typedef unsigned short bf16_t;
typedef short bf16x8 __attribute__((ext_vector_type(8)));
typedef float f32x4 __attribute__((ext_vector_type(4)));
typedef unsigned u32x4 __attribute__((ext_vector_type(4)));
constexpr int BM = 256, BK = 64, HALF = 128, HTB = HALF * BK * 2  , STAGE_BYTES = 8 * HTB, NXCD = 8, WGM = 8;

__host__ __device__ __forceinline__ int lds_byte(int r, int c) { const int st = (r >> 4) * 2 + (c >> 5), rr = r & 15, cc = c & 31, ob = rr * 64 + cc * 2; return st * 1024 + (ob ^ (((ob >> 9) & 1) << 5)); }
__host__ __device__ __forceinline__ void stage_rc(int b, int& R, int& C) { const int st = b / 1024, sb = b % 1024, swz = sb ^ (((sb >> 9) & 1) << 5); R = (st >> 1) * 16 + swz / 64; C = (st & 1) * 32 + (swz % 64) / 2; }
__host__ __device__ __forceinline__ int perm32(int rho) { const int n = rho >> 4, i = rho & 15; return 8 * (i >> 2) + 4 * n + (i & 3); }

struct Unit { int pm, pn, kq; };
struct Gemm { const bf16_t* A; const bf16_t* Bt; int M, N, K, ld; };

struct StaticOrder {
    int nM, nN, nwg, G, c; bool rev = false;
    __host__ __device__ void init(int M, int N, int G_, int c_) { nM = M / BM; nN = N / BM; nwg = nM * nN; G = G_; c = c_; }
    __host__ __device__ bool next(int i, Unit& u) const {
        const long L = (long)i * G + c; if (L >= nwg) return false;
        int wgid = (int)L; { const int q = nwg / NXCD, r = nwg % NXCD, xcd = wgid % NXCD, off = wgid / NXCD; wgid = (xcd < r ? xcd * (q + 1) : r * (q + 1) + (xcd - r) * q) + off; }
        const int nig = WGM * nN, gid = wgid / nig, fm = gid * WGM, gsz = (nM - fm) < WGM ? (nM - fm) : WGM;
        u.pm = fm + ((wgid % nig) % gsz); u.pn = (wgid % nig) / gsz; u.kq = 0; if (rev) u.pm = nM - 1 - u.pm; return true;
    }
    __device__ __forceinline__ void a_ready(const Unit&) const {}
    __device__ __forceinline__ void done(const Unit&) const {}
};
struct SplitOrder {
    int nN, nsplit, mt0, total, G, c;
    __host__ __device__ void init(int nMt, int nN_, int nsplit_, int mt0_, int G_, int c_) { nN = nN_; nsplit = nsplit_; mt0 = mt0_; total = nMt * nN_ * nsplit_; G = G_; c = c_; }
    __host__ __device__ bool next(int i, Unit& u) const { const int L = i * G + c; if (L >= total) return false; u.kq = L % nsplit; const int t = L / nsplit; u.pn = t % nN; u.pm = mt0 + t / nN; return true; }
    __device__ __forceinline__ void a_ready(const Unit&) const {}
    __device__ __forceinline__ void done(const Unit&) const {}
};

__device__ __forceinline__ unsigned cvt_pk_bf16(float lo, float hi) { unsigned r; asm volatile("v_cvt_pk_bf16_f32 %0, %1, %2" : "=v"(r) : "v"(lo), "v"(hi)); return r; }
typedef float f32x2 __attribute__((ext_vector_type(2)));
template <int ACT> struct EpiBf16 {
    static constexpr bool PERM = true, AFTER_DRAIN = false;
    bf16_t* O; int ldc;
    __device__ __forceinline__ void operator()(const f32x4 (&acc)[2][2][4][2], const Unit& u, int wr, int wc, int fr, int fq) const {
        const int row0 = u.pm * BM + wr * 64 + fr; const int col0 = u.pn * BM + wc * 32 + 8 * fq;
#pragma unroll
        for (int ai = 0; ai < 2; ++ai)
#pragma unroll
            for (int m = 0; m < 4; ++m) { bf16_t* rowp = O + (size_t)(row0 + ai * HALF + m * 16) * ldc + col0;
#pragma unroll
                for (int bj = 0; bj < 2; ++bj) { f32x4 v0 = acc[ai][bj][m][0], v1 = acc[ai][bj][m][1];
                    if (ACT == 2) {
#pragma unroll
                        for (int e = 0; e < 4; ++e) { float a = fmaxf(v0[e], 0.f), b = fmaxf(v1[e], 0.f); v0[e] = a * a; v1[e] = b * b; } }
                    u32x4 w; w.x = cvt_pk_bf16(v0[0], v0[1]); w.y = cvt_pk_bf16(v0[2], v0[3]); w.z = cvt_pk_bf16(v1[0], v1[1]); w.w = cvt_pk_bf16(v1[2], v1[3]);
                    *(u32x4*)(rowp + bj * HALF) = w; } }
    }
};
struct EpiF32Part {
    static constexpr bool PERM = true, AFTER_DRAIN = false;
    float* P; int ldc; int mt0; size_t slice;
    __device__ __forceinline__ void operator()(const f32x4 (&acc)[2][2][4][2], const Unit& u, int wr, int wc, int fr, int fq) const {
        const int row0 = (u.pm - mt0) * BM + wr * 64 + fr; const int col0 = u.pn * BM + wc * 32 + 8 * fq; float* base = P + (size_t)u.kq * slice;
#pragma unroll
        for (int ai = 0; ai < 2; ++ai)
#pragma unroll
            for (int m = 0; m < 4; ++m) { float* rowp = base + (size_t)(row0 + ai * HALF + m * 16) * ldc + col0;
#pragma unroll
                for (int bj = 0; bj < 2; ++bj) { *(f32x4*)(rowp + bj * HALF) = acc[ai][bj][m][0]; *(f32x4*)(rowp + bj * HALF + 4) = acc[ai][bj][m][1]; } }
    }
};
template <class Epi, class Sched, bool ALIGN_EPI = false, bool SP2 = false>
__device__ __forceinline__ void gemm_phase(PG8_LAS unsigned char* lds, const Gemm g, const Sched& S, const Epi& E, int wave_s) {
    int tid = wave_s * 64 + (int)__builtin_amdgcn_mbcnt_hi(~0u, __builtin_amdgcn_mbcnt_lo(~0u, 0u)); asm volatile("" : "+v"(tid));
    const int wid = __builtin_amdgcn_readfirstlane(tid >> 6), lane = tid & 63, wr = wid >> 2, wc = wid & 3, fr = lane & 15, fq = lane >> 4;
    const int K = g.K, LD = g.ld, nt = K / BK;
    unsigned voffA[2], voffB[2];
#pragma unroll
    for (int i = 0; i < 2; ++i) { int R, C; stage_rc(tid * 16 + i * 8192, R, C); const int Rb = Epi::PERM ? ((R & ~31) + perm32(R & 31)) : R;
        voffA[i] = (unsigned)(R * LD + C) * 2u; voffB[i] = (unsigned)(Rb * LD + C) * 2u; }
    const size_t kstep = (size_t)(BK * 2);
    const size_t hstep = (size_t)HALF * LD * 2;
    const size_t tstep = 2 * hstep;
    const unsigned ldsw = (unsigned)wid * 1024u;
    const int aoff = lds_byte(wr * 64 + fr, fq * 8), boff = lds_byte(wc * 32 + fr, fq * 8);
#define PG8_SA(b, h) (((b) * 2 + (h)) * HTB)
#define PG8_SB(b, h) ((4 + (b) * 2 + (h)) * HTB)
#define PG8_STAGE(bufoff, gbase, voff) do { _Pragma("unroll") for (int _i = 0; _i < 2; ++_i) \
        __builtin_amdgcn_global_load_lds((const unsigned*)((const char*)(gbase) + (voff)[_i]), (PG8_LAS unsigned*)(lds + (bufoff) + ldsw + _i * 8192), 16, 0, 0); } while (0)
#define PG8_LDA(dst, b, h) do { _Pragma("unroll") for (int m = 0; m < 4; ++m) _Pragma("unroll") for (int k = 0; k < 2; ++k) dst[m][k] = *(const PG8_LAS bf16x8*)(lds + PG8_SA(b, h) + aoff + m * 2048 + k * 1024); } while (0)
#define PG8_LDB(dst, b, h) do { _Pragma("unroll") for (int n = 0; n < 2; ++n) _Pragma("unroll") for (int k = 0; k < 2; ++k) dst[n][k] = *(const PG8_LAS bf16x8*)(lds + PG8_SB(b, h) + boff + n * 2048 + k * 1024); } while (0)
#define PG8_MMA(ai, bj, At, Bt) do { __builtin_amdgcn_s_setprio(1); _Pragma("unroll") for (int m = 0; m < 4; ++m) _Pragma("unroll") for (int n = 0; n < 2; ++n) _Pragma("unroll") for (int k = 0; k < 2; ++k) \
        acc[ai][bj][m][n] = __builtin_amdgcn_mfma_f32_16x16x32_bf16(Bt[n][k], At[m][k], acc[ai][bj][m][n], 0, 0, 0); __builtin_amdgcn_s_setprio(0); } while (0)
#define PG8_WAIT_V(n) asm volatile("s_waitcnt vmcnt(" #n ")" ::: "memory")
#define PG8_WAIT_L(n) asm volatile("s_waitcnt lgkmcnt(" #n ")" ::: "memory")
#define PG8_BAR __builtin_amdgcn_s_barrier()
#define PG8_SCHED __builtin_amdgcn_sched_barrier(0)
    Unit cur, nxt; int ui = 0;
    if (!S.next(0, cur)) return;
    f32x4 acc[2][2][4][2];
#pragma unroll
    for (int a = 0; a < 2; ++a)
#pragma unroll
        for (int b = 0; b < 2; ++b)
#pragma unroll
            for (int m = 0; m < 4; ++m)
#pragma unroll
                for (int n = 0; n < 2; ++n) acc[a][b][m][n] = (f32x4){0.f, 0.f, 0.f, 0.f};
    bf16x8 At[4][2], B0[2][2], B1[2][2];
    const size_t kqstep = (size_t)K * 2;
    const char* cA = (const char*)g.A + (size_t)cur.pm * tstep + (size_t)cur.kq * kqstep; const char* cB = (const char*)g.Bt + (size_t)cur.pn * tstep + (size_t)cur.kq * kqstep;
    S.a_ready(cur);
    if constexpr (SP2) {
        PG8_STAGE(PG8_SB(0, 0), cB, voffB); PG8_STAGE(PG8_SB(0, 1), cB + hstep, voffB); PG8_STAGE(PG8_SA(0, 0), cA, voffA); PG8_STAGE(PG8_SA(0, 1), cA + hstep, voffA);
        if (wr == 1) PG8_BAR;
        PG8_WAIT_V(2); PG8_BAR;
        PG8_STAGE(PG8_SB(1, 0), cB + kstep, voffB); PG8_STAGE(PG8_SA(1, 0), cA + kstep, voffA); PG8_STAGE(PG8_SB(1, 1), cB + hstep + kstep, voffB);
        PG8_WAIT_V(6); PG8_BAR;
    } else {
        PG8_STAGE(PG8_SB(0, 0), cB, voffB); PG8_STAGE(PG8_SA(0, 0), cA, voffA); PG8_STAGE(PG8_SB(0, 1), cB + hstep, voffB); PG8_STAGE(PG8_SA(0, 1), cA + hstep, voffA);
        if (wr == 1) PG8_BAR;
        PG8_WAIT_V(4); PG8_BAR;
        PG8_STAGE(PG8_SB(1, 0), cB + kstep, voffB); PG8_STAGE(PG8_SA(1, 0), cA + kstep, voffA); PG8_STAGE(PG8_SB(1, 1), cB + hstep + kstep, voffB);
        PG8_WAIT_V(6); PG8_BAR;
    }
    for (;;) {
        const bool has_next = S.next(ui + 1, nxt);
        const char* nA = has_next ? (const char*)g.A + (size_t)nxt.pm * tstep + (size_t)nxt.kq * kqstep : cA; const char* nB = has_next ? (const char*)g.Bt + (size_t)nxt.pn * tstep + (size_t)nxt.kq * kqstep : cB;
        for (int t = 0; t < nt; t += 2) {
            const bool last = (t == nt - 2);
            const char* a1 = cA + (size_t)(t + 1) * kstep;
            const char* a2 = last ? nA : cA + (size_t)(t + 2) * kstep; const char* b2 = last ? nB : cB + (size_t)(t + 2) * kstep;
            const char* a3 = a2 + kstep; const char* b3 = b2 + kstep;
            if (last && has_next) S.a_ready(nxt);
            if constexpr (SP2) {
            PG8_LDB(B0, 0, 0); PG8_LDB(B1, 0, 1); PG8_SCHED; PG8_LDA(At, 0, 0); PG8_STAGE(PG8_SA(1, 1), a1 + hstep, voffA);
            PG8_WAIT_V(8); PG8_WAIT_L(0); PG8_BAR; PG8_MMA(0, 0, At, B0); PG8_MMA(0, 1, At, B1); PG8_BAR; PG8_SCHED;
            PG8_LDA(At, 0, 1); PG8_STAGE(PG8_SB(0, 0), b2, voffB); PG8_STAGE(PG8_SB(0, 1), b2 + hstep, voffB); PG8_STAGE(PG8_SA(0, 0), a2, voffA);
            PG8_WAIT_V(8); PG8_WAIT_L(0); PG8_BAR; PG8_MMA(1, 0, At, B0); PG8_MMA(1, 1, At, B1); PG8_BAR; PG8_SCHED;
            PG8_LDB(B0, 1, 0); PG8_LDB(B1, 1, 1); PG8_SCHED; PG8_LDA(At, 1, 0); PG8_STAGE(PG8_SA(0, 1), a2 + hstep, voffA);
            PG8_WAIT_V(8); PG8_WAIT_L(0); PG8_BAR; PG8_MMA(0, 0, At, B0); PG8_MMA(0, 1, At, B1); PG8_BAR; PG8_SCHED;
            PG8_LDA(At, 1, 1); PG8_STAGE(PG8_SB(1, 0), b3, voffB); PG8_STAGE(PG8_SB(1, 1), b3 + hstep, voffB); PG8_STAGE(PG8_SA(1, 0), a3, voffA);
            PG8_WAIT_V(8); PG8_WAIT_L(0); PG8_BAR; PG8_MMA(1, 0, At, B0); PG8_MMA(1, 1, At, B1); PG8_BAR; PG8_SCHED;
            } else {
            PG8_LDB(B0, 0, 0); PG8_SCHED; PG8_LDA(At, 0, 0); PG8_STAGE(PG8_SA(1, 1), a1 + hstep, voffA);
            PG8_WAIT_L(8); PG8_BAR; PG8_WAIT_L(0); PG8_MMA(0, 0, At, B0); PG8_BAR; PG8_SCHED;
            PG8_LDB(B1, 0, 1); PG8_STAGE(PG8_SB(0, 0), b2, voffB);
            PG8_BAR; PG8_WAIT_L(0); PG8_MMA(0, 1, At, B1); PG8_BAR;
            PG8_LDA(At, 0, 1); PG8_STAGE(PG8_SA(0, 0), a2, voffA);
            PG8_BAR; PG8_WAIT_L(0); PG8_MMA(1, 0, At, B0); PG8_BAR; PG8_SCHED;
            PG8_STAGE(PG8_SB(0, 1), b2 + hstep, voffB);
            PG8_WAIT_V(6); PG8_BAR; PG8_MMA(1, 1, At, B1); PG8_BAR;
            PG8_LDB(B0, 1, 0); PG8_SCHED; PG8_LDA(At, 1, 0); PG8_STAGE(PG8_SA(0, 1), a2 + hstep, voffA);
            PG8_WAIT_L(8); PG8_BAR; PG8_WAIT_L(0); PG8_MMA(0, 0, At, B0); PG8_BAR; PG8_SCHED;
            PG8_LDB(B1, 1, 1); PG8_STAGE(PG8_SB(1, 0), b3, voffB);
            PG8_BAR; PG8_WAIT_L(0); PG8_MMA(0, 1, At, B1); PG8_BAR;
            PG8_LDA(At, 1, 1); PG8_STAGE(PG8_SA(1, 0), a3, voffA);
            PG8_BAR; PG8_WAIT_L(0); PG8_MMA(1, 0, At, B0); PG8_BAR; PG8_SCHED;
            PG8_STAGE(PG8_SB(1, 1), b3 + hstep, voffB);
            PG8_WAIT_V(6); PG8_BAR; PG8_MMA(1, 1, At, B1); PG8_BAR;
            }
        }
        if constexpr (ALIGN_EPI) { if (wr == 0) PG8_BAR; }
        if constexpr (!Epi::AFTER_DRAIN) { E(acc, cur, wr, wc, fr, fq); S.done(cur); }
        if (!has_next) break;
#pragma unroll
        for (int a = 0; a < 2; ++a)
#pragma unroll
            for (int b = 0; b < 2; ++b)
#pragma unroll
                for (int m = 0; m < 4; ++m)
#pragma unroll
                    for (int n = 0; n < 2; ++n) acc[a][b][m][n] = (f32x4){0.f, 0.f, 0.f, 0.f};
        cur = nxt; cA = nA; cB = nB; ++ui;
        if constexpr (ALIGN_EPI) { if (wr == 1) PG8_BAR; }
    }
    PG8_WAIT_V(0);
    if constexpr (!ALIGN_EPI) { if (wr == 0) PG8_BAR; }
    PG8_BAR;
    if constexpr (Epi::AFTER_DRAIN) { E.fused(acc, cur, wr, wc, fr, fq, lds, wid, lane); S.done(cur); }
#undef PG8_SA
#undef PG8_SB
#undef PG8_STAGE
#undef PG8_LDA
#undef PG8_LDB
#undef PG8_MMA
#undef PG8_WAIT_V
#undef PG8_WAIT_L
#undef PG8_BAR
#undef PG8_SCHED
}
}

#define LAS __attribute__((address_space(3)))
typedef unsigned short bf16_t;
typedef short bf16x8 __attribute__((ext_vector_type(8)));
typedef short s16x4 __attribute__((ext_vector_type(4)));
typedef float f32x4 __attribute__((ext_vector_type(4)));
typedef float f32x16 __attribute__((ext_vector_type(16)));
typedef unsigned u32x2 __attribute__((ext_vector_type(2)));
typedef unsigned u32x4 __attribute__((ext_vector_type(4)));
__device__ __forceinline__ unsigned cvtpk(float lo, float hi) { unsigned r; asm volatile("v_cvt_pk_bf16_f32 %0, %1, %2" : "=v"(r) : "v"(lo), "v"(hi)); return r; }
__device__ __forceinline__ float bflo(unsigned w) { return __uint_as_float(w << 16); }
__device__ __forceinline__ float bfhi(unsigned w) { return __uint_as_float(w & 0xffff0000u); }
__device__ __forceinline__ float bf2f(unsigned short h) { return __uint_as_float((unsigned)h << 16); }
__device__ __forceinline__ unsigned short f2bf(float f) { unsigned u = __float_as_uint(f); return (unsigned short)((u + 0x7fffu + ((u >> 16) & 1u)) >> 16); }
__device__ __forceinline__ int lane_id() { return (int)__builtin_amdgcn_mbcnt_hi(~0u, __builtin_amdgcn_mbcnt_lo(~0u, 0u)); }
template <int X> __device__ __forceinline__ float swz_xor(float v) { return __int_as_float(__builtin_amdgcn_ds_swizzle(__float_as_int(v), (X << 10) | 0x1f)); }
template <int CTRL, int ROWMASK> __device__ __forceinline__ float dpp_f(float v) { return __int_as_float(__builtin_amdgcn_update_dpp(0, __float_as_int(v), CTRL, ROWMASK, 0xF, false)); }
__device__ __forceinline__ float wave_sum(float v) {
    v += dpp_f<0xB1, 0xF>(v);
    v += dpp_f<0x4E, 0xF>(v);
    v += dpp_f<0x141, 0xF>(v);
    v += dpp_f<0x140, 0xF>(v);
    v += dpp_f<0x142, 0xA>(v);
    v += dpp_f<0x143, 0xC>(v);
    return __builtin_amdgcn_readlane(v, 63);
}
__device__ __forceinline__ float sigmoidf_(float x) { return __builtin_amdgcn_rcpf(1.f + __expf(-x)); }
__device__ __forceinline__ float rope_inv(int i) { return exp2f(-1.6609640474436813f * (float)i); }

namespace att {
constexpr int NW = 8, QBLK = 32, KVBLK = 64;
constexpr float SCALE = 0.10206207261596575f;
constexpr float THR = 8.f;
constexpr int BUFB = 16384;
constexpr int NRING = 3, OFF_V = 0, OFF_K = NRING * BUFB, OFF_WS = 2 * NRING * BUFB, LDS_BYTES = OFF_WS + NW * 64 * 4;
#define KSWZ(row, colB) ((row) * 256 + ((colB) ^ (((row) & 15) << 4)))
#define SBAR() __builtin_amdgcn_sched_barrier(0)
__device__ __forceinline__ int crow(int r, int hi) { return (r & 3) + 8 * (r >> 2) + 4 * hi; }
constexpr float C2 = SCALE * 1.4426950408889634f;
constexpr float THR2 = THR * 1.4426950408889634f;
#define MX3(a, b, c) __builtin_fmaxf(__builtin_fmaxf((a), (b)), (c))
__device__ __forceinline__ void softmaxT(f32x16& p0, f32x16& p1, float& mref, f32x16& negm, float& l_reg, float& alpha, bf16x8& pa0, bf16x8& pa1, bf16x8& pa2, bf16x8& pa3) {
  float a = MX3(p0[0], p0[1], p1[0]), b = MX3(p0[2], p0[3], p1[1]); a = MX3(a, p1[2], p1[3]);
#pragma unroll
  for (int r = 4; r < 16; r += 4) { a = MX3(a, p0[r], p0[r + 1]); b = MX3(b, p0[r + 2], p0[r + 3]); a = MX3(a, p1[r], p1[r + 1]); b = MX3(b, p1[r + 2], p1[r + 3]); }
  float pmax = __builtin_fmaxf(a, b);
  { auto rr = __builtin_amdgcn_permlane32_swap(__float_as_uint(pmax), __float_as_uint(pmax), false, false);
    pmax = __builtin_fmaxf(__uint_as_float(rr[0]), __uint_as_float(rr[1])); }
  if (__builtin_expect(__all(pmax <= THR2), 1)) { alpha = 1.f; }
  else { const float dl = __builtin_fmaxf(pmax, 0.f); mref += dl; alpha = __builtin_amdgcn_exp2f(-dl); l_reg *= alpha;
#pragma unroll
    for (int r = 0; r < 16; ++r) { p0[r] -= dl; p1[r] -= dl; negm[r] = -mref; }
    asm volatile("" : "+v"(negm)); }
#pragma unroll
  for (int r = 0; r < 16; ++r) { p0[r] = __builtin_amdgcn_exp2f(p0[r]); p1[r] = __builtin_amdgcn_exp2f(p1[r]); }
  { float s0 = p0[0] + p1[0], s1 = p0[1] + p1[1], s2 = p0[2] + p1[2], s3 = p0[3] + p1[3];
#pragma unroll
    for (int r = 4; r < 16; r += 4) { s0 += p0[r] + p1[r]; s1 += p0[r + 1] + p1[r + 1]; s2 += p0[r + 2] + p1[r + 2]; s3 += p0[r + 3] + p1[r + 3]; }
    l_reg += (s0 + s1) + (s2 + s3); }
#define PK4(P, BASE, OUT) do { unsigned a0 = cvtpk(P[BASE + 0], P[BASE + 1]), a1 = cvtpk(P[BASE + 2], P[BASE + 3]);   \
    unsigned b0 = cvtpk(P[BASE + 4], P[BASE + 5]), b1 = cvtpk(P[BASE + 6], P[BASE + 7]);                              \
    auto r0 = __builtin_amdgcn_permlane32_swap(a0, b0, false, false); auto r1 = __builtin_amdgcn_permlane32_swap(a1, b1, false, false); \
    u32x4 w = {r0[0], r1[0], r0[1], r1[1]}; OUT = __builtin_bit_cast(bf16x8, w); } while (0)
  PK4(p0, 0, pa0); PK4(p0, 8, pa1); PK4(p1, 0, pa2); PK4(p1, 8, pa3);
#undef PK4
}
__device__ __forceinline__ void partialSM(f32x16& p0, f32x16& p1, float& mref, f32x16& negm, float& alpha) {
  float a = MX3(p0[0], p0[1], p1[0]), b = MX3(p0[2], p0[3], p1[1]); a = MX3(a, p1[2], p1[3]);
#pragma unroll
  for (int r = 4; r < 16; r += 4) { a = MX3(a, p0[r], p0[r + 1]); b = MX3(b, p0[r + 2], p0[r + 3]); a = MX3(a, p1[r], p1[r + 1]); b = MX3(b, p1[r + 2], p1[r + 3]); }
  float pmax = __builtin_fmaxf(a, b);
  { auto rr = __builtin_amdgcn_permlane32_swap(__float_as_uint(pmax), __float_as_uint(pmax), false, false);
    pmax = __builtin_fmaxf(__uint_as_float(rr[0]), __uint_as_float(rr[1])); }
  if (__builtin_expect(__all(pmax <= THR2), 1)) { alpha = 1.f; }
  else { const float dl = __builtin_fmaxf(pmax, 0.f); mref += dl; alpha = __builtin_amdgcn_exp2f(-dl);
#pragma unroll
    for (int r = 0; r < 16; ++r) { p0[r] -= dl; p1[r] -= dl; negm[r] = -mref; }
    asm volatile("" : "+v"(negm)); }
#pragma unroll
  for (int r = 0; r < 16; ++r) p0[r] = __builtin_amdgcn_exp2f(p0[r]);
}
__device__ __forceinline__ void finishSM(f32x16& p0, f32x16& p1, float& l_reg, bf16x8& pa0, bf16x8& pa1, bf16x8& pa2, bf16x8& pa3) {
#pragma unroll
  for (int r = 0; r < 16; ++r) p1[r] = __builtin_amdgcn_exp2f(p1[r]);
  { float s0 = p0[0] + p1[0], s1 = p0[1] + p1[1], s2 = p0[2] + p1[2], s3 = p0[3] + p1[3];
#pragma unroll
    for (int r = 4; r < 16; r += 4) { s0 += p0[r] + p1[r]; s1 += p0[r + 1] + p1[r + 1]; s2 += p0[r + 2] + p1[r + 2]; s3 += p0[r + 3] + p1[r + 3]; }
    l_reg += (s0 + s1) + (s2 + s3); }
#define PK4(P, BASE, OUT) do { unsigned a0 = cvtpk(P[BASE + 0], P[BASE + 1]), a1 = cvtpk(P[BASE + 2], P[BASE + 3]);   \
    unsigned b0 = cvtpk(P[BASE + 4], P[BASE + 5]), b1 = cvtpk(P[BASE + 6], P[BASE + 7]);                              \
    auto r0 = __builtin_amdgcn_permlane32_swap(a0, b0, false, false); auto r1 = __builtin_amdgcn_permlane32_swap(a1, b1, false, false); \
    u32x4 w = {r0[0], r1[0], r0[1], r1[1]}; OUT = __builtin_bit_cast(bf16x8, w); } while (0)
  PK4(p0, 0, pa0); PK4(p0, 8, pa1); PK4(p1, 0, pa2); PK4(p1, 8, pa3);
#undef PK4
}
__device__ __forceinline__ void qkt(f32x16& p0, f32x16& p1, const LAS unsigned char* Ks, const bf16x8* qr, const f32x16& negm, int r32, int hi) {
  bf16x8 kf[12];
#pragma unroll
  for (int d0 = 0; d0 < 6; ++d0) { const int cb = (d0 * 16 + hi * 8) * 2;
    kf[2 * d0] = *(const LAS bf16x8*)(Ks + KSWZ(r32, cb)); kf[2 * d0 + 1] = *(const LAS bf16x8*)(Ks + KSWZ(32 + r32, cb)); }
  SBAR();
  p0 = __builtin_amdgcn_mfma_f32_32x32x16_bf16(kf[0], qr[0], negm, 0, 0, 0); p1 = __builtin_amdgcn_mfma_f32_32x32x16_bf16(kf[1], qr[0], negm, 0, 0, 0);
#pragma unroll
  for (int d0 = 1; d0 < 6; ++d0) { p0 = __builtin_amdgcn_mfma_f32_32x32x16_bf16(kf[2 * d0], qr[d0], p0, 0, 0, 0); p1 = __builtin_amdgcn_mfma_f32_32x32x16_bf16(kf[2 * d0 + 1], qr[d0], p1, 0, 0, 0); }
}
__device__ __forceinline__ int v_st(int k, int c) { const int kk = (k & ~0xC) | ((k & 4) << 1) | ((k & 8) >> 1); return ((kk >> 3) * 4 + (c >> 5)) * 512 + ((kk & 7) * 32 + (c & 31)) * 2; }
__device__ __forceinline__ int v_rd_base(int lane) { return ((lane & 3) << 3) | (((lane >> 2) & 3) << 6) | (((lane >> 4) & 1) << 5) | (((lane >> 5) & 1) << 8); }
constexpr int v_rd_off(int d0, int ks, int half) { return d0 * 512 + ks * 4096 + half * 2048; }
template <int OFF> __device__ __forceinline__ s16x4 tr_read(int vb) {
  s16x4 r; asm volatile("ds_read_b64_tr_b16 %0, %1 offset:%2" : "=&v"(r) : "v"(vb), "i"(OFF) : "memory"); return r;
}
__device__ __forceinline__ void pv_d0(f32x16* o, int vb, bf16x8 pa0, bf16x8 pa1, bf16x8 pa2, bf16x8 pa3) {
  const s16x4 a0 = tr_read<v_rd_off(0, 0, 0)>(vb), b0 = tr_read<v_rd_off(0, 0, 1)>(vb), a1 = tr_read<v_rd_off(0, 1, 0)>(vb), b1 = tr_read<v_rd_off(0, 1, 1)>(vb);
  const s16x4 a2 = tr_read<v_rd_off(0, 2, 0)>(vb), b2 = tr_read<v_rd_off(0, 2, 1)>(vb), a3 = tr_read<v_rd_off(0, 3, 0)>(vb), b3 = tr_read<v_rd_off(0, 3, 1)>(vb);
  const s16x4 c0 = tr_read<v_rd_off(1, 0, 0)>(vb), d0 = tr_read<v_rd_off(1, 0, 1)>(vb), c1 = tr_read<v_rd_off(1, 1, 0)>(vb), d1 = tr_read<v_rd_off(1, 1, 1)>(vb);
  const s16x4 c2 = tr_read<v_rd_off(1, 2, 0)>(vb), d2 = tr_read<v_rd_off(1, 2, 1)>(vb), c3 = tr_read<v_rd_off(1, 3, 0)>(vb), d3 = tr_read<v_rd_off(1, 3, 1)>(vb);
  asm volatile("s_waitcnt lgkmcnt(0)" ::: "memory"); SBAR();
#define PK(L, H) (bf16x8){L[0], L[1], L[2], L[3], H[0], H[1], H[2], H[3]}
  o[0] = __builtin_amdgcn_mfma_f32_32x32x16_bf16(pa0, PK(a0, b0), o[0], 0, 0, 0); o[1] = __builtin_amdgcn_mfma_f32_32x32x16_bf16(pa0, PK(c0, d0), o[1], 0, 0, 0);
  o[0] = __builtin_amdgcn_mfma_f32_32x32x16_bf16(pa1, PK(a1, b1), o[0], 0, 0, 0); o[1] = __builtin_amdgcn_mfma_f32_32x32x16_bf16(pa1, PK(c1, d1), o[1], 0, 0, 0);
  o[0] = __builtin_amdgcn_mfma_f32_32x32x16_bf16(pa2, PK(a2, b2), o[0], 0, 0, 0); o[1] = __builtin_amdgcn_mfma_f32_32x32x16_bf16(pa2, PK(c2, d2), o[1], 0, 0, 0);
  o[0] = __builtin_amdgcn_mfma_f32_32x32x16_bf16(pa3, PK(a3, b3), o[0], 0, 0, 0); o[1] = __builtin_amdgcn_mfma_f32_32x32x16_bf16(pa3, PK(c3, d3), o[1], 0, 0, 0);
#undef PK
}
__device__ __forceinline__ void attn_unit(const bf16_t* __restrict__ Qb, bool rope_q, int tq0, const bf16_t* __restrict__ KVh, const bf16_t* __restrict__ KR,
                                          int ctx_row0, int lat_row0, int NT, bf16_t* __restrict__ Ob, LAS unsigned char* lds, int wave_s) {
  int tid = wave_s * 64 + lane_id(); asm volatile("" : "+v"(tid));
  const int wid = tid >> 6, lane = tid & 63, r32 = lane & 31, hi = lane >> 5;
  LAS float* al_l = (LAS float*)(lds + OFF_WS) + wid * 64;
  float mref = 0.f, l_reg = 0.f; f32x16 o[2] = {}; f32x16 negm = {}; asm volatile("" : "+v"(negm)); bf16x8 qr[6];
  const int sr = tid >> 4, sc = (tid & 15) * 8, rr = (tid & 255) >> 2, rc = (tid & 3) * 8;
  const int st0 = (sc < 64) ? OFF_K + KSWZ(sr, sc * 2) : OFF_V + v_st(sr, sc - 64);
  const int st1 = (sc < 64) ? OFF_K + KSWZ(32 + sr, sc * 2) : OFF_V + v_st(32 + sr, sc - 64);
  const int st2 = OFF_K + KSWZ(rr, (64 + rc) * 2);
  const int vb0 = (int)(size_t)(lds + OFF_V) + v_rd_base(lane);
  struct { bf16x8 a0, a1, rp; } sg[2];
#define KROW(t) ((t) < 4 ? ctx_row0 + (t) * KVBLK : lat_row0 + ((t) - 4) * KVBLK)
#define SLOAD(i, t) do { const long k0_ = KROW(t); sg[i].a0 = *(const bf16x8*)(KVh + (k0_ + sr) * 1024 + sc); sg[i].a1 = *(const bf16x8*)(KVh + (k0_ + 32 + sr) * 1024 + sc); \
    sg[i].rp = *(const bf16x8*)(KR + (k0_ + rr) * 32 + rc); } while (0)
#define SWRITE_AT(boff, i) do { *(LAS bf16x8*)(lds + (boff) + st0) = sg[i].a0; *(LAS bf16x8*)(lds + (boff) + st1) = sg[i].a1; *(LAS bf16x8*)(lds + (boff) + st2) = sg[i].rp; } while (0)
#define RESC(a) do { if (__any((a) < 1.f)) { if (hi == 0) al_l[r32] = (a); asm volatile("s_waitcnt lgkmcnt(0)" ::: "memory"); \
    _Pragma("unroll") for (int r = 0; r < 16; ++r) { const float f_ = al_l[crow(r, hi)]; o[0][r] *= f_; o[1][r] *= f_; } } } while (0)
  const int trail = (wave_s >= 4) ? 1 : 0;
  const LAS unsigned char* Kb = lds + OFF_K;
  f32x16 p0, p1; float alpha; bf16x8 pa0, pa1, pa2, pa3;
  SLOAD(0, 0); SLOAD(1, 1);
  { const bf16_t* Qw = Qb + (long)(wid * QBLK + r32) * 768;
#pragma unroll
    for (int d0 = 0; d0 < 4; ++d0) { const u32x4 w = *(const u32x4*)(Qw + d0 * 16 + hi * 8);
      u32x4 s = {cvtpk(bflo(w.x) * C2, bfhi(w.x) * C2), cvtpk(bflo(w.y) * C2, bfhi(w.y) * C2), cvtpk(bflo(w.z) * C2, bfhi(w.z) * C2), cvtpk(bflo(w.w) * C2, bfhi(w.w) * C2)};
      qr[d0] = __builtin_bit_cast(bf16x8, s); }
    const int t = tq0 + wid * QBLK + r32;
#pragma unroll
    for (int a = 0; a < 2; ++a) {
      const u32x4 lo = *(const u32x4*)(Qw + 64 + a * 16), hh = *(const u32x4*)(Qw + 64 + a * 16 + 8);
      const float pos = (float)(a == 0 ? (t >> 6) : (t & 63)); float ov[8];
#pragma unroll
      for (int i = 0; i < 8; ++i) { const float ang = rope_q ? pos * rope_inv(i) : 0.f, c = __cosf(ang) * C2, s = __sinf(ang) * C2;
        const float l = (i & 1) ? bfhi(lo[i >> 1]) : bflo(lo[i >> 1]), h = (i & 1) ? bfhi(hh[i >> 1]) : bflo(hh[i >> 1]);
        ov[i] = hi ? (h * c + l * s) : (l * c - h * s); }
      u32x4 w = {cvtpk(ov[0], ov[1]), cvtpk(ov[2], ov[3]), cvtpk(ov[4], ov[5]), cvtpk(ov[6], ov[7])}; qr[4 + a] = __builtin_bit_cast(bf16x8, w);
    }
  }
  asm volatile("s_waitcnt vmcnt(3)" ::: "memory"); SWRITE_AT(0, 0);
  if (trail) { asm volatile("s_waitcnt vmcnt(0)" ::: "memory"); SWRITE_AT(BUFB, 1); SLOAD(1, 2); SLOAD(0, 3); }
  else { SLOAD(0, 2); }
  __syncthreads();
  if (trail) __syncthreads();
  int bV = 0, bK = 0, bN = BUFB, bNN = 2 * BUFB;
#define PHASE_M(j) do { SBAR(); __builtin_amdgcn_s_setprio(2); if ((j) > 0) pv_d0(o, vb0 + bV, pa0, pa1, pa2, pa3); qkt(p0, p1, Kb + bK, qr, negm, r32, hi); __builtin_amdgcn_s_setprio(0); SBAR(); __syncthreads(); } while (0)
#define PHASE_V(j, slot) do { softmaxT(p0, p1, mref, negm, l_reg, alpha, pa0, pa1, pa2, pa3); RESC(alpha); \
    { const int s_ = (j) + 1 + trail; if (s_ < NT) { asm volatile("s_waitcnt vmcnt(3)" ::: "memory"); SWRITE_AT(trail ? bNN : bN, slot); const int s2_ = s_ + 2; SLOAD(slot, s2_ < NT ? s2_ : NT - 1); } } \
    __syncthreads(); bV = bK; bK = bN; bN = bNN; bNN = bV; } while (0)
  for (int j = 0; j < NT; j += 2) {
    PHASE_M(j); PHASE_V(j, 1);
    PHASE_M(j + 1); PHASE_V(j + 1, 0);
  }
  SBAR(); pv_d0(o, vb0 + bV, pa0, pa1, pa2, pa3);
  if (!trail) __syncthreads();
#undef PHASE_M
#undef PHASE_V
  { auto rr_ = __builtin_amdgcn_permlane32_swap(__float_as_uint(l_reg), __float_as_uint(l_reg), false, false); l_reg = __uint_as_float(rr_[0]) + __uint_as_float(rr_[1]); }
  if (hi == 0) al_l[32 + r32] = l_reg; asm volatile("s_waitcnt lgkmcnt(0)" ::: "memory");
  float rli[16];
#pragma unroll
  for (int r = 0; r < 16; ++r) rli[r] = __builtin_amdgcn_rcpf(al_l[32 + crow(r, hi)]);
  bf16_t* Ow = Ob + (long)(wid * QBLK) * 1024;
#pragma unroll
  for (int r = 0; r < 16; ++r) { const int orow = crow(r, hi);
#pragma unroll
    for (int d0 = 0; d0 < 2; ++d0) Ow[(long)orow * 1024 + d0 * 32 + r32] = f2bf(o[d0][r] * rli[r]); }
  __syncthreads();
#undef KROW
#undef SLOAD
#undef SWRITE_AT
#undef RESC
}
}

constexpr int NLAT = 32768, NCTX = 1024, MTOT = 33792, DM = 1024, ZW = 1792, INW = 1696, SEQL = 8192, CTXL = 256, DFF = 4096;
constexpr float EPSN = 1e-6f;
constexpr size_t MiB = 1u << 20;
constexpr size_t WS_MOD = 1 * MiB;
constexpr size_t WS_W = 2 * MiB, W_LAYER = 23 * MiB;
constexpr size_t W_IN = 0, W_Q = 3584 * 1024, W_KV = 4 * MiB, W_O = 4608 * 1024, W_UP = 7 * MiB, W_DN = 15 * MiB;
constexpr size_t WS_A = 48 * MiB;
constexpr size_t WS_B = 114 * MiB;
constexpr size_t WS_Z = WS_B, WS_Q = WS_B + 116 * MiB, WS_KV = WS_B + 166 * MiB, WS_QN = WS_B + 232 * MiB, WS_KVN = WS_B + 249 * MiB, WS_KR = WS_B + 258 * MiB;
constexpr size_t WS_D = 378 * MiB;
constexpr size_t WS_XSC = 444 * MiB;
constexpr size_t WS_PART = 448 * MiB;
constexpr size_t WS_END = 512 * MiB;
static_assert((size_t)MTOT * ZW * 2 <= 116 * MiB && (size_t)MTOT * 768 * 2 <= 50 * MiB && (size_t)MTOT * 1024 * 2 <= 66 * MiB && (size_t)MTOT * 256 * 2 <= 17 * MiB && (size_t)MTOT * 128 * 2 <= 9 * MiB && WS_KR + (size_t)MTOT * 64 <= WS_B + 264 * MiB, "ws map");
constexpr int LDS_BYTES = 147456;

struct Params { const float* in[24]; float* out; unsigned char* ws; };
enum { I_X = 0, I_C, I_CTX, I_CCTX, I_WMOD, I_BMOD, I_GPREMIX, I_GPOSTMIX, I_GPREMLP, I_GPOSTMLP, I_WIN, I_GQ, I_WQB, I_GKV, I_WKVB, I_CDWW, I_CDWB, I_CLNG, I_CLNB, I_SDWW, I_GBR, I_WO, I_WUP, I_WDN };

__device__ __forceinline__ void transpose_item(const float* __restrict__ W, int K, int N, bf16_t* __restrict__ WT, LAS float* scr, int item, int lane) {
    const int nblk = N / 32, kb = item / nblk, nb = item % nblk, k0 = 64 * kb, n0 = 32 * nb;
#pragma unroll 8
    for (int i = 0; i < 32; ++i) { const int kk = 2 * i + (lane >> 5); scr[kk * 33 + (lane & 31)] = W[(size_t)(k0 + kk) * N + n0 + (lane & 31)]; }
    asm volatile("s_waitcnt lgkmcnt(0)" ::: "memory");
    const int c = lane & 7;
#pragma unroll
    for (int j = 0; j < 4; ++j) { const int n = (lane >> 3) + 8 * j; const LAS float* s = scr + (8 * c) * 33 + n;
        u32x4 o; o.x = cvtpk(s[0 * 33], s[1 * 33]); o.y = cvtpk(s[2 * 33], s[3 * 33]); o.z = cvtpk(s[4 * 33], s[5 * 33]); o.w = cvtpk(s[6 * 33], s[7 * 33]);
        *(u32x4*)(WT + (size_t)(n0 + n) * K + k0 + 8 * c) = o; }
    asm volatile("s_waitcnt lgkmcnt(0)" ::: "memory");
}
__device__ __forceinline__ void load16(const float* row, int lane, f32x4 (&v)[4]) {
#pragma unroll
    for (int j = 0; j < 4; ++j) v[j] = __builtin_nontemporal_load((const f32x4*)row + lane + 64 * j);
}
__device__ __forceinline__ void load16bf(const bf16_t* row, int lane, f32x4 (&v)[4]) {
#pragma unroll
    for (int j = 0; j < 4; ++j) { const u32x2 w = __builtin_nontemporal_load((const u32x2*)row + lane + 64 * j); v[j] = (f32x4){bflo(w.x), bfhi(w.x), bflo(w.y), bfhi(w.y)}; }
}
template <int NS> __device__ __forceinline__ void load16part(const float* P, int rowrel, int lane, f32x4 (&v)[4]) {
#pragma unroll
    for (int j = 0; j < 4; ++j) v[j] = (f32x4){0.f, 0.f, 0.f, 0.f};
#pragma unroll
    for (int s0 = 0; s0 < NS; s0 += 4) { f32x4 t[4][4];
#pragma unroll
        for (int s = 0; s < 4; ++s) { const f32x4* q = (const f32x4*)(P + ((size_t)(s0 + s) * 1024 + rowrel) * 1024);
#pragma unroll
            for (int j = 0; j < 4; ++j) t[s][j] = q[lane + 64 * j]; }
#pragma unroll
        for (int s = 0; s < 4; ++s)
#pragma unroll
            for (int j = 0; j < 4; ++j) v[j] += t[s][j]; }
}
__device__ __forceinline__ float ssq16(const f32x4 (&v)[4]) {
    float s = 0.f;
#pragma unroll
    for (int j = 0; j < 4; ++j) s += (v[j].x * v[j].x + v[j].y * v[j].y) + (v[j].z * v[j].z + v[j].w * v[j].w);
    return wave_sum(s);
}
__device__ __forceinline__ void prenorm_store(const f32x4 (&v)[4], float rinv, const float* g, const float* shift, const float* scale, bf16_t* orow, int lane) {
#pragma unroll
    for (int j = 0; j < 4; ++j) { const int q = lane + 64 * j; const f32x4 gg = ((const f32x4*)g)[q], sh = ((const f32x4*)shift)[q], sc = ((const f32x4*)scale)[q];
        const f32x4 h = (v[j] * rinv * gg) * (sc + 1.0f) + sh; u32x2 w; w.x = cvtpk(h.x, h.y); w.y = cvtpk(h.z, h.w); ((u32x2*)orow)[q] = w; }
}

#define XB_TMO      128
#define XB_XCNT(j)  (256  + 64 * (j))
#define XB_XSUB(j)  (1280 + 64 * (j))
#define XB_XGEN(j)  (2304 + 64 * (j))
#define XB_TOP      3328
#define XB_TOPGEN   3392
#define XCD_BAR_WORDS 3456
#define XB_SPIN_CAP (1u << 18)

__device__ __forceinline__ unsigned xb_ld(unsigned* p)              { return __hip_atomic_load(p, __ATOMIC_RELAXED, __HIP_MEMORY_SCOPE_AGENT); }
__device__ __forceinline__ unsigned xb_add(unsigned* p, unsigned v) { return __hip_atomic_fetch_add(p, v, __ATOMIC_RELAXED, __HIP_MEMORY_SCOPE_AGENT); }
__device__ __forceinline__ unsigned xb_xcc_id() { return (unsigned)__builtin_amdgcn_s_getreg((3 << 11) | 20) & 0xFu; }
#define XB_SPIN(cond, bar) do { unsigned _sp = 0; while (cond) { __builtin_amdgcn_s_sleep(1); \
    if ((++_sp & 255u) == 0u) { if (xb_ld(&(bar)[XB_TMO])) break; if (_sp > XB_SPIN_CAP) { atomicAdd(&(bar)[XB_TMO], 1u); break; } } } } while (0)

struct XcdBarrier { unsigned* bar; unsigned x; volatile LAS unsigned* st; };
__device__ __forceinline__ XcdBarrier xcd_barrier_post(unsigned* bar, volatile LAS unsigned* st, bool leader) {
    XcdBarrier b; b.bar = bar; b.x = xb_xcc_id(); b.st = st;
    if (leader) (void)xb_add(&bar[XB_XCNT(b.x)], 1u);
    return b;
}
__device__ __forceinline__ void xcd_barrier_complete(unsigned* bar, unsigned x, unsigned& nloc, unsigned& nx) {
    const unsigned G = gridDim.x * gridDim.y * gridDim.z;
    unsigned sum, cnt, mine, sp = 0u;
    for (;;) {
        sum = 0u; cnt = 0u; mine = 0u;
#pragma unroll
        for (unsigned j = 0; j < 16; ++j) { const unsigned c = xb_ld(&bar[XB_XCNT(j)]); sum += c; cnt += (c > 0u) ? 1u : 0u; mine = (j == x) ? c : mine; }
        if (sum == G) break;
        __builtin_amdgcn_s_sleep(1);
        if ((++sp & 255u) == 0u) { if (xb_ld(&bar[XB_TMO])) break; if (sp > XB_SPIN_CAP) { atomicAdd(&bar[XB_TMO], 1u); break; } }
    }
    nloc = mine > 0u ? mine : 1u; nx = cnt > 0u ? cnt : 1u;
}
__device__ __forceinline__ void xcd_barrier(const XcdBarrier& b, bool leader) {
    asm volatile("s_waitcnt vmcnt(0) lgkmcnt(0)" ::: "memory");
    __syncthreads();
    if (leader) {
        unsigned* bar = b.bar;
        __builtin_amdgcn_s_waitcnt(0);
        unsigned nloc = b.st[0], nx = b.st[1];
        if (nloc == 0u) { xcd_barrier_complete(bar, b.x, nloc, nx); b.st[0] = nloc; b.st[1] = nx; }
        const unsigned old = xb_add(&bar[XB_XSUB(b.x)], 1u);
        const unsigned gen = old / nloc;
        if (old + 1u == (gen + 1u) * nloc) {
            __builtin_amdgcn_fence(__ATOMIC_RELEASE, "agent");
            asm volatile("s_waitcnt vmcnt(0)" ::: "memory");
            const unsigned og = xb_add(&bar[XB_TOP], 1u);
            const unsigned tg = og / nx;
            if (og + 1u == (tg + 1u) * nx) xb_add(&bar[XB_TOPGEN], 1u);
            else XB_SPIN(xb_ld(&bar[XB_TOPGEN]) == tg, bar);
            __builtin_amdgcn_fence(__ATOMIC_ACQUIRE, "agent");
            xb_add(&bar[XB_XGEN(b.x)], 1u);
            asm volatile("s_waitcnt vmcnt(0)" ::: "memory");
        } else {
            XB_SPIN(xb_ld(&bar[XB_XGEN(b.x)]) == gen, bar);
            __builtin_amdgcn_fence(__ATOMIC_ACQUIRE, "agent");
            asm volatile("s_waitcnt vmcnt(0)" ::: "memory");
        }
    }
    __syncthreads();
}
#ifndef PROBE_R1_REPS
#define PROBE_R1_REPS 1
#endif
#ifndef PROBE_P1_REPS
#define PROBE_P1_REPS 1
#endif
#ifndef PROBE_P0_REPS
#define PROBE_P0_REPS 1
#endif
#ifndef PROBE_BAR_REPS
#define PROBE_BAR_REPS 1
#endif
#ifndef PROBE_GEMM_REPS
#define PROBE_GEMM_REPS 1
#endif
#ifndef PROBE_ATT_REPS
#define PROBE_ATT_REPS 1
#endif

__global__ void __launch_bounds__(512, 2) fwd_megakernel(Params p) {
    extern __shared__ __attribute__((aligned(16))) unsigned char lds_raw[];
    LAS unsigned char* lds = (LAS unsigned char*)lds_raw;
    const int wave = __builtin_amdgcn_readfirstlane(threadIdx.x >> 6);
    typedef const __attribute__((address_space(4))) Params* KP;
#define PHASE_IDS() int tid = wave * 64 + lane_id(); asm volatile("" : "+v"(tid)); int G = gridDim.x, blk = blockIdx.x; asm volatile("" : "+s"(G), "+s"(blk)); const int NGW = G * 8; const int lane = tid & 63; const int gw = blk * 8 + wave; (void)lane; (void)gw; (void)NGW; \
    KP pp = (KP)__builtin_amdgcn_kernarg_segment_ptr(); asm volatile("" : "+s"(pp)); unsigned char* ws = pp->ws; (void)ws;
#define PIN(i) (pp->in[i])
#define LOADY(m, y, ns) do { if ((m) >= NLAT) load16part<ns>(WSP(float, WS_PART), (m) - NLAT, lane, y); else load16bf(BY + (size_t)(m) * DM, lane, y); } while (0)
#define XBAR_WORDS ((unsigned*)((KP)__builtin_amdgcn_kernarg_segment_ptr())->ws)
#define XBAR_ST ((volatile LAS unsigned*)(lds + 131072 + 256))
#define GBAR() do { XcdBarrier xb_; xb_.bar = XBAR_WORDS; xb_.x = xb_xcc_id(); xb_.st = XBAR_ST; xcd_barrier(xb_, wave == 0 && lane_id() == 0); } while (0)
#define WSP(T, off) ((T*)(ws + (off)))
#define MOD WSP(float, WS_MOD)
#define BA WSP(bf16_t, WS_A)
#define BH WSP(bf16_t, WS_B)
#define BZ WSP(bf16_t, WS_Z)
#define BQ WSP(bf16_t, WS_Q)
#define BKV WSP(bf16_t, WS_KV)
#define BQN WSP(bf16_t, WS_QN)
#define BKVN WSP(bf16_t, WS_KVN)
#define BKR WSP(bf16_t, WS_KR)
#define BY WSP(bf16_t, WS_D)
#define XSC WSP(float, WS_XSC)
#define XS_ROW(m) ((m) < NLAT ? pp->out + (size_t)(m) * DM : XSC + (size_t)((m) - NLAT) * DM)
#define MOD_ROW(l, m) (MOD + ((l) * 5 + ((m) < NLAT ? (m) / SEQL : 4)) * 6144)

    for (int rp0_ = 0; rp0_ < PROBE_P0_REPS; ++rp0_) {
        PHASE_IDS();
        if (blk == 0) for (int i = tid; i < XCD_BAR_WORDS; i += 512) ((unsigned*)ws)[i] = 0u;
        if (tid < 2) ((LAS unsigned*)(lds + 131072 + 256))[tid] = 0u;
        LAS float* sil = (LAS float*)lds;
        LAS float* part = sil + 5 * 1024;
        for (int it = blk; it < 192; it += G) {
            const int l = it / 96, j0 = (it % 96) * 64;
            for (int i = tid; i < 5 * 1024; i += 512) { const int r = i >> 10, k = i & 1023; const float cv = r < 4 ? PIN(I_C)[r * 1024 + k] : PIN(I_CCTX)[k]; sil[i] = cv * sigmoidf_(cv); }
            __syncthreads();
            const int kg = tid >> 6, jc = tid & 63; const float* wm = PIN(I_WMOD) + (size_t)l * 1024 * 6144 + j0 + jc;
            float a0 = 0.f, a1 = 0.f, a2 = 0.f, a3 = 0.f, a4 = 0.f;
#pragma unroll 8
            for (int k = kg; k < 1024; k += 8) { const float w = wm[(size_t)k * 6144]; a0 += sil[k] * w; a1 += sil[1024 + k] * w; a2 += sil[2048 + k] * w; a3 += sil[3072 + k] * w; a4 += sil[4096 + k] * w; }
            part[(kg * 5 + 0) * 64 + jc] = a0; part[(kg * 5 + 1) * 64 + jc] = a1; part[(kg * 5 + 2) * 64 + jc] = a2; part[(kg * 5 + 3) * 64 + jc] = a3; part[(kg * 5 + 4) * 64 + jc] = a4;
            __syncthreads();
            if (tid < 320) { const int r = tid >> 6; float s = 0.f;
#pragma unroll
                for (int q = 0; q < 8; ++q) s += part[(q * 5 + r) * 64 + jc];
                MOD[(l * 5 + r) * 6144 + j0 + jc] = s + PIN(I_BMOD)[l * 6144 + j0 + jc]; }
            __syncthreads();
        }
        LAS float* scr = (LAS float*)(lds + 32768 + wave * 8704);
        constexpr int T_IN = 16 * 53, T_Q = 4 * 24, T_KV = 2 * 32, T_O = 16 * 32, T_UP = 16 * 128, T_DN = 64 * 32, T_L = T_IN + T_Q + T_KV + T_O + T_UP + T_DN;
        for (int it = gw; it < 2 * T_L; it += NGW) {
            const int l = it / T_L; int r = it % T_L; bf16_t* wl = (bf16_t*)(ws + WS_W + (size_t)l * W_LAYER);
            if (r < T_IN) { transpose_item(PIN(I_WIN) + (size_t)l * 1024 * INW, 1024, INW, (bf16_t*)((unsigned char*)wl + W_IN), scr, r, lane); continue; } r -= T_IN;
            if (r < T_Q) { transpose_item(PIN(I_WQB) + (size_t)l * 256 * 768, 256, 768, (bf16_t*)((unsigned char*)wl + W_Q), scr, r, lane); continue; } r -= T_Q;
            if (r < T_KV) { transpose_item(PIN(I_WKVB) + (size_t)l * 128 * 1024, 128, 1024, (bf16_t*)((unsigned char*)wl + W_KV), scr, r, lane); continue; } r -= T_KV;
            if (r < T_O) { transpose_item(PIN(I_WO) + (size_t)l * 1024 * 1024, 1024, 1024, (bf16_t*)((unsigned char*)wl + W_O), scr, r, lane); continue; } r -= T_O;
            if (r < T_UP) { transpose_item(PIN(I_WUP) + (size_t)l * 1024 * DFF, 1024, DFF, (bf16_t*)((unsigned char*)wl + W_UP), scr, r, lane); continue; } r -= T_UP;
            transpose_item(PIN(I_WDN) + (size_t)l * DFF * 1024, DFF, 1024, (bf16_t*)((unsigned char*)wl + W_DN), scr, r, lane);
        }
        for (int i = blk * 512 + tid; i < 2 * 96 * 128; i += G * 512) { const int l = i / (96 * 128), q = i % (96 * 128);
            ((u32x4*)(ws + WS_W + (size_t)l * W_LAYER + W_IN + (size_t)INW * 2048))[q] = (u32x4){0u, 0u, 0u, 0u}; }
    }
    cg::this_grid().sync();
    (void)xcd_barrier_post(XBAR_WORDS, XBAR_ST, wave == 0 && lane_id() == 0);
    { PHASE_IDS();
#define P1_SRC(m) ((m) < NLAT ? PIN(I_X) + (size_t)(m) * DM : PIN(I_CTX) + (size_t)((m) - NLAT) * DM)
#define P1_ROW(m, v) do { const float* mod = MOD_ROW(0, m); const float rinv = rsqrtf(ssq16(v) * (1.f / DM) + EPSN); prenorm_store(v, rinv, PIN(I_GPREMIX), mod, mod + 1024, BA + (size_t)(m) * DM, lane); } while (0)
    for (int m0 = gw; m0 < MTOT; m0 += 2 * NGW) { const int m1 = m0 + NGW; const bool has1 = m1 < MTOT; const int m1c = has1 ? m1 : m0;
        f32x4 v0[4], v1[4]; load16(P1_SRC(m0), lane, v0); load16(P1_SRC(m1c), lane, v1);
        P1_ROW(m0, v0); if (has1) P1_ROW(m1, v1); } }
    GBAR();

    for (int l = 0; l < 2; ++l) {
        const bool last = (l == 1);
#define WL (ws + WS_W + (size_t)l * W_LAYER)
        const int Mact = last ? NLAT : MTOT;
        for (int rep_ = 0; rep_ < PROBE_GEMM_REPS; ++rep_) { PHASE_IDS(); pg8::Gemm g{BA, (const bf16_t*)(WL + W_IN), MTOT, ZW, 1024, 1024}; pg8::StaticOrder S; S.init(MTOT, ZW, G, blk); pg8::EpiBf16<0> E{BZ, ZW};
          pg8::gemm_phase<pg8::EpiBf16<0>, pg8::StaticOrder, true, true>(lds, g, S, E, wave); }
        GBAR();
        for (int rr1_ = 0; rr1_ < PROBE_R1_REPS; ++rr1_) {
            PHASE_IDS();
            const float* gq = PIN(I_GQ) + l * 256; const float* gkv = PIN(I_GKV) + l * 128; const float* gbr = PIN(I_GBR) + l * 1024;
            const float* cw = PIN(I_CDWW) + l * 31 * 256; const float* cb = PIN(I_CDWB) + l * 256; const float* lng = PIN(I_CLNG) + l * 256; const float* lnb = PIN(I_CLNB) + l * 256;
            const float* sw = PIN(I_SDWW) + l * 3 * 256;
            LAS float* U = (LAS float*)lds;
            LAS float* WL_ = (LAS float*)(lds + 96256);
            for (int i = tid; i < 31 * 64; i += 512) *(LAS f32x4*)(WL_ + 4 * i) = ((const f32x4*)cw)[i];
            __syncthreads();
            const int lane_o = lane, tid_o = tid;
            for (int ti = blk; ti < 544; ti += G) {
                int tid = tid_o; asm volatile("" : "+v"(tid)); const int lane = tid & 63;
                int seq_base, seq_len, t0; bool is_lat;
                if (ti < 512) { seq_base = (ti >> 7) * SEQL; seq_len = SEQL; t0 = (ti & 127) * 64; is_lat = true; }
                else { const int tc = ti - 512; seq_base = NLAT + (tc >> 3) * CTXL; seq_len = CTXL; t0 = (tc & 7) * 32; is_lat = false; }
                const int TT = is_lat ? 64 : 32; const int urows = (TT + 30) * 32; const bool wact = wave * 8 < TT;
                { u32x4 ua[6], ug[6];
#pragma unroll
                  for (int i = 0; i < 6; ++i) { const int it = tid + 512 * i, rr = it >> 5, c8 = it & 31, t = t0 - 15 + rr; const bool ok = it < urows && t >= 0 && t < seq_len;
                      const bf16_t* zr = BZ + (size_t)(seq_base + (ok ? t : t0)) * ZW; ua[i] = *(const u32x4*)(zr + 416 + 8 * c8); ug[i] = *(const u32x4*)(zr + 672 + 8 * c8); if (!ok) ua[i] = (u32x4){0u, 0u, 0u, 0u}; }
#pragma unroll
                  for (int i = 0; i < 6; ++i) { const int it = tid + 512 * i, rr = it >> 5, c8 = it & 31; const u32x4 a = ua[i], gg = ug[i];
                      if (it < urows) {
                        const f32x4 u0 = {bflo(a.x) * sigmoidf_(bflo(gg.x)), bfhi(a.x) * sigmoidf_(bfhi(gg.x)), bflo(a.y) * sigmoidf_(bflo(gg.y)), bfhi(a.y) * sigmoidf_(bfhi(gg.y))};
                        const f32x4 u1 = {bflo(a.z) * sigmoidf_(bflo(gg.z)), bfhi(a.z) * sigmoidf_(bfhi(gg.z)), bflo(a.w) * sigmoidf_(bflo(gg.w)), bfhi(a.w) * sigmoidf_(bfhi(gg.w))};
                        *(LAS f32x4*)(U + rr * 256 + 8 * c8) = u0; *(LAS f32x4*)(U + rr * 256 + 8 * c8 + 4) = u1; } } }
                if (wact) { const int tw = t0 + wave * 8; const size_t mw = (size_t)seq_base + tw; const bf16_t* zw = BZ + mw * ZW;
                  u32x2 zq[8], bgt[8], cgt[10], hht[10]; unsigned kvv[8]; unsigned short krv[8];
#pragma unroll
                  for (int k8 = 0; k8 < 8; ++k8) { const bf16_t* zr = zw + (size_t)k8 * ZW; zq[k8] = *(const u32x2*)(zr + 4 * lane); kvv[k8] = *(const unsigned*)(zr + 256 + 2 * lane); krv[k8] = zr[384 + (lane & 31)];
                      bgt[k8] = *(const u32x2*)(zr + 928 + 4 * lane); }
#pragma unroll
                  for (int j = 0; j < 10; ++j) { const int tt = tw - 1 + j; const bool ok = tt >= 0 && tt < seq_len; const bf16_t* z2 = BZ + (size_t)(seq_base + (ok ? tt : tw)) * ZW;
                      cgt[j] = *(const u32x2*)(z2 + 1184 + 4 * lane); hht[j] = *(const u32x2*)(z2 + 1440 + 4 * lane); if (!ok) { cgt[j] = (u32x2){0u, 0u}; } }
                  const f32x4 gqv = ((const f32x4*)gq)[lane]; const float gk0 = gkv[2 * lane], gk1 = gkv[2 * lane + 1]; const f32x4 gsc = ((const f32x4*)(gbr + 768))[lane];
                  const f32x4 sw0 = ((const f32x4*)sw)[lane], sw1 = ((const f32x4*)(sw + 256))[lane], sw2 = ((const f32x4*)(sw + 512))[lane];
                  f32x4 pr[10];
#pragma unroll
                  for (int j = 0; j < 10; ++j) pr[j] = (f32x4){bflo(cgt[j].x) * bflo(hht[j].x), bfhi(cgt[j].x) * bfhi(hht[j].x), bflo(cgt[j].y) * bflo(hht[j].y), bfhi(cgt[j].y) * bfhi(hht[j].y)};
#pragma unroll
                  for (int k8 = 0; k8 < 8; ++k8) { const int t = tw + k8; const size_t m = mw + k8;
                    { const u32x2 w = zq[k8]; const f32x4 v = {bflo(w.x), bfhi(w.x), bflo(w.y), bfhi(w.y)};
                      const float ri = rsqrtf(wave_sum((v.x * v.x + v.y * v.y) + (v.z * v.z + v.w * v.w)) * (1.f / 256.f) + EPSN); const f32x4 o = v * ri * gqv;
                      u32x2 ow; ow.x = cvtpk(o.x, o.y); ow.y = cvtpk(o.z, o.w); *(u32x2*)(BQN + m * 256 + 4 * lane) = ow; }
                    { const unsigned w = kvv[k8]; const float v0 = bflo(w), v1 = bfhi(w);
                      const float ri = rsqrtf(wave_sum(v0 * v0 + v1 * v1) * (1.f / 128.f) + EPSN); *(unsigned*)(BKVN + m * 128 + 2 * lane) = cvtpk(v0 * ri * gk0, v1 * ri * gk1); }
                    { const int e = lane & 31; const float v = bf2f(krv[k8]); const float prn = swz_xor<8>(v); float o = v;
                      if (is_lat) { const int a = e >> 4, i = e & 15; const float pos = (float)(a == 0 ? (t >> 6) : (t & 63)); const float ang = pos * rope_inv(i & 7), c = __cosf(ang), s = __sinf(ang);
                          o = (i < 8) ? (v * c - prn * s) : (v * c + prn * s); }
                      if (lane < 32) BKR[m * 32 + e] = f2bf(o); }
                    { const f32x4 acc = pr[k8] * sw0 + pr[k8 + 1] * sw1 + pr[k8 + 2] * sw2; const u32x2 bg = bgt[k8];
                      const f32x4 s = {bflo(bg.x) * acc.x, bfhi(bg.x) * acc.y, bflo(bg.y) * acc.z, bfhi(bg.y) * acc.w};
                      const float ri = rsqrtf(wave_sum((s.x * s.x + s.y * s.y) + (s.z * s.z + s.w * s.w)) * (1.f / 256.f) + EPSN); const f32x4 o = s * ri * gsc;
                      u32x2 ow; ow.x = cvtpk(o.x, o.y); ow.y = cvtpk(o.z, o.w); *(u32x2*)(BA + m * DM + 768 + 4 * lane) = ow; }
                  }
                }
                __syncthreads();
                if (wact) { int lane = lane_o; asm volatile("" : "+v"(lane)); f32x4 wv[31];
#pragma unroll
                  for (int j = 0; j < 31; ++j) wv[j] = *(const LAS f32x4*)(WL_ + j * 256 + 4 * lane);
                  const f32x4 bias = ((const f32x4*)cb)[lane]; f32x4 acc[8];
#pragma unroll
                  for (int k = 0; k < 8; ++k) acc[k] = bias;
                  const LAS float* Ub = U + (wave * 8) * 256 + 4 * lane;
#pragma unroll
                  for (int i = 0; i < 38; ++i) { const f32x4 u = *(const LAS f32x4*)(Ub + i * 256);
#pragma unroll
                      for (int k = 0; k < 8; ++k) { const int j = i - k; if (j >= 0 && j < 31) acc[k] += u * wv[j]; } }
                  const f32x4 lg = ((const f32x4*)lng)[lane], lb = ((const f32x4*)lnb)[lane], gb = ((const f32x4*)(gbr + 512))[lane];
#pragma unroll
                  for (int k = 0; k < 8; ++k) { const f32x4 a = acc[k]; const float mean = wave_sum((a.x + a.y) + (a.z + a.w)) * (1.f / 256.f); const f32x4 d = a - mean;
                      const float rstd = rsqrtf(wave_sum((d.x * d.x + d.y * d.y) + (d.z * d.z + d.w * d.w)) * (1.f / 256.f) + EPSN); f32x4 y = d * rstd * lg + lb;
                      y = (f32x4){y.x * sigmoidf_(y.x), y.y * sigmoidf_(y.y), y.z * sigmoidf_(y.z), y.w * sigmoidf_(y.w)};
                      const float ri = rsqrtf(wave_sum((y.x * y.x + y.y * y.y) + (y.z * y.z + y.w * y.w)) * (1.f / 256.f) + EPSN); const f32x4 o = y * ri * gb;
                      u32x2 ow; ow.x = cvtpk(o.x, o.y); ow.y = cvtpk(o.z, o.w); *(u32x2*)(BA + ((size_t)seq_base + t0 + wave * 8 + k) * DM + 512 + 4 * lane) = ow; } }
                __syncthreads();
            }
        }
        GBAR();
        for (int rep_ = 0; rep_ < PROBE_GEMM_REPS; ++rep_) { PHASE_IDS(); pg8::Gemm g{BQN, (const bf16_t*)(WL + W_Q), MTOT, 768, 256, 256}; pg8::StaticOrder S; S.init(MTOT, 768, G, blk); pg8::EpiBf16<0> E{BQ, 768};
          pg8::gemm_phase<pg8::EpiBf16<0>, pg8::StaticOrder, true, true>(lds, g, S, E, wave); }
        for (int rep_ = 0; rep_ < PROBE_GEMM_REPS; ++rep_) { PHASE_IDS(); pg8::Gemm g{BKVN, (const bf16_t*)(WL + W_KV), MTOT, 1024, 128, 128}; pg8::StaticOrder S; S.init(MTOT, 1024, G, blk); pg8::EpiBf16<0> E{BKV, 1024};
          pg8::gemm_phase<pg8::EpiBf16<0>, pg8::StaticOrder, true, true>(lds, g, S, E, wave); }
        GBAR();
        {
            PHASE_IDS();
            const int nunits = last ? 1024 : 1056;
            for (int rep_ = 0; rep_ < PROBE_ATT_REPS; ++rep_)
            for (int u = blk; u < nunits; u += G) {
                if (u < 1024) { const int bh = (u & 7) + 8 * (u >> 8), qb = (u >> 3) & 31, b = bh >> 3, h = bh & 7; const int q0 = b * SEQL + qb * 256;
                    att::attn_unit(BQ + (size_t)q0 * 768 + h * 96, true, qb * 256, BKV + h * 128, BKR, NLAT + b * CTXL, b * SEQL, 132, BA + (size_t)q0 * DM + h * 64, lds, wave); }
                else { const int uc = u - 1024, b = uc >> 3, h = uc & 7; const int q0 = NLAT + b * CTXL;
                    att::attn_unit(BQ + (size_t)q0 * 768 + h * 96, false, 0, BKV + h * 128, BKR, q0, 0, 4, BA + (size_t)q0 * DM + h * 64, lds, wave); }
            }
        }
        GBAR();
        { PHASE_IDS(); const float* gbr = PIN(I_GBR) + l * 1024; const f32x4 g0 = ((const f32x4*)gbr)[2 * lane], g1 = ((const f32x4*)gbr)[2 * lane + 1];
          for (int m0 = gw; m0 < Mact; m0 += 4 * NGW) { u32x4 w[4];
#pragma unroll
              for (int i = 0; i < 4; ++i) { const int m = m0 + i * NGW; w[i] = ((const u32x4*)(BA + (size_t)(m < Mact ? m : m0) * DM))[lane]; }
#pragma unroll
              for (int i = 0; i < 4; ++i) { const int m = m0 + i * NGW; if (m < Mact) {
                  const float v[8] = {bflo(w[i].x), bfhi(w[i].x), bflo(w[i].y), bfhi(w[i].y), bflo(w[i].z), bfhi(w[i].z), bflo(w[i].w), bfhi(w[i].w)}; float s = 0.f;
#pragma unroll
                  for (int q = 0; q < 8; ++q) s += v[q] * v[q];
                  const float ri = rsqrtf(wave_sum(s) * (1.f / 512.f) + EPSN);
                  u32x4 o; o.x = cvtpk(v[0] * ri * g0.x, v[1] * ri * g0.y); o.y = cvtpk(v[2] * ri * g0.z, v[3] * ri * g0.w); o.z = cvtpk(v[4] * ri * g1.x, v[5] * ri * g1.y); o.w = cvtpk(v[6] * ri * g1.z, v[7] * ri * g1.w);
                  ((u32x4*)(BA + (size_t)m * DM))[lane] = o; } } } }
        GBAR();
        { PHASE_IDS(); pg8::Gemm g{BA, (const bf16_t*)(WL + W_O), NLAT, 1024, 1024, 1024}; pg8::StaticOrder S; S.init(NLAT, 1024, G, blk); pg8::EpiBf16<0> E{BY, 1024};
          pg8::gemm_phase<pg8::EpiBf16<0>, pg8::StaticOrder, true, true>(lds, g, S, E, wave); }
        if (!last) { PHASE_IDS(); pg8::Gemm g{BA, (const bf16_t*)(WL + W_O), MTOT, 1024, 256, 1024}; pg8::SplitOrder S; S.init(4, 4, 4, 128, G, blk); pg8::EpiF32Part E{WSP(float, WS_PART), 1024, 128, (size_t)1024 * 1024};
          pg8::gemm_phase<pg8::EpiF32Part, pg8::SplitOrder, true, true>(lds, g, S, E, wave); }
        GBAR();
        { PHASE_IDS(); const float* gp = PIN(I_GPOSTMIX) + l * DM; const float* gm = PIN(I_GPREMLP) + l * DM;
#define R3_SRC(m) ((l == 0) ? ((m) < NLAT ? PIN(I_X) + (size_t)(m) * DM : PIN(I_CTX) + (size_t)((m) - NLAT) * DM) : (const float*)XS_ROW(m))
#define R3_ROW(m, y, x) do { const float* mod = MOD_ROW(l, m); float* dst = XS_ROW(m); const float ry = rsqrtf(ssq16(y) * (1.f / DM) + EPSN); \
            _Pragma("unroll") for (int j = 0; j < 4; ++j) { const int q = lane + 64 * j; x[j] = x[j] + ((const f32x4*)(mod + 2048))[q] * (y[j] * ry * ((const f32x4*)gp)[q]); __builtin_nontemporal_store(x[j], (f32x4*)dst + q); } \
            const float r1 = rsqrtf(ssq16(x) * (1.f / DM) + EPSN); prenorm_store(x, r1, gm, mod + 3072, mod + 4096, BA + (size_t)(m) * DM, lane); } while (0)
        for (int m0 = gw; m0 < Mact; m0 += 4 * NGW) { f32x4 yb[4][4], xb[4][4];
#pragma unroll
            for (int i = 0; i < 4; ++i) { const int mi = m0 + i * NGW, mc = mi < Mact ? mi : m0; LOADY(mc, yb[i], 4); load16(R3_SRC(mc), lane, xb[i]); }
#pragma unroll
            for (int i = 0; i < 4; ++i) { const int mi = m0 + i * NGW; if (mi < Mact) R3_ROW(mi, yb[i], xb[i]); } } }
        GBAR();
        for (int rep_ = 0; rep_ < PROBE_GEMM_REPS; ++rep_) { PHASE_IDS(); pg8::Gemm g{BA, (const bf16_t*)(WL + W_UP), Mact, DFF, 1024, 1024}; pg8::StaticOrder S; S.init(Mact, DFF, G, blk); pg8::EpiBf16<2> E{BH, DFF};
          pg8::gemm_phase<pg8::EpiBf16<2>, pg8::StaticOrder, true, true>(lds, g, S, E, wave); }
        GBAR();
        { PHASE_IDS(); pg8::Gemm g{BH, (const bf16_t*)(WL + W_DN), NLAT, 1024, DFF, DFF}; pg8::StaticOrder S; S.init(NLAT, 1024, G, blk); S.rev = true; pg8::EpiBf16<0> E{BY, 1024};
          pg8::gemm_phase<pg8::EpiBf16<0>, pg8::StaticOrder, true, true>(lds, g, S, E, wave); }
        if (!last) { PHASE_IDS(); pg8::Gemm g{BH, (const bf16_t*)(WL + W_DN), MTOT, 1024, 256, DFF}; pg8::SplitOrder S; S.init(4, 4, 16, 128, G, blk); pg8::EpiF32Part E{WSP(float, WS_PART), 1024, 128, (size_t)1024 * 1024};
          pg8::gemm_phase<pg8::EpiF32Part, pg8::SplitOrder, true, true>(lds, g, S, E, wave); }
        GBAR();
        { PHASE_IDS(); const float* gp = PIN(I_GPOSTMLP) + l * DM; const float* gn = PIN(I_GPREMIX) + (last ? 0 : (l + 1) * DM);
#define R4_ROW(m, y, x) do { const float* mod = MOD_ROW(l, m); float* xr = XS_ROW(m); const float ry = rsqrtf(ssq16(y) * (1.f / DM) + EPSN); \
            _Pragma("unroll") for (int j = 0; j < 4; ++j) { const int q = lane + 64 * j; x[j] = x[j] + ((const f32x4*)(mod + 5120))[q] * (y[j] * ry * ((const f32x4*)gp)[q]); __builtin_nontemporal_store(x[j], (f32x4*)xr + q); } \
            if (!last) { const float* mod1 = MOD_ROW(l + 1, m); const float r1 = rsqrtf(ssq16(x) * (1.f / DM) + EPSN); prenorm_store(x, r1, gn, mod1, mod1 + 1024, BA + (size_t)(m) * DM, lane); } } while (0)
        for (int m0 = gw; m0 < Mact; m0 += 4 * NGW) { f32x4 yb[4][4], xb[4][4];
#pragma unroll
            for (int i = 0; i < 4; ++i) { const int mi = m0 + i * NGW, mc = mi < Mact ? mi : m0; LOADY(mc, yb[i], 16); load16(XS_ROW(mc), lane, xb[i]); }
#pragma unroll
            for (int i = 0; i < 4; ++i) { const int mi = m0 + i * NGW; if (mi < Mact) R4_ROW(mi, yb[i], xb[i]); } } }
        if (!last) GBAR();
    }
}

extern "C" void kernel_launch(void* const* d_in, const int* in_sizes, int n_in, void* d_out, int out_size, void* d_ws, size_t ws_size, hipStream_t stream) {
    static int grid_blocks = 0;
    if (grid_blocks == 0) {
        if (n_in != 24 || out_size != NLAT * DM || ws_size < WS_END) { fprintf(stderr, "kernel_launch: unexpected shapes n_in %d out %d ws %zu\n", n_in, out_size, ws_size); grid_blocks = -1; return; }
        int dev = 0, cus = 0, per_cu = 0;
        hipGetDevice(&dev); hipDeviceGetAttribute(&cus, hipDeviceAttributeMultiprocessorCount, dev);
        if (hipFuncSetAttribute((const void*)fwd_megakernel, hipFuncAttributeMaxDynamicSharedMemorySize, LDS_BYTES) != hipSuccess) { fprintf(stderr, "kernel_launch: hipFuncSetAttribute failed\n"); grid_blocks = -1; return; }
        if (hipOccupancyMaxActiveBlocksPerMultiprocessor(&per_cu, (const void*)fwd_megakernel, 512, LDS_BYTES) != hipSuccess || per_cu < 1) { fprintf(stderr, "kernel_launch: occupancy query says %d\n", per_cu); per_cu = 1; (void)hipGetLastError(); }
        grid_blocks = cus * per_cu;
    }
    if (grid_blocks < 0) return;
    Params p{};
    for (int i = 0; i < 24; ++i) p.in[i] = (const float*)d_in[i];
    p.out = (float*)d_out; p.ws = (unsigned char*)d_ws;
    void* args[] = {&p};
    hipError_t e = hipLaunchCooperativeKernel((const void*)fwd_megakernel, dim3(grid_blocks), dim3(512), args, LDS_BYTES, stream);
    if (e != hipSuccess) fprintf(stderr, "cooperative launch failed: %s (grid %d)\n", hipGetErrorString(e), grid_blocks);
}
```

```cpp
#include <hip/hip_runtime.h>
#include <hip/hip_cooperative_groups.h>
#include <cstdio>
#include <cstdint>
namespace cg = cooperative_groups;
namespace pg8 {
#define PG8_LAS __attribute__((address_space(3)))
typedef unsigned short bf16_t;
typedef short bf16x8 __attribute__((ext_vector_type(8)));
typedef float f32x4 __attribute__((ext_vector_type(4)));
typedef unsigned u32x4 __attribute__((ext_vector_type(4)));
constexpr int BM = 256, BK = 64, HALF = 128, HTB = HALF * BK * 2  , STAGE_BYTES = 8 * HTB, NXCD = 8, WGM = 8;

__host__ __device__ __forceinline__ int lds_byte(int r, int c) { const int st = (r >> 4) * 2 + (c >> 5), rr = r & 15, cc = c & 31, ob = rr * 64 + cc * 2; return st * 1024 + (ob ^ (((ob >> 9) & 1) << 5)); }
__host__ __device__ __forceinline__ void stage_rc(int b, int& R, int& C) { const int st = b / 1024, sb = b % 1024, swz = sb ^ (((sb >> 9) & 1) << 5); R = (st >> 1) * 16 + swz / 64; C = (st & 1) * 32 + (swz % 64) / 2; }
__host__ __device__ __forceinline__ int perm32(int rho) { const int n = rho >> 4, i = rho & 15; return 8 * (i >> 2) + 4 * n + (i & 3); }

struct Unit { int pm, pn, kq; };
struct Gemm { const bf16_t* A; const bf16_t* Bt; int M, N, K, ld; };

struct StaticOrder {
    int nM, nN, nwg, G, c; bool rev = false;
    __host__ __device__ void init(int M, int N, int G_, int c_) { nM = M / BM; nN = N / BM; nwg = nM * nN; G = G_; c = c_; }
    __host__ __device__ bool next(int i, Unit& u) const {
        const long L = (long)i * G + c; if (L >= nwg) return false;
        int wgid = (int)L; { const int q = nwg / NXCD, r = nwg % NXCD, xcd = wgid % NXCD, off = wgid / NXCD; wgid = (xcd < r ? xcd * (q + 1) : r * (q + 1) + (xcd - r) * q) + off; }
        const int nig = WGM * nN, gid = wgid / nig, fm = gid * WGM, gsz = (nM - fm) < WGM ? (nM - fm) : WGM;
        u.pm = fm + ((wgid % nig) % gsz); u.pn = (wgid % nig) / gsz; u.kq = 0; if (rev) u.pm = nM - 1 - u.pm; return true;
    }
    __device__ __forceinline__ void a_ready(const Unit&) const {}
    __device__ __forceinline__ void done(const Unit&) const {}
};
struct SplitOrder {
    int nN, nsplit, mt0, total, G, c;
    __host__ __device__ void init(int nMt, int nN_, int nsplit_, int mt0_, int G_, int c_) { nN = nN_; nsplit = nsplit_; mt0 = mt0_; total = nMt * nN_ * nsplit_; G = G_; c = c_; }
    __host__ __device__ bool next(int i, Unit& u) const { const int L = i * G + c; if (L >= total) return false; u.kq = L % nsplit; const int t = L / nsplit; u.pn = t % nN; u.pm = mt0 + t / nN; return true; }
    __device__ __forceinline__ void a_ready(const Unit&) const {}
    __device__ __forceinline__ void done(const Unit&) const {}
};

__device__ __forceinline__ unsigned cvt_pk_bf16(float lo, float hi) { unsigned r; asm volatile("v_cvt_pk_bf16_f32 %0, %1, %2" : "=v"(r) : "v"(lo), "v"(hi)); return r; }
typedef float f32x2 __attribute__((ext_vector_type(2)));
template <int ACT> struct EpiBf16 {
    static constexpr bool PERM = true, AFTER_DRAIN = false;
    bf16_t* O; int ldc;
    __device__ __forceinline__ void operator()(const f32x4 (&acc)[2][2][4][2], const Unit& u, int wr, int wc, int fr, int fq) const {
        const int row0 = u.pm * BM + wr * 64 + fr; const int col0 = u.pn * BM + wc * 32 + 8 * fq;
#pragma unroll
        for (int ai = 0; ai < 2; ++ai)
#pragma unroll
            for (int m = 0; m < 4; ++m) { bf16_t* rowp = O + (size_t)(row0 + ai * HALF + m * 16) * ldc + col0;
#pragma unroll
                for (int bj = 0; bj < 2; ++bj) { f32x4 v0 = acc[ai][bj][m][0], v1 = acc[ai][bj][m][1];
                    if (ACT == 2) {
#pragma unroll
                        for (int e = 0; e < 4; ++e) { float a = fmaxf(v0[e], 0.f), b = fmaxf(v1[e], 0.f); v0[e] = a * a; v1[e] = b * b; } }
                    u32x4 w; w.x = cvt_pk_bf16(v0[0], v0[1]); w.y = cvt_pk_bf16(v0[2], v0[3]); w.z = cvt_pk_bf16(v1[0], v1[1]); w.w = cvt_pk_bf16(v1[2], v1[3]);
                    *(u32x4*)(rowp + bj * HALF) = w; } }
    }
};
struct EpiF32Part {
    static constexpr bool PERM = true, AFTER_DRAIN = false;
    float* P; int ldc; int mt0; size_t slice;
    __device__ __forceinline__ void operator()(const f32x4 (&acc)[2][2][4][2], const Unit& u, int wr, int wc, int fr, int fq) const {
        const int row0 = (u.pm - mt0) * BM + wr * 64 + fr; const int col0 = u.pn * BM + wc * 32 + 8 * fq; float* base = P + (size_t)u.kq * slice;
#pragma unroll
        for (int ai = 0; ai < 2; ++ai)
#pragma unroll
            for (int m = 0; m < 4; ++m) { float* rowp = base + (size_t)(row0 + ai * HALF + m * 16) * ldc + col0;
#pragma unroll
                for (int bj = 0; bj < 2; ++bj) { *(f32x4*)(rowp + bj * HALF) = acc[ai][bj][m][0]; *(f32x4*)(rowp + bj * HALF + 4) = acc[ai][bj][m][1]; } }
    }
};
template <class Epi, class Sched, bool ALIGN_EPI = false, bool SP2 = false>
__device__ __forceinline__ void gemm_phase(PG8_LAS unsigned char* lds, const Gemm g, const Sched& S, const Epi& E, int wave_s) {
    int tid = wave_s * 64 + (int)__builtin_amdgcn_mbcnt_hi(~0u, __builtin_amdgcn_mbcnt_lo(~0u, 0u)); asm volatile("" : "+v"(tid));
    const int wid = __builtin_amdgcn_readfirstlane(tid >> 6), lane = tid & 63, wr = wid >> 2, wc = wid & 3, fr = lane & 15, fq = lane >> 4;
    const int K = g.K, LD = g.ld, nt = K / BK;
    unsigned voffA[2], voffB[2];
#pragma unroll
    for (int i = 0; i < 2; ++i) { int R, C; stage_rc(tid * 16 + i * 8192, R, C); const int Rb = Epi::PERM ? ((R & ~31) + perm32(R & 31)) : R;
        voffA[i] = (unsigned)(R * LD + C) * 2u; voffB[i] = (unsigned)(Rb * LD + C) * 2u; }
    const size_t kstep = (size_t)(BK * 2);
    const size_t hstep = (size_t)HALF * LD * 2;
    const size_t tstep = 2 * hstep;
    const unsigned ldsw = (unsigned)wid * 1024u;
    const int aoff = lds_byte(wr * 64 + fr, fq * 8), boff = lds_byte(wc * 32 + fr, fq * 8);
#define PG8_SA(b, h) (((b) * 2 + (h)) * HTB)
#define PG8_SB(b, h) ((4 + (b) * 2 + (h)) * HTB)
#define PG8_STAGE(bufoff, gbase, voff) do { _Pragma("unroll") for (int _i = 0; _i < 2; ++_i) \
        __builtin_amdgcn_global_load_lds((const unsigned*)((const char*)(gbase) + (voff)[_i]), (PG8_LAS unsigned*)(lds + (bufoff) + ldsw + _i * 8192), 16, 0, 0); } while (0)
#define PG8_LDA(dst, b, h) do { _Pragma("unroll") for (int m = 0; m < 4; ++m) _Pragma("unroll") for (int k = 0; k < 2; ++k) dst[m][k] = *(const PG8_LAS bf16x8*)(lds + PG8_SA(b, h) + aoff + m * 2048 + k * 1024); } while (0)
#define PG8_LDB(dst, b, h) do { _Pragma("unroll") for (int n = 0; n < 2; ++n) _Pragma("unroll") for (int k = 0; k < 2; ++k) dst[n][k] = *(const PG8_LAS bf16x8*)(lds + PG8_SB(b, h) + boff + n * 2048 + k * 1024); } while (0)
#define PG8_MMA(ai, bj, At, Bt) do { __builtin_amdgcn_s_setprio(1); _Pragma("unroll") for (int m = 0; m < 4; ++m) _Pragma("unroll") for (int n = 0; n < 2; ++n) _Pragma("unroll") for (int k = 0; k < 2; ++k) \
        acc[ai][bj][m][n] = __builtin_amdgcn_mfma_f32_16x16x32_bf16(Bt[n][k], At[m][k], acc[ai][bj][m][n], 0, 0, 0); __builtin_amdgcn_s_setprio(0); } while (0)
#define PG8_WAIT_V(n) asm volatile("s_waitcnt vmcnt(" #n ")" ::: "memory")
#define PG8_WAIT_L(n) asm volatile("s_waitcnt lgkmcnt(" #n ")" ::: "memory")
#define PG8_BAR __builtin_amdgcn_s_barrier()
#define PG8_SCHED __builtin_amdgcn_sched_barrier(0)
    Unit cur, nxt; int ui = 0;
    if (!S.next(0, cur)) return;
    f32x4 acc[2][2][4][2];
#pragma unroll
    for (int a = 0; a < 2; ++a)
#pragma unroll
        for (int b = 0; b < 2; ++b)
#pragma unroll
            for (int m = 0; m < 4; ++m)
#pragma unroll
                for (int n = 0; n < 2; ++n) acc[a][b][m][n] = (f32x4){0.f, 0.f, 0.f, 0.f};
    bf16x8 At[4][2], B0[2][2], B1[2][2];
    const size_t kqstep = (size_t)K * 2;
    const char* cA = (const char*)g.A + (size_t)cur.pm * tstep + (size_t)cur.kq * kqstep; const char* cB = (const char*)g.Bt + (size_t)cur.pn * tstep + (size_t)cur.kq * kqstep;
    S.a_ready(cur);
    if constexpr (SP2) {
        PG8_STAGE(PG8_SB(0, 0), cB, voffB); PG8_STAGE(PG8_SB(0, 1), cB + hstep, voffB); PG8_STAGE(PG8_SA(0, 0), cA, voffA); PG8_STAGE(PG8_SA(0, 1), cA + hstep, voffA);
        if (wr == 1) PG8_BAR;
        PG8_WAIT_V(2); PG8_BAR;
        PG8_STAGE(PG8_SB(1, 0), cB + kstep, voffB); PG8_STAGE(PG8_SA(1, 0), cA + kstep, voffA); PG8_STAGE(PG8_SB(1, 1), cB + hstep + kstep, voffB);
        PG8_WAIT_V(6); PG8_BAR;
    } else {
        PG8_STAGE(PG8_SB(0, 0), cB, voffB); PG8_STAGE(PG8_SA(0, 0), cA, voffA); PG8_STAGE(PG8_SB(0, 1), cB + hstep, voffB); PG8_STAGE(PG8_SA(0, 1), cA + hstep, voffA);
        if (wr == 1) PG8_BAR;
        PG8_WAIT_V(4); PG8_BAR;
        PG8_STAGE(PG8_SB(1, 0), cB + kstep, voffB); PG8_STAGE(PG8_SA(1, 0), cA + kstep, voffA); PG8_STAGE(PG8_SB(1, 1), cB + hstep + kstep, voffB);
        PG8_WAIT_V(6); PG8_BAR;
    }
    for (;;) {
        const bool has_next = S.next(ui + 1, nxt);
        const char* nA = has_next ? (const char*)g.A + (size_t)nxt.pm * tstep + (size_t)nxt.kq * kqstep : cA; const char* nB = has_next ? (const char*)g.Bt + (size_t)nxt.pn * tstep + (size_t)nxt.kq * kqstep : cB;
        for (int t = 0; t < nt; t += 2) {
            const bool last = (t == nt - 2);
            const char* a1 = cA + (size_t)(t + 1) * kstep;
            const char* a2 = last ? nA : cA + (size_t)(t + 2) * kstep; const char* b2 = last ? nB : cB + (size_t)(t + 2) * kstep;
            const char* a3 = a2 + kstep; const char* b3 = b2 + kstep;
            if (last && has_next) S.a_ready(nxt);
            if constexpr (SP2) {
            PG8_LDB(B0, 0, 0); PG8_LDB(B1, 0, 1); PG8_SCHED; PG8_LDA(At, 0, 0); PG8_STAGE(PG8_SA(1, 1), a1 + hstep, voffA);
            PG8_WAIT_V(8); PG8_WAIT_L(0); PG8_BAR; PG8_MMA(0, 0, At, B0); PG8_MMA(0, 1, At, B1); PG8_BAR; PG8_SCHED;
            PG8_LDA(At, 0, 1); PG8_STAGE(PG8_SB(0, 0), b2, voffB); PG8_STAGE(PG8_SB(0, 1), b2 + hstep, voffB); PG8_STAGE(PG8_SA(0, 0), a2, voffA);
            PG8_WAIT_V(8); PG8_WAIT_L(0); PG8_BAR; PG8_MMA(1, 0, At, B0); PG8_MMA(1, 1, At, B1); PG8_BAR; PG8_SCHED;
            PG8_LDB(B0, 1, 0); PG8_LDB(B1, 1, 1); PG8_SCHED; PG8_LDA(At, 1, 0); PG8_STAGE(PG8_SA(0, 1), a2 + hstep, voffA);
            PG8_WAIT_V(8); PG8_WAIT_L(0); PG8_BAR; PG8_MMA(0, 0, At, B0); PG8_MMA(0, 1, At, B1); PG8_BAR; PG8_SCHED;
            PG8_LDA(At, 1, 1); PG8_STAGE(PG8_SB(1, 0), b3, voffB); PG8_STAGE(PG8_SB(1, 1), b3 + hstep, voffB); PG8_STAGE(PG8_SA(1, 0), a3, voffA);
            PG8_WAIT_V(8); PG8_WAIT_L(0); PG8_BAR; PG8_MMA(1, 0, At, B0); PG8_MMA(1, 1, At, B1); PG8_BAR; PG8_SCHED;
            } else {
            PG8_LDB(B0, 0, 0); PG8_SCHED; PG8_LDA(At, 0, 0); PG8_STAGE(PG8_SA(1, 1), a1 + hstep, voffA);
            PG8_WAIT_L(8); PG8_BAR; PG8_WAIT_L(0); PG8_MMA(0, 0, At, B0); PG8_BAR; PG8_SCHED;
            PG8_LDB(B1, 0, 1); PG8_STAGE(PG8_SB(0, 0), b2, voffB);
            PG8_BAR; PG8_WAIT_L(0); PG8_MMA(0, 1, At, B1); PG8_BAR;
            PG8_LDA(At, 0, 1); PG8_STAGE(PG8_SA(0, 0), a2, voffA);
            PG8_BAR; PG8_WAIT_L(0); PG8_MMA(1, 0, At, B0); PG8_BAR; PG8_SCHED;
            PG8_STAGE(PG8_SB(0, 1), b2 + hstep, voffB);
            PG8_WAIT_V(6); PG8_BAR; PG8_MMA(1, 1, At, B1); PG8_BAR;
            PG8_LDB(B0, 1, 0); PG8_SCHED; PG8_LDA(At, 1, 0); PG8_STAGE(PG8_SA(0, 1), a2 + hstep, voffA);
            PG8_WAIT_L(8); PG8_BAR; PG8_WAIT_L(0); PG8_MMA(0, 0, At, B0); PG8_BAR; PG8_SCHED;
            PG8_LDB(B1, 1, 1); PG8_STAGE(PG8_SB(1, 0), b3, voffB);
            PG8_BAR; PG8_WAIT_L(0); PG8_MMA(0, 1, At, B1); PG8_BAR;
            PG8_LDA(At, 1, 1); PG8_STAGE(PG8_SA(1, 0), a3, voffA);
            PG8_BAR; PG8_WAIT_L(0); PG8_MMA(1, 0, At, B0); PG8_BAR; PG8_SCHED;
            PG8_STAGE(PG8_SB(1, 1), b3 + hstep, voffB);
            PG8_WAIT_V(6); PG8_BAR; PG8_MMA(1, 1, At, B1); PG8_BAR;
            }
        }
        if constexpr (ALIGN_EPI) { if (wr == 0) PG8_BAR; }
        if constexpr (!Epi::AFTER_DRAIN) { E(acc, cur, wr, wc, fr, fq); S.done(cur); }
        if (!has_next) break;
#pragma unroll
        for (int a = 0; a < 2; ++a)
#pragma unroll
            for (int b = 0; b < 2; ++b)
#pragma unroll
                for (int m = 0; m < 4; ++m)
#pragma unroll
                    for (int n = 0; n < 2; ++n) acc[a][b][m][n] = (f32x4){0.f, 0.f, 0.f, 0.f};
        cur = nxt; cA = nA; cB = nB; ++ui;
        if constexpr (ALIGN_EPI) { if (wr == 1) PG8_BAR; }
    }
    PG8_WAIT_V(0);
    if constexpr (!ALIGN_EPI) { if (wr == 0) PG8_BAR; }
    PG8_BAR;
    if constexpr (Epi::AFTER_DRAIN) { E.fused(acc, cur, wr, wc, fr, fq, lds, wid, lane); S.done(cur); }
#undef PG8_SA
#undef PG8_SB
#undef PG8_STAGE
#undef PG8_LDA
#undef PG8_LDB
#undef PG8_MMA
#undef PG8_WAIT_V
#undef PG8_WAIT_L
#undef PG8_BAR
#undef PG8_SCHED
}
}

#define LAS __attribute__((address_space(3)))
typedef unsigned short bf16_t;
typedef short bf16x8 __attribute__((ext_vector_type(8)));
typedef short s16x4 __attribute__((ext_vector_type(4)));
typedef float f32x4 __attribute__((ext_vector_type(4)));
typedef float f32x16 __attribute__((ext_vector_type(16)));
typedef unsigned u32x2 __attribute__((ext_vector_type(2)));
typedef unsigned u32x4 __attribute__((ext_vector_type(4)));
__device__ __forceinline__ unsigned cvtpk(float lo, float hi) { unsigned r; asm volatile("v_cvt_pk_bf16_f32 %0, %1, %2" : "=v"(r) : "v"(lo), "v"(hi)); return r; }
__device__ __forceinline__ float bflo(unsigned w) { return __uint_as_float(w << 16); }
__device__ __forceinline__ float bfhi(unsigned w) { return __uint_as_float(w & 0xffff0000u); }
__device__ __forceinline__ float bf2f(unsigned short h) { return __uint_as_float((unsigned)h << 16); }
__device__ __forceinline__ unsigned short f2bf(float f) { unsigned u = __float_as_uint(f); return (unsigned short)((u + 0x7fffu + ((u >> 16) & 1u)) >> 16); }
__device__ __forceinline__ int lane_id() { return (int)__builtin_amdgcn_mbcnt_hi(~0u, __builtin_amdgcn_mbcnt_lo(~0u, 0u)); }
template <int X> __device__ __forceinline__ float swz_xor(float v) { return __int_as_float(__builtin_amdgcn_ds_swizzle(__float_as_int(v), (X << 10) | 0x1f)); }
template <int CTRL, int ROWMASK> __device__ __forceinline__ float dpp_f(float v) { return __int_as_float(__builtin_amdgcn_update_dpp(0, __float_as_int(v), CTRL, ROWMASK, 0xF, false)); }
__device__ __forceinline__ float wave_sum(float v) {
    v += dpp_f<0xB1, 0xF>(v);
    v += dpp_f<0x4E, 0xF>(v);
    v += dpp_f<0x141, 0xF>(v);
    v += dpp_f<0x140, 0xF>(v);
    v += dpp_f<0x142, 0xA>(v);
    v += dpp_f<0x143, 0xC>(v);
    return __builtin_amdgcn_readlane(v, 63);
}
__device__ __forceinline__ float sigmoidf_(float x) { return __builtin_amdgcn_rcpf(1.f + __expf(-x)); }
__device__ __forceinline__ float rope_inv(int i) { return exp2f(-1.6609640474436813f * (float)i); }

namespace att {
constexpr int NW = 8, QBLK = 32, KVBLK = 64;
constexpr float SCALE = 0.10206207261596575f;
constexpr float THR = 8.f;
constexpr int BUFB = 16384;
constexpr int NRING = 3, OFF_V = 0, OFF_K = NRING * BUFB, OFF_WS = 2 * NRING * BUFB, LDS_BYTES = OFF_WS + NW * 64 * 4;
#define KSWZ(row, colB) ((row) * 256 + ((colB) ^ (((row) & 15) << 4)))
#define SBAR() __builtin_amdgcn_sched_barrier(0)
__device__ __forceinline__ int crow(int r, int hi) { return (r & 3) + 8 * (r >> 2) + 4 * hi; }
constexpr float C2 = SCALE * 1.4426950408889634f;
constexpr float THR2 = THR * 1.4426950408889634f;
#define MX3(a, b, c) __builtin_fmaxf(__builtin_fmaxf((a), (b)), (c))
__device__ __forceinline__ void softmaxT(f32x16& p0, f32x16& p1, float& mref, f32x16& negm, float& l_reg, float& alpha, bf16x8& pa0, bf16x8& pa1, bf16x8& pa2, bf16x8& pa3) {
  float a = MX3(p0[0], p0[1], p1[0]), b = MX3(p0[2], p0[3], p1[1]); a = MX3(a, p1[2], p1[3]);
#pragma unroll
  for (int r = 4; r < 16; r += 4) { a = MX3(a, p0[r], p0[r + 1]); b = MX3(b, p0[r + 2], p0[r + 3]); a = MX3(a, p1[r], p1[r + 1]); b = MX3(b, p1[r + 2], p1[r + 3]); }
  float pmax = __builtin_fmaxf(a, b);
  { auto rr = __builtin_amdgcn_permlane32_swap(__float_as_uint(pmax), __float_as_uint(pmax), false, false);
    pmax = __builtin_fmaxf(__uint_as_float(rr[0]), __uint_as_float(rr[1])); }
  if (__builtin_expect(__all(pmax <= THR2), 1)) { alpha = 1.f; }
  else { const float dl = __builtin_fmaxf(pmax, 0.f); mref += dl; alpha = __builtin_amdgcn_exp2f(-dl); l_reg *= alpha;
#pragma unroll
    for (int r = 0; r < 16; ++r) { p0[r] -= dl; p1[r] -= dl; negm[r] = -mref; }
    asm volatile("" : "+v"(negm)); }
#pragma unroll
  for (int r = 0; r < 16; ++r) { p0[r] = __builtin_amdgcn_exp2f(p0[r]); p1[r] = __builtin_amdgcn_exp2f(p1[r]); }
  { float s0 = p0[0] + p1[0], s1 = p0[1] + p1[1], s2 = p0[2] + p1[2], s3 = p0[3] + p1[3];
#pragma unroll
    for (int r = 4; r < 16; r += 4) { s0 += p0[r] + p1[r]; s1 += p0[r + 1] + p1[r + 1]; s2 += p0[r + 2] + p1[r + 2]; s3 += p0[r + 3] + p1[r + 3]; }
    l_reg += (s0 + s1) + (s2 + s3); }
#define PK4(P, BASE, OUT) do { unsigned a0 = cvtpk(P[BASE + 0], P[BASE + 1]), a1 = cvtpk(P[BASE + 2], P[BASE + 3]);   \
    unsigned b0 = cvtpk(P[BASE + 4], P[BASE + 5]), b1 = cvtpk(P[BASE + 6], P[BASE + 7]);                              \
    auto r0 = __builtin_amdgcn_permlane32_swap(a0, b0, false, false); auto r1 = __builtin_amdgcn_permlane32_swap(a1, b1, false, false); \
    u32x4 w = {r0[0], r1[0], r0[1], r1[1]}; OUT = __builtin_bit_cast(bf16x8, w); } while (0)
  PK4(p0, 0, pa0); PK4(p0, 8, pa1); PK4(p1, 0, pa2); PK4(p1, 8, pa3);
#undef PK4
}
__device__ __forceinline__ void partialSM(f32x16& p0, f32x16& p1, float& mref, f32x16& negm, float& alpha) {
  float a = MX3(p0[0], p0[1], p1[0]), b = MX3(p0[2], p0[3], p1[1]); a = MX3(a, p1[2], p1[3]);
#pragma unroll
  for (int r = 4; r < 16; r += 4) { a = MX3(a, p0[r], p0[r + 1]); b = MX3(b, p0[r + 2], p0[r + 3]); a = MX3(a, p1[r], p1[r + 1]); b = MX3(b, p1[r + 2], p1[r + 3]); }
  float pmax = __builtin_fmaxf(a, b);
  { auto rr = __builtin_amdgcn_permlane32_swap(__float_as_uint(pmax), __float_as_uint(pmax), false, false);
    pmax = __builtin_fmaxf(__uint_as_float(rr[0]), __uint_as_float(rr[1])); }
  if (__builtin_expect(__all(pmax <= THR2), 1)) { alpha = 1.f; }
  else { const float dl = __builtin_fmaxf(pmax, 0.f); mref += dl; alpha = __builtin_amdgcn_exp2f(-dl);
#pragma unroll
    for (int r = 0; r < 16; ++r) { p0[r] -= dl; p1[r] -= dl; negm[r] = -mref; }
    asm volatile("" : "+v"(negm)); }
#pragma unroll
  for (int r = 0; r < 16; ++r) p0[r] = __builtin_amdgcn_exp2f(p0[r]);
}
__device__ __forceinline__ void finishSM(f32x16& p0, f32x16& p1, float& l_reg, bf16x8& pa0, bf16x8& pa1, bf16x8& pa2, bf16x8& pa3) {
#pragma unroll
  for (int r = 0; r < 16; ++r) p1[r] = __builtin_amdgcn_exp2f(p1[r]);
  { float s0 = p0[0] + p1[0], s1 = p0[1] + p1[1], s2 = p0[2] + p1[2], s3 = p0[3] + p1[3];
#pragma unroll
    for (int r = 4; r < 16; r += 4) { s0 += p0[r] + p1[r]; s1 += p0[r + 1] + p1[r + 1]; s2 += p0[r + 2] + p1[r + 2]; s3 += p0[r + 3] + p1[r + 3]; }
    l_reg += (s0 + s1) + (s2 + s3); }
#define PK4(P, BASE, OUT) do { unsigned a0 = cvtpk(P[BASE + 0], P[BASE + 1]), a1 = cvtpk(P[BASE + 2], P[BASE + 3]);   \
    unsigned b0 = cvtpk(P[BASE + 4], P[BASE + 5]), b1 = cvtpk(P[BASE + 6], P[BASE + 7]);                              \
    auto r0 = __builtin_amdgcn_permlane32_swap(a0, b0, false, false); auto r1 = __builtin_amdgcn_permlane32_swap(a1, b1, false, false); \
    u32x4 w = {r0[0], r1[0], r0[1], r1[1]}; OUT = __builtin_bit_cast(bf16x8, w); } while (0)
  PK4(p0, 0, pa0); PK4(p0, 8, pa1); PK4(p1, 0, pa2); PK4(p1, 8, pa3);
#undef PK4
}
__device__ __forceinline__ void qkt(f32x16& p0, f32x16& p1, const LAS unsigned char* Ks, const bf16x8* qr, const f32x16& negm, int r32, int hi) {
  bf16x8 kf[12];
#pragma unroll
  for (int d0 = 0; d0 < 6; ++d0) { const int cb = (d0 * 16 + hi * 8) * 2;
    kf[2 * d0] = *(const LAS bf16x8*)(Ks + KSWZ(r32, cb)); kf[2 * d0 + 1] = *(const LAS bf16x8*)(Ks + KSWZ(32 + r32, cb)); }
  SBAR();
  p0 = __builtin_amdgcn_mfma_f32_32x32x16_bf16(kf[0], qr[0], negm, 0, 0, 0); p1 = __builtin_amdgcn_mfma_f32_32x32x16_bf16(kf[1], qr[0], negm, 0, 0, 0);
#pragma unroll
  for (int d0 = 1; d0 < 6; ++d0) { p0 = __builtin_amdgcn_mfma_f32_32x32x16_bf16(kf[2 * d0], qr[d0], p0, 0, 0, 0); p1 = __builtin_amdgcn_mfma_f32_32x32x16_bf16(kf[2 * d0 + 1], qr[d0], p1, 0, 0, 0); }
}
__device__ __forceinline__ int v_st(int k, int c) { const int kk = (k & ~0xC) | ((k & 4) << 1) | ((k & 8) >> 1); return ((kk >> 3) * 4 + (c >> 5)) * 512 + ((kk & 7) * 32 + (c & 31)) * 2; }
__device__ __forceinline__ int v_rd_base(int lane) { return ((lane & 3) << 3) | (((lane >> 2) & 3) << 6) | (((lane >> 4) & 1) << 5) | (((lane >> 5) & 1) << 8); }
constexpr int v_rd_off(int d0, int ks, int half) { return d0 * 512 + ks * 4096 + half * 2048; }
template <int OFF> __device__ __forceinline__ s16x4 tr_read(int vb) {
  s16x4 r; asm volatile("ds_read_b64_tr_b16 %0, %1 offset:%2" : "=&v"(r) : "v"(vb), "i"(OFF) : "memory"); return r;
}
__device__ __forceinline__ void pv_d0(f32x16* o, int vb, bf16x8 pa0, bf16x8 pa1, bf16x8 pa2, bf16x8 pa3) {
  const s16x4 a0 = tr_read<v_rd_off(0, 0, 0)>(vb), b0 = tr_read<v_rd_off(0, 0, 1)>(vb), a1 = tr_read<v_rd_off(0, 1, 0)>(vb), b1 = tr_read<v_rd_off(0, 1, 1)>(vb);
  const s16x4 a2 = tr_read<v_rd_off(0, 2, 0)>(vb), b2 = tr_read<v_rd_off(0, 2, 1)>(vb), a3 = tr_read<v_rd_off(0, 3, 0)>(vb), b3 = tr_read<v_rd_off(0, 3, 1)>(vb);
  const s16x4 c0 = tr_read<v_rd_off(1, 0, 0)>(vb), d0 = tr_read<v_rd_off(1, 0, 1)>(vb), c1 = tr_read<v_rd_off(1, 1, 0)>(vb), d1 = tr_read<v_rd_off(1, 1, 1)>(vb);
  const s16x4 c2 = tr_read<v_rd_off(1, 2, 0)>(vb), d2 = tr_read<v_rd_off(1, 2, 1)>(vb), c3 = tr_read<v_rd_off(1, 3, 0)>(vb), d3 = tr_read<v_rd_off(1, 3, 1)>(vb);
  asm volatile("s_waitcnt lgkmcnt(0)" ::: "memory"); SBAR();
#define PK(L, H) (bf16x8){L[0], L[1], L[2], L[3], H[0], H[1], H[2], H[3]}
  o[0] = __builtin_amdgcn_mfma_f32_32x32x16_bf16(pa0, PK(a0, b0), o[0], 0, 0, 0); o[1] = __builtin_amdgcn_mfma_f32_32x32x16_bf16(pa0, PK(c0, d0), o[1], 0, 0, 0);
  o[0] = __builtin_amdgcn_mfma_f32_32x32x16_bf16(pa1, PK(a1, b1), o[0], 0, 0, 0); o[1] = __builtin_amdgcn_mfma_f32_32x32x16_bf16(pa1, PK(c1, d1), o[1], 0, 0, 0);
  o[0] = __builtin_amdgcn_mfma_f32_32x32x16_bf16(pa2, PK(a2, b2), o[0], 0, 0, 0); o[1] = __builtin_amdgcn_mfma_f32_32x32x16_bf16(pa2, PK(c2, d2), o[1], 0, 0, 0);
  o[0] = __builtin_amdgcn_mfma_f32_32x32x16_bf16(pa3, PK(a3, b3), o[0], 0, 0, 0); o[1] = __builtin_amdgcn_mfma_f32_32x32x16_bf16(pa3, PK(c3, d3), o[1], 0, 0, 0);
#undef PK
}
__device__ __forceinline__ void attn_unit(const bf16_t* __restrict__ Qb, bool rope_q, int tq0, const bf16_t* __restrict__ KVh, const bf16_t* __restrict__ KR,
                                          int ctx_row0, int lat_row0, int NT, bf16_t* __restrict__ Ob, LAS unsigned char* lds, int wave_s) {
  int tid = wave_s * 64 + lane_id(); asm volatile("" : "+v"(tid));
  const int wid = tid >> 6, lane = tid & 63, r32 = lane & 31, hi = lane >> 5;
  LAS float* al_l = (LAS float*)(lds + OFF_WS) + wid * 64;
  float mref = 0.f, l_reg = 0.f; f32x16 o[2] = {}; f32x16 negm = {}; asm volatile("" : "+v"(negm)); bf16x8 qr[6];
  { const bf16_t* Qw = Qb + (long)(wid * QBLK + r32) * 768;
#pragma unroll
    for (int d0 = 0; d0 < 4; ++d0) { const u32x4 w = *(const u32x4*)(Qw + d0 * 16 + hi * 8);
      u32x4 s = {cvtpk(bflo(w.x) * C2, bfhi(w.x) * C2), cvtpk(bflo(w.y) * C2, bfhi(w.y) * C2), cvtpk(bflo(w.z) * C2, bfhi(w.z) * C2), cvtpk(bflo(w.w) * C2, bfhi(w.w) * C2)};
      qr[d0] = __builtin_bit_cast(bf16x8, s); }
    const int t = tq0 + wid * QBLK + r32;
#pragma unroll
    for (int a = 0; a < 2; ++a) {
      const u32x4 lo = *(const u32x4*)(Qw + 64 + a * 16), hh = *(const u32x4*)(Qw + 64 + a * 16 + 8);
      const float pos = (float)(a == 0 ? (t >> 6) : (t & 63)); float ov[8];
#pragma unroll
      for (int i = 0; i < 8; ++i) { const float ang = rope_q ? pos * rope_inv(i) : 0.f, c = __cosf(ang) * C2, s = __sinf(ang) * C2;
        const float l = (i & 1) ? bfhi(lo[i >> 1]) : bflo(lo[i >> 1]), h = (i & 1) ? bfhi(hh[i >> 1]) : bflo(hh[i >> 1]);
        ov[i] = hi ? (h * c + l * s) : (l * c - h * s); }
      u32x4 w = {cvtpk(ov[0], ov[1]), cvtpk(ov[2], ov[3]), cvtpk(ov[4], ov[5]), cvtpk(ov[6], ov[7])}; qr[4 + a] = __builtin_bit_cast(bf16x8, w);
    }
  }
  const int sr = tid >> 4, sc = (tid & 15) * 8, rr = (tid & 255) >> 2, rc = (tid & 3) * 8;
  const int st0 = (sc < 64) ? OFF_K + KSWZ(sr, sc * 2) : OFF_V + v_st(sr, sc - 64);
  const int st1 = (sc < 64) ? OFF_K + KSWZ(32 + sr, sc * 2) : OFF_V + v_st(32 + sr, sc - 64);
  const int st2 = OFF_K + KSWZ(rr, (64 + rc) * 2);
  const int vb0 = (int)(size_t)(lds + OFF_V) + v_rd_base(lane);
  struct { bf16x8 a0, a1, rp; } sg[2];
#define KROW(t) ((t) < 4 ? ctx_row0 + (t) * KVBLK : lat_row0 + ((t) - 4) * KVBLK)
#define SLOAD(i, t) do { const long k0_ = KROW(t); sg[i].a0 = *(const bf16x8*)(KVh + (k0_ + sr) * 1024 + sc); sg[i].a1 = *(const bf16x8*)(KVh + (k0_ + 32 + sr) * 1024 + sc); \
    sg[i].rp = *(const bf16x8*)(KR + (k0_ + rr) * 32 + rc); } while (0)
#define SWRITE_AT(boff, i) do { *(LAS bf16x8*)(lds + (boff) + st0) = sg[i].a0; *(LAS bf16x8*)(lds + (boff) + st1) = sg[i].a1; *(LAS bf16x8*)(lds + (boff) + st2) = sg[i].rp; } while (0)
#define RESC(a) do { if (__any((a) < 1.f)) { if (hi == 0) al_l[r32] = (a); asm volatile("s_waitcnt lgkmcnt(0)" ::: "memory"); \
    _Pragma("unroll") for (int r = 0; r < 16; ++r) { const float f_ = al_l[crow(r, hi)]; o[0][r] *= f_; o[1][r] *= f_; } } } while (0)
  const int trail = (wave_s >= 4) ? 1 : 0;
  const LAS unsigned char* Kb = lds + OFF_K;
  f32x16 p0, p1; float alpha; bf16x8 pa0, pa1, pa2, pa3;
  SLOAD(0, 0); SLOAD(1, 1);
  asm volatile("s_waitcnt vmcnt(3)" ::: "memory"); SWRITE_AT(0, 0);
  if (trail) { asm volatile("s_waitcnt vmcnt(0)" ::: "memory"); SWRITE_AT(BUFB, 1); SLOAD(1, 2); SLOAD(0, 3); }
  else { SLOAD(0, 2); }
  __syncthreads();
  if (trail) __syncthreads();
  int bV = 0, bK = 0, bN = BUFB, bNN = 2 * BUFB;
#define PHASE_M(j) do { SBAR(); __builtin_amdgcn_s_setprio(2); if ((j) > 0) pv_d0(o, vb0 + bV, pa0, pa1, pa2, pa3); qkt(p0, p1, Kb + bK, qr, negm, r32, hi); __builtin_amdgcn_s_setprio(0); SBAR(); __syncthreads(); } while (0)
#define PHASE_V(j, slot) do { softmaxT(p0, p1, mref, negm, l_reg, alpha, pa0, pa1, pa2, pa3); RESC(alpha); \
    { const int s_ = (j) + 1 + trail; if (s_ < NT) { asm volatile("s_waitcnt vmcnt(3)" ::: "memory"); SWRITE_AT(trail ? bNN : bN, slot); const int s2_ = s_ + 2; SLOAD(slot, s2_ < NT ? s2_ : NT - 1); } } \
    __syncthreads(); bV = bK; bK = bN; bN = bNN; bNN = bV; } while (0)
  for (int j = 0; j < NT; j += 2) {
    PHASE_M(j); PHASE_V(j, 1);
    PHASE_M(j + 1); PHASE_V(j + 1, 0);
  }
  SBAR(); pv_d0(o, vb0 + bV, pa0, pa1, pa2, pa3);
  if (!trail) __syncthreads();
#undef PHASE_M
#undef PHASE_V
  { auto rr_ = __builtin_amdgcn_permlane32_swap(__float_as_uint(l_reg), __float_as_uint(l_reg), false, false); l_reg = __uint_as_float(rr_[0]) + __uint_as_float(rr_[1]); }
  if (hi == 0) al_l[32 + r32] = l_reg; asm volatile("s_waitcnt lgkmcnt(0)" ::: "memory");
  float rli[16];
#pragma unroll
  for (int r = 0; r < 16; ++r) rli[r] = __builtin_amdgcn_rcpf(al_l[32 + crow(r, hi)]);
  bf16_t* Ow = Ob + (long)(wid * QBLK) * 1024;
#pragma unroll
  for (int r = 0; r < 16; ++r) { const int orow = crow(r, hi);
#pragma unroll
    for (int d0 = 0; d0 < 2; ++d0) Ow[(long)orow * 1024 + d0 * 32 + r32] = f2bf(o[d0][r] * rli[r]); }
  __syncthreads();
#undef KROW
#undef SLOAD
#undef SWRITE_AT
#undef RESC
}
}

constexpr int NLAT = 32768, NCTX = 1024, MTOT = 33792, DM = 1024, ZW = 1792, INW = 1696, SEQL = 8192, CTXL = 256, DFF = 4096;
constexpr float EPSN = 1e-6f;
constexpr size_t MiB = 1u << 20;
constexpr size_t WS_MOD = 1 * MiB;
constexpr size_t WS_W = 2 * MiB, W_LAYER = 23 * MiB;
constexpr size_t W_IN = 0, W_Q = 3584 * 1024, W_KV = 4 * MiB, W_O = 4608 * 1024, W_UP = 7 * MiB, W_DN = 15 * MiB;
constexpr size_t WS_A = 48 * MiB;
constexpr size_t WS_B = 114 * MiB;
constexpr size_t WS_Z = WS_B, WS_Q = WS_B + 116 * MiB, WS_KV = WS_B + 166 * MiB, WS_QN = WS_B + 232 * MiB, WS_KVN = WS_B + 249 * MiB, WS_KR = WS_B + 258 * MiB;
constexpr size_t WS_D = 378 * MiB;
constexpr size_t WS_XSC = 444 * MiB;
constexpr size_t WS_PART = 448 * MiB;
constexpr size_t WS_END = 512 * MiB;
static_assert((size_t)MTOT * ZW * 2 <= 116 * MiB && (size_t)MTOT * 768 * 2 <= 50 * MiB && (size_t)MTOT * 1024 * 2 <= 66 * MiB && (size_t)MTOT * 256 * 2 <= 17 * MiB && (size_t)MTOT * 128 * 2 <= 9 * MiB && WS_KR + (size_t)MTOT * 64 <= WS_B + 264 * MiB, "ws map");
constexpr int LDS_BYTES = 147456;

struct Params { const float* in[24]; float* out; unsigned char* ws; };
enum { I_X = 0, I_C, I_CTX, I_CCTX, I_WMOD, I_BMOD, I_GPREMIX, I_GPOSTMIX, I_GPREMLP, I_GPOSTMLP, I_WIN, I_GQ, I_WQB, I_GKV, I_WKVB, I_CDWW, I_CDWB, I_CLNG, I_CLNB, I_SDWW, I_GBR, I_WO, I_WUP, I_WDN };

__device__ __forceinline__ void transpose_item(const float* __restrict__ W, int K, int N, bf16_t* __restrict__ WT, LAS float* scr, int item, int lane) {
    const int nblk = N / 32, kb = item / nblk, nb = item % nblk, k0 = 64 * kb, n0 = 32 * nb;
#pragma unroll 8
    for (int i = 0; i < 32; ++i) { const int kk = 2 * i + (lane >> 5); scr[kk * 33 + (lane & 31)] = W[(size_t)(k0 + kk) * N + n0 + (lane & 31)]; }
    asm volatile("s_waitcnt lgkmcnt(0)" ::: "memory");
    const int c = lane & 7;
#pragma unroll
    for (int j = 0; j < 4; ++j) { const int n = (lane >> 3) + 8 * j; const LAS float* s = scr + (8 * c) * 33 + n;
        u32x4 o; o.x = cvtpk(s[0 * 33], s[1 * 33]); o.y = cvtpk(s[2 * 33], s[3 * 33]); o.z = cvtpk(s[4 * 33], s[5 * 33]); o.w = cvtpk(s[6 * 33], s[7 * 33]);
        *(u32x4*)(WT + (size_t)(n0 + n) * K + k0 + 8 * c) = o; }
    asm volatile("s_waitcnt lgkmcnt(0)" ::: "memory");
}
__device__ __forceinline__ void load16(const float* row, int lane, f32x4 (&v)[4]) {
#pragma unroll
    for (int j = 0; j < 4; ++j) v[j] = __builtin_nontemporal_load((const f32x4*)row + lane + 64 * j);
}
__device__ __forceinline__ void load16bf(const bf16_t* row, int lane, f32x4 (&v)[4]) {
#pragma unroll
    for (int j = 0; j < 4; ++j) { const u32x2 w = __builtin_nontemporal_load((const u32x2*)row + lane + 64 * j); v[j] = (f32x4){bflo(w.x), bfhi(w.x), bflo(w.y), bfhi(w.y)}; }
}
template <int NS> __device__ __forceinline__ void load16part(const float* P, int rowrel, int lane, f32x4 (&v)[4]) {
#pragma unroll
    for (int j = 0; j < 4; ++j) v[j] = (f32x4){0.f, 0.f, 0.f, 0.f};
#pragma unroll
    for (int s0 = 0; s0 < NS; s0 += 4) { f32x4 t[4][4];
#pragma unroll
        for (int s = 0; s < 4; ++s) { const f32x4* q = (const f32x4*)(P + ((size_t)(s0 + s) * 1024 + rowrel) * 1024);
#pragma unroll
            for (int j = 0; j < 4; ++j) t[s][j] = q[lane + 64 * j]; }
#pragma unroll
        for (int s = 0; s < 4; ++s)
#pragma unroll
            for (int j = 0; j < 4; ++j) v[j] += t[s][j]; }
}
__device__ __forceinline__ float ssq16(const f32x4 (&v)[4]) {
    float s = 0.f;
#pragma unroll
    for (int j = 0; j < 4; ++j) s += (v[j].x * v[j].x + v[j].y * v[j].y) + (v[j].z * v[j].z + v[j].w * v[j].w);
    return wave_sum(s);
}
__device__ __forceinline__ void prenorm_store(const f32x4 (&v)[4], float rinv, const float* g, const float* shift, const float* scale, bf16_t* orow, int lane) {
#pragma unroll
    for (int j = 0; j < 4; ++j) { const int q = lane + 64 * j; const f32x4 gg = ((const f32x4*)g)[q], sh = ((const f32x4*)shift)[q], sc = ((const f32x4*)scale)[q];
        const f32x4 h = (v[j] * rinv * gg) * (sc + 1.0f) + sh; u32x2 w; w.x = cvtpk(h.x, h.y); w.y = cvtpk(h.z, h.w); ((u32x2*)orow)[q] = w; }
}

#define XB_TMO      128
#define XB_XCNT(j)  (256  + 64 * (j))
#define XB_XSUB(j)  (1280 + 64 * (j))
#define XB_XGEN(j)  (2304 + 64 * (j))
#define XB_TOP      3328
#define XB_TOPGEN   3392
#define XCD_BAR_WORDS 3456
#define XB_SPIN_CAP (1u << 18)

__device__ __forceinline__ unsigned xb_ld(unsigned* p)              { return __hip_atomic_load(p, __ATOMIC_RELAXED, __HIP_MEMORY_SCOPE_AGENT); }
__device__ __forceinline__ unsigned xb_add(unsigned* p, unsigned v) { return __hip_atomic_fetch_add(p, v, __ATOMIC_RELAXED, __HIP_MEMORY_SCOPE_AGENT); }
__device__ __forceinline__ unsigned xb_xcc_id() { return (unsigned)__builtin_amdgcn_s_getreg((3 << 11) | 20) & 0xFu; }
#define XB_SPIN(cond, bar) do { unsigned _sp = 0; while (cond) { __builtin_amdgcn_s_sleep(1); \
    if ((++_sp & 255u) == 0u) { if (xb_ld(&(bar)[XB_TMO])) break; if (_sp > XB_SPIN_CAP) { atomicAdd(&(bar)[XB_TMO], 1u); break; } } } } while (0)

struct XcdBarrier { unsigned* bar; unsigned x; volatile LAS unsigned* st; };
__device__ __forceinline__ XcdBarrier xcd_barrier_post(unsigned* bar, volatile LAS unsigned* st, bool leader) {
    XcdBarrier b; b.bar = bar; b.x = xb_xcc_id(); b.st = st;
    if (leader) (void)xb_add(&bar[XB_XCNT(b.x)], 1u);
    return b;
}
__device__ __forceinline__ void xcd_barrier_complete(unsigned* bar, unsigned x, unsigned& nloc, unsigned& nx) {
    const unsigned G = gridDim.x * gridDim.y * gridDim.z;
    unsigned sum, cnt, mine, sp = 0u;
    for (;;) {
        sum = 0u; cnt = 0u; mine = 0u;
#pragma unroll
        for (unsigned j = 0; j < 16; ++j) { const unsigned c = xb_ld(&bar[XB_XCNT(j)]); sum += c; cnt += (c > 0u) ? 1u : 0u; mine = (j == x) ? c : mine; }
        if (sum == G) break;
        __builtin_amdgcn_s_sleep(1);
        if ((++sp & 255u) == 0u) { if (xb_ld(&bar[XB_TMO])) break; if (sp > XB_SPIN_CAP) { atomicAdd(&bar[XB_TMO], 1u); break; } }
    }
    nloc = mine > 0u ? mine : 1u; nx = cnt > 0u ? cnt : 1u;
}
__device__ __forceinline__ void xcd_barrier(const XcdBarrier& b, bool leader) {
    asm volatile("s_waitcnt vmcnt(0) lgkmcnt(0)" ::: "memory");
    __syncthreads();
    if (leader) {
        unsigned* bar = b.bar;
        __builtin_amdgcn_s_waitcnt(0);
        unsigned nloc = b.st[0], nx = b.st[1];
        if (nloc == 0u) { xcd_barrier_complete(bar, b.x, nloc, nx); b.st[0] = nloc; b.st[1] = nx; }
        const unsigned old = xb_add(&bar[XB_XSUB(b.x)], 1u);
        const unsigned gen = old / nloc;
        if (old + 1u == (gen + 1u) * nloc) {
            __builtin_amdgcn_fence(__ATOMIC_RELEASE, "agent");
            asm volatile("s_waitcnt vmcnt(0)" ::: "memory");
            const unsigned og = xb_add(&bar[XB_TOP], 1u);
            const unsigned tg = og / nx;
            if (og + 1u == (tg + 1u) * nx) xb_add(&bar[XB_TOPGEN], 1u);
            else XB_SPIN(xb_ld(&bar[XB_TOPGEN]) == tg, bar);
            __builtin_amdgcn_fence(__ATOMIC_ACQUIRE, "agent");
            xb_add(&bar[XB_XGEN(b.x)], 1u);
            asm volatile("s_waitcnt vmcnt(0)" ::: "memory");
        } else {
            XB_SPIN(xb_ld(&bar[XB_XGEN(b.x)]) == gen, bar);
            __builtin_amdgcn_fence(__ATOMIC_ACQUIRE, "agent");
            asm volatile("s_waitcnt vmcnt(0)" ::: "memory");
        }
    }
    __syncthreads();
}
#ifndef PROBE_R1_REPS
#define PROBE_R1_REPS 1
#endif
#ifndef PROBE_P1_REPS
#define PROBE_P1_REPS 1
#endif
#ifndef PROBE_P0_REPS
#define PROBE_P0_REPS 1
#endif
#ifndef PROBE_BAR_REPS
#define PROBE_BAR_REPS 1
#endif
#ifndef PROBE_GEMM_REPS
#define PROBE_GEMM_REPS 1
#endif
#ifndef PROBE_ATT_REPS
#define PROBE_ATT_REPS 1
#endif

__global__ void __launch_bounds__(512, 2) fwd_megakernel(Params p) {
    extern __shared__ __attribute__((aligned(16))) unsigned char lds_raw[];
    LAS unsigned char* lds = (LAS unsigned char*)lds_raw;
    const int wave = __builtin_amdgcn_readfirstlane(threadIdx.x >> 6);
    typedef const __attribute__((address_space(4))) Params* KP;
#define PHASE_IDS() int tid = wave * 64 + lane_id(); asm volatile("" : "+v"(tid)); int G = gridDim.x, blk = blockIdx.x; asm volatile("" : "+s"(G), "+s"(blk)); const int NGW = G * 8; const int lane = tid & 63; const int gw = blk * 8 + wave; (void)lane; (void)gw; (void)NGW; \
    KP pp = (KP)__builtin_amdgcn_kernarg_segment_ptr(); asm volatile("" : "+s"(pp)); unsigned char* ws = pp->ws; (void)ws;
#define PIN(i) (pp->in[i])
#define LOADY(m, y, ns) do { if ((m) >= NLAT) load16part<ns>(WSP(float, WS_PART), (m) - NLAT, lane, y); else load16bf(BY + (size_t)(m) * DM, lane, y); } while (0)
#define XBAR_WORDS ((unsigned*)((KP)__builtin_amdgcn_kernarg_segment_ptr())->ws)
#define XBAR_ST ((volatile LAS unsigned*)(lds + 131072 + 256))
#define GBAR() do { XcdBarrier xb_; xb_.bar = XBAR_WORDS; xb_.x = xb_xcc_id(); xb_.st = XBAR_ST; xcd_barrier(xb_, wave == 0 && lane_id() == 0); } while (0)
#define WSP(T, off) ((T*)(ws + (off)))
#define MOD WSP(float, WS_MOD)
#define BA WSP(bf16_t, WS_A)
#define BH WSP(bf16_t, WS_B)
#define BZ WSP(bf16_t, WS_Z)
#define BQ WSP(bf16_t, WS_Q)
#define BKV WSP(bf16_t, WS_KV)
#define BQN WSP(bf16_t, WS_QN)
#define BKVN WSP(bf16_t, WS_KVN)
#define BKR WSP(bf16_t, WS_KR)
#define BY WSP(bf16_t, WS_D)
#define XSC WSP(float, WS_XSC)
#define XS_ROW(m) ((m) < NLAT ? pp->out + (size_t)(m) * DM : XSC + (size_t)((m) - NLAT) * DM)
#define MOD_ROW(l, m) (MOD + ((l) * 5 + ((m) < NLAT ? (m) / SEQL : 4)) * 6144)

    for (int rp0_ = 0; rp0_ < PROBE_P0_REPS; ++rp0_) {
        PHASE_IDS();
        if (blk == 0) for (int i = tid; i < XCD_BAR_WORDS; i += 512) ((unsigned*)ws)[i] = 0u;
        if (tid < 2) ((LAS unsigned*)(lds + 131072 + 256))[tid] = 0u;
        LAS float* sil = (LAS float*)lds;
        LAS float* part = sil + 5 * 1024;
        for (int it = blk; it < 192; it += G) {
            const int l = it / 96, j0 = (it % 96) * 64;
            for (int i = tid; i < 5 * 1024; i += 512) { const int r = i >> 10, k = i & 1023; const float cv = r < 4 ? PIN(I_C)[r * 1024 + k] : PIN(I_CCTX)[k]; sil[i] = cv * sigmoidf_(cv); }
            __syncthreads();
            const int kg = tid >> 6, jc = tid & 63; const float* wm = PIN(I_WMOD) + (size_t)l * 1024 * 6144 + j0 + jc;
            float a0 = 0.f, a1 = 0.f, a2 = 0.f, a3 = 0.f, a4 = 0.f;
#pragma unroll 8
            for (int k = kg; k < 1024; k += 8) { const float w = wm[(size_t)k * 6144]; a0 += sil[k] * w; a1 += sil[1024 + k] * w; a2 += sil[2048 + k] * w; a3 += sil[3072 + k] * w; a4 += sil[4096 + k] * w; }
            part[(kg * 5 + 0) * 64 + jc] = a0; part[(kg * 5 + 1) * 64 + jc] = a1; part[(kg * 5 + 2) * 64 + jc] = a2; part[(kg * 5 + 3) * 64 + jc] = a3; part[(kg * 5 + 4) * 64 + jc] = a4;
            __syncthreads();
            if (tid < 320) { const int r = tid >> 6; float s = 0.f;
#pragma unroll
                for (int q = 0; q < 8; ++q) s += part[(q * 5 + r) * 64 + jc];
                MOD[(l * 5 + r) * 6144 + j0 + jc] = s + PIN(I_BMOD)[l * 6144 + j0 + jc]; }
            __syncthreads();
        }
        LAS float* scr = (LAS float*)(lds + 32768 + wave * 8704);
        constexpr int T_IN = 16 * 53, T_Q = 4 * 24, T_KV = 2 * 32, T_O = 16 * 32, T_UP = 16 * 128, T_DN = 64 * 32, T_L = T_IN + T_Q + T_KV + T_O + T_UP + T_DN;
        for (int it = gw; it < 2 * T_L; it += NGW) {
            const int l = it / T_L; int r = it % T_L; bf16_t* wl = (bf16_t*)(ws + WS_W + (size_t)l * W_LAYER);
            if (r < T_IN) { transpose_item(PIN(I_WIN) + (size_t)l * 1024 * INW, 1024, INW, (bf16_t*)((unsigned char*)wl + W_IN), scr, r, lane); continue; } r -= T_IN;
            if (r < T_Q) { transpose_item(PIN(I_WQB) + (size_t)l * 256 * 768, 256, 768, (bf16_t*)((unsigned char*)wl + W_Q), scr, r, lane); continue; } r -= T_Q;
            if (r < T_KV) { transpose_item(PIN(I_WKVB) + (size_t)l * 128 * 1024, 128, 1024, (bf16_t*)((unsigned char*)wl + W_KV), scr, r, lane); continue; } r -= T_KV;
            if (r < T_O) { transpose_item(PIN(I_WO) + (size_t)l * 1024 * 1024, 1024, 1024, (bf16_t*)((unsigned char*)wl + W_O), scr, r, lane); continue; } r -= T_O;
            if (r < T_UP) { transpose_item(PIN(I_WUP) + (size_t)l * 1024 * DFF, 1024, DFF, (bf16_t*)((unsigned char*)wl + W_UP), scr, r, lane); continue; } r -= T_UP;
            transpose_item(PIN(I_WDN) + (size_t)l * DFF * 1024, DFF, 1024, (bf16_t*)((unsigned char*)wl + W_DN), scr, r, lane);
        }
        for (int i = blk * 512 + tid; i < 2 * 96 * 128; i += G * 512) { const int l = i / (96 * 128), q = i % (96 * 128);
            ((u32x4*)(ws + WS_W + (size_t)l * W_LAYER + W_IN + (size_t)INW * 2048))[q] = (u32x4){0u, 0u, 0u, 0u}; }
    }
    cg::this_grid().sync();
    (void)xcd_barrier_post(XBAR_WORDS, XBAR_ST, wave == 0 && lane_id() == 0);
    { PHASE_IDS();
#define P1_SRC(m) ((m) < NLAT ? PIN(I_X) + (size_t)(m) * DM : PIN(I_CTX) + (size_t)((m) - NLAT) * DM)
#define P1_ROW(m, v) do { const float* mod = MOD_ROW(0, m); const float rinv = rsqrtf(ssq16(v) * (1.f / DM) + EPSN); prenorm_store(v, rinv, PIN(I_GPREMIX), mod, mod + 1024, BA + (size_t)(m) * DM, lane); } while (0)
    for (int m0 = gw; m0 < MTOT; m0 += 2 * NGW) { const int m1 = m0 + NGW; const bool has1 = m1 < MTOT; const int m1c = has1 ? m1 : m0;
        f32x4 v0[4], v1[4]; load16(P1_SRC(m0), lane, v0); load16(P1_SRC(m1c), lane, v1);
        P1_ROW(m0, v0); if (has1) P1_ROW(m1, v1); } }
    GBAR();

    for (int l = 0; l < 2; ++l) {
        const bool last = (l == 1);
#define WL (ws + WS_W + (size_t)l * W_LAYER)
        const int Mact = last ? NLAT : MTOT;
        for (int rep_ = 0; rep_ < PROBE_GEMM_REPS; ++rep_) { PHASE_IDS(); pg8::Gemm g{BA, (const bf16_t*)(WL + W_IN), MTOT, ZW, 1024, 1024}; pg8::StaticOrder S; S.init(MTOT, ZW, G, blk); pg8::EpiBf16<0> E{BZ, ZW};
          pg8::gemm_phase<pg8::EpiBf16<0>, pg8::StaticOrder, true, true>(lds, g, S, E, wave); }
        GBAR();
        for (int rr1_ = 0; rr1_ < PROBE_R1_REPS; ++rr1_) {
            PHASE_IDS();
            const float* gq = PIN(I_GQ) + l * 256; const float* gkv = PIN(I_GKV) + l * 128; const float* gbr = PIN(I_GBR) + l * 1024;
            const float* cw = PIN(I_CDWW) + l * 31 * 256; const float* cb = PIN(I_CDWB) + l * 256; const float* lng = PIN(I_CLNG) + l * 256; const float* lnb = PIN(I_CLNB) + l * 256;
            const float* sw = PIN(I_SDWW) + l * 3 * 256;
            LAS float* U = (LAS float*)lds;
            LAS float* WL_ = (LAS float*)(lds + 96256);
            for (int i = tid; i < 31 * 64; i += 512) *(LAS f32x4*)(WL_ + 4 * i) = ((const f32x4*)cw)[i];
            __syncthreads();
            const int lane_o = lane, tid_o = tid;
            for (int ti = blk; ti < 544; ti += G) {
                int tid = tid_o; asm volatile("" : "+v"(tid)); const int lane = tid & 63;
                int seq_base, seq_len, t0; bool is_lat;
                if (ti < 512) { seq_base = (ti >> 7) * SEQL; seq_len = SEQL; t0 = (ti & 127) * 64; is_lat = true; }
                else { const int tc = ti - 512; seq_base = NLAT + (tc >> 3) * CTXL; seq_len = CTXL; t0 = (tc & 7) * 32; is_lat = false; }
                const int TT = is_lat ? 64 : 32; const bool dead = last && !is_lat;
                const int urows = dead ? 0 : (TT + 30) * 32; const bool wact = wave * 8 < TT;
                if (!dead) { u32x4 ua[6], ug[6];
#pragma unroll
                  for (int i = 0; i < 6; ++i) { const int it = tid + 512 * i, rr = it >> 5, c8 = it & 31, t = t0 - 15 + rr; const bool ok = it < urows && t >= 0 && t < seq_len;
                      const bf16_t* zr = BZ + (size_t)(seq_base + (ok ? t : t0)) * ZW; ua[i] = *(const u32x4*)(zr + 416 + 8 * c8); ug[i] = *(const u32x4*)(zr + 672 + 8 * c8); if (!ok) ua[i] = (u32x4){0u, 0u, 0u, 0u}; }
#pragma unroll
                  for (int i = 0; i < 6; ++i) { const int it = tid + 512 * i, rr = it >> 5, c8 = it & 31; const u32x4 a = ua[i], gg = ug[i];
                      if (it < urows) {
                        const f32x4 u0 = {bflo(a.x) * sigmoidf_(bflo(gg.x)), bfhi(a.x) * sigmoidf_(bfhi(gg.x)), bflo(a.y) * sigmoidf_(bflo(gg.y)), bfhi(a.y) * sigmoidf_(bfhi(gg.y))};
                        const f32x4 u1 = {bflo(a.z) * sigmoidf_(bflo(gg.z)), bfhi(a.z) * sigmoidf_(bfhi(gg.z)), bflo(a.w) * sigmoidf_(bflo(gg.w)), bfhi(a.w) * sigmoidf_(bfhi(gg.w))};
                        *(LAS f32x4*)(U + rr * 256 + 8 * c8) = u0; *(LAS f32x4*)(U + rr * 256 + 8 * c8 + 4) = u1; } } }
                if (wact) { const int tw = t0 + wave * 8; const size_t mw = (size_t)seq_base + tw; const bf16_t* zw = BZ + mw * ZW;
                  u32x2 zq[8], bgt[8], cgt[10], hht[10]; unsigned kvv[8]; unsigned short krv[8];
#pragma unroll
                  for (int k8 = 0; k8 < 8; ++k8) { const bf16_t* zr = zw + (size_t)k8 * ZW; zq[k8] = *(const u32x2*)(zr + 4 * lane); kvv[k8] = *(const unsigned*)(zr + 256 + 2 * lane); krv[k8] = zr[384 + (lane & 31)];
                      bgt[k8] = *(const u32x2*)(zr + 928 + 4 * lane); }
#pragma unroll
                  for (int j = 0; j < 10; ++j) { const int tt = tw - 1 + j; const bool ok = tt >= 0 && tt < seq_len; const bf16_t* z2 = BZ + (size_t)(seq_base + (ok ? tt : tw)) * ZW;
                      cgt[j] = *(const u32x2*)(z2 + 1184 + 4 * lane); hht[j] = *(const u32x2*)(z2 + 1440 + 4 * lane); if (!ok) { cgt[j] = (u32x2){0u, 0u}; } }
                  const f32x4 gqv = ((const f32x4*)gq)[lane]; const float gk0 = gkv[2 * lane], gk1 = gkv[2 * lane + 1]; const f32x4 gsc = ((const f32x4*)(gbr + 768))[lane];
                  const f32x4 sw0 = ((const f32x4*)sw)[lane], sw1 = ((const f32x4*)(sw + 256))[lane], sw2 = ((const f32x4*)(sw + 512))[lane];
                  f32x4 pr[10];
#pragma unroll
                  for (int j = 0; j < 10; ++j) pr[j] = (f32x4){bflo(cgt[j].x) * bflo(hht[j].x), bfhi(cgt[j].x) * bfhi(hht[j].x), bflo(cgt[j].y) * bflo(hht[j].y), bfhi(cgt[j].y) * bfhi(hht[j].y)};
#pragma unroll
                  for (int k8 = 0; k8 < 8; ++k8) { const int t = tw + k8; const size_t m = mw + k8;
                    { const u32x2 w = zq[k8]; const f32x4 v = {bflo(w.x), bfhi(w.x), bflo(w.y), bfhi(w.y)};
                      const float ri = rsqrtf(wave_sum((v.x * v.x + v.y * v.y) + (v.z * v.z + v.w * v.w)) * (1.f / 256.f) + EPSN); const f32x4 o = v * ri * gqv;
                      u32x2 ow; ow.x = cvtpk(o.x, o.y); ow.y = cvtpk(o.z, o.w); *(u32x2*)(BQN + m * 256 + 4 * lane) = ow; }
                    { const unsigned w = kvv[k8]; const float v0 = bflo(w), v1 = bfhi(w);
                      const float ri = rsqrtf(wave_sum(v0 * v0 + v1 * v1) * (1.f / 128.f) + EPSN); *(unsigned*)(BKVN + m * 128 + 2 * lane) = cvtpk(v0 * ri * gk0, v1 * ri * gk1); }
                    { const int e = lane & 31; const float v = bf2f(krv[k8]); const float prn = swz_xor<8>(v); float o = v;
                      if (is_lat) { const int a = e >> 4, i = e & 15; const float pos = (float)(a == 0 ? (t >> 6) : (t & 63)); const float ang = pos * rope_inv(i & 7), c = __cosf(ang), s = __sinf(ang);
                          o = (i < 8) ? (v * c - prn * s) : (v * c + prn * s); }
                      if (lane < 32) BKR[m * 32 + e] = f2bf(o); }
                    { const f32x4 acc = pr[k8] * sw0 + pr[k8 + 1] * sw1 + pr[k8 + 2] * sw2; const u32x2 bg = bgt[k8];
                      const f32x4 s = {bflo(bg.x) * acc.x, bfhi(bg.x) * acc.y, bflo(bg.y) * acc.z, bfhi(bg.y) * acc.w};
                      const float ri = rsqrtf(wave_sum((s.x * s.x + s.y * s.y) + (s.z * s.z + s.w * s.w)) * (1.f / 256.f) + EPSN); const f32x4 o = s * ri * gsc;
                      u32x2 ow; ow.x = cvtpk(o.x, o.y); ow.y = cvtpk(o.z, o.w); *(u32x2*)(BA + m * DM + 768 + 4 * lane) = ow; }
                  }
                }
                __syncthreads();
                if (wact && !dead) { int lane = lane_o; asm volatile("" : "+v"(lane)); f32x4 wv[31];
#pragma unroll
                  for (int j = 0; j < 31; ++j) wv[j] = *(const LAS f32x4*)(WL_ + j * 256 + 4 * lane);
                  const f32x4 bias = ((const f32x4*)cb)[lane]; f32x4 acc[8];
#pragma unroll
                  for (int k = 0; k < 8; ++k) acc[k] = bias;
                  const LAS float* Ub = U + (wave * 8) * 256 + 4 * lane;
#pragma unroll
                  for (int i = 0; i < 38; ++i) { const f32x4 u = *(const LAS f32x4*)(Ub + i * 256);
#pragma unroll
                      for (int k = 0; k < 8; ++k) { const int j = i - k; if (j >= 0 && j < 31) acc[k] += u * wv[j]; } }
                  const f32x4 lg = ((const f32x4*)lng)[lane], lb = ((const f32x4*)lnb)[lane], gb = ((const f32x4*)(gbr + 512))[lane];
#pragma unroll
                  for (int k = 0; k < 8; ++k) { const f32x4 a = acc[k]; const float mean = wave_sum((a.x + a.y) + (a.z + a.w)) * (1.f / 256.f); const f32x4 d = a - mean;
                      const float rstd = rsqrtf(wave_sum((d.x * d.x + d.y * d.y) + (d.z * d.z + d.w * d.w)) * (1.f / 256.f) + EPSN); f32x4 y = d * rstd * lg + lb;
                      y = (f32x4){y.x * sigmoidf_(y.x), y.y * sigmoidf_(y.y), y.z * sigmoidf_(y.z), y.w * sigmoidf_(y.w)};
                      const float ri = rsqrtf(wave_sum((y.x * y.x + y.y * y.y) + (y.z * y.z + y.w * y.w)) * (1.f / 256.f) + EPSN); const f32x4 o = y * ri * gb;
                      u32x2 ow; ow.x = cvtpk(o.x, o.y); ow.y = cvtpk(o.z, o.w); *(u32x2*)(BA + ((size_t)seq_base + t0 + wave * 8 + k) * DM + 512 + 4 * lane) = ow; } }
                __syncthreads();
            }
        }
        GBAR();
        for (int rep_ = 0; rep_ < PROBE_GEMM_REPS; ++rep_) { PHASE_IDS(); pg8::Gemm g{BQN, (const bf16_t*)(WL + W_Q), MTOT, 768, 256, 256}; pg8::StaticOrder S; S.init(MTOT, 768, G, blk); pg8::EpiBf16<0> E{BQ, 768};
          pg8::gemm_phase<pg8::EpiBf16<0>, pg8::StaticOrder, true, true>(lds, g, S, E, wave); }
        for (int rep_ = 0; rep_ < PROBE_GEMM_REPS; ++rep_) { PHASE_IDS(); pg8::Gemm g{BKVN, (const bf16_t*)(WL + W_KV), MTOT, 1024, 128, 128}; pg8::StaticOrder S; S.init(MTOT, 1024, G, blk); pg8::EpiBf16<0> E{BKV, 1024};
          pg8::gemm_phase<pg8::EpiBf16<0>, pg8::StaticOrder, true, true>(lds, g, S, E, wave); }
        GBAR();
        {
            PHASE_IDS();
            const int nunits = last ? 1024 : 1056;
            for (int rep_ = 0; rep_ < PROBE_ATT_REPS; ++rep_)
            for (int u = blk; u < nunits; u += G) {
                if (u < 1024) { const int bh = (u & 7) + 8 * (u >> 8), qb = (u >> 3) & 31, b = bh >> 3, h = bh & 7; const int q0 = b * SEQL + qb * 256;
                    att::attn_unit(BQ + (size_t)q0 * 768 + h * 96, true, qb * 256, BKV + h * 128, BKR, NLAT + b * CTXL, b * SEQL, 132, BA + (size_t)q0 * DM + h * 64, lds, wave); }
                else { const int uc = u - 1024, b = uc >> 3, h = uc & 7; const int q0 = NLAT + b * CTXL;
                    att::attn_unit(BQ + (size_t)q0 * 768 + h * 96, false, 0, BKV + h * 128, BKR, q0, 0, 4, BA + (size_t)q0 * DM + h * 64, lds, wave); }
            }
        }
        GBAR();
        { PHASE_IDS(); const float* gbr = PIN(I_GBR) + l * 1024; const f32x4 g0 = ((const f32x4*)gbr)[2 * lane], g1 = ((const f32x4*)gbr)[2 * lane + 1];
          for (int m0 = gw; m0 < Mact; m0 += 4 * NGW) { u32x4 w[4];
#pragma unroll
              for (int i = 0; i < 4; ++i) { const int m = m0 + i * NGW; w[i] = ((const u32x4*)(BA + (size_t)(m < Mact ? m : m0) * DM))[lane]; }
#pragma unroll
              for (int i = 0; i < 4; ++i) { const int m = m0 + i * NGW; if (m < Mact) {
                  const float v[8] = {bflo(w[i].x), bfhi(w[i].x), bflo(w[i].y), bfhi(w[i].y), bflo(w[i].z), bfhi(w[i].z), bflo(w[i].w), bfhi(w[i].w)}; float s = 0.f;
#pragma unroll
                  for (int q = 0; q < 8; ++q) s += v[q] * v[q];
                  const float ri = rsqrtf(wave_sum(s) * (1.f / 512.f) + EPSN);
                  u32x4 o; o.x = cvtpk(v[0] * ri * g0.x, v[1] * ri * g0.y); o.y = cvtpk(v[2] * ri * g0.z, v[3] * ri * g0.w); o.z = cvtpk(v[4] * ri * g1.x, v[5] * ri * g1.y); o.w = cvtpk(v[6] * ri * g1.z, v[7] * ri * g1.w);
                  ((u32x4*)(BA + (size_t)m * DM))[lane] = o; } } } }
        GBAR();
        { PHASE_IDS(); pg8::Gemm g{BA, (const bf16_t*)(WL + W_O), NLAT, 1024, 1024, 1024}; pg8::StaticOrder S; S.init(NLAT, 1024, G, blk); pg8::EpiBf16<0> E{BY, 1024};
          pg8::gemm_phase<pg8::EpiBf16<0>, pg8::StaticOrder, true, true>(lds, g, S, E, wave); }
        if (!last) { PHASE_IDS(); pg8::Gemm g{BA, (const bf16_t*)(WL + W_O), MTOT, 1024, 256, 1024}; pg8::SplitOrder S; S.init(4, 4, 4, 128, G, blk); pg8::EpiF32Part E{WSP(float, WS_PART), 1024, 128, (size_t)1024 * 1024};
          pg8::gemm_phase<pg8::EpiF32Part, pg8::SplitOrder, true, true>(lds, g, S, E, wave); }
        GBAR();
        { PHASE_IDS(); const float* gp = PIN(I_GPOSTMIX) + l * DM; const float* gm = PIN(I_GPREMLP) + l * DM;
#define R3_SRC(m) ((l == 0) ? ((m) < NLAT ? PIN(I_X) + (size_t)(m) * DM : PIN(I_CTX) + (size_t)((m) - NLAT) * DM) : (const float*)XS_ROW(m))
#define R3_ROW(m, y, x) do { const float* mod = MOD_ROW(l, m); float* dst = XS_ROW(m); const float ry = rsqrtf(ssq16(y) * (1.f / DM) + EPSN); \
            _Pragma("unroll") for (int j = 0; j < 4; ++j) { const int q = lane + 64 * j; x[j] = x[j] + ((const f32x4*)(mod + 2048))[q] * (y[j] * ry * ((const f32x4*)gp)[q]); __builtin_nontemporal_store(x[j], (f32x4*)dst + q); } \
            const float r1 = rsqrtf(ssq16(x) * (1.f / DM) + EPSN); prenorm_store(x, r1, gm, mod + 3072, mod + 4096, BA + (size_t)(m) * DM, lane); } while (0)
        for (int m0 = gw; m0 < Mact; m0 += 4 * NGW) { f32x4 yb[4][4], xb[4][4];
#pragma unroll
            for (int i = 0; i < 4; ++i) { const int mi = m0 + i * NGW, mc = mi < Mact ? mi : m0; LOADY(mc, yb[i], 4); load16(R3_SRC(mc), lane, xb[i]); }
#pragma unroll
            for (int i = 0; i < 4; ++i) { const int mi = m0 + i * NGW; if (mi < Mact) R3_ROW(mi, yb[i], xb[i]); } } }
        GBAR();
        for (int rep_ = 0; rep_ < PROBE_GEMM_REPS; ++rep_) { PHASE_IDS(); pg8::Gemm g{BA, (const bf16_t*)(WL + W_UP), Mact, DFF, 1024, 1024}; pg8::StaticOrder S; S.init(Mact, DFF, G, blk); pg8::EpiBf16<2> E{BH, DFF};
          pg8::gemm_phase<pg8::EpiBf16<2>, pg8::StaticOrder, true, true>(lds, g, S, E, wave); }
        GBAR();
        { PHASE_IDS(); pg8::Gemm g{BH, (const bf16_t*)(WL + W_DN), NLAT, 1024, DFF, DFF}; pg8::StaticOrder S; S.init(NLAT, 1024, G, blk); S.rev = true; pg8::EpiBf16<0> E{BY, 1024};
          pg8::gemm_phase<pg8::EpiBf16<0>, pg8::StaticOrder, true, true>(lds, g, S, E, wave); }
        if (!last) { PHASE_IDS(); pg8::Gemm g{BH, (const bf16_t*)(WL + W_DN), MTOT, 1024, 256, DFF}; pg8::SplitOrder S; S.init(4, 4, 16, 128, G, blk); pg8::EpiF32Part E{WSP(float, WS_PART), 1024, 128, (size_t)1024 * 1024};
          pg8::gemm_phase<pg8::EpiF32Part, pg8::SplitOrder, true, true>(lds, g, S, E, wave); }
        GBAR();
        { PHASE_IDS(); const float* gp = PIN(I_GPOSTMLP) + l * DM; const float* gn = PIN(I_GPREMIX) + (last ? 0 : (l + 1) * DM);
#define R4_ROW(m, y, x) do { const float* mod = MOD_ROW(l, m); float* xr = XS_ROW(m); const float ry = rsqrtf(ssq16(y) * (1.f / DM) + EPSN); \
            _Pragma("unroll") for (int j = 0; j < 4; ++j) { const int q = lane + 64 * j; x[j] = x[j] + ((const f32x4*)(mod + 5120))[q] * (y[j] * ry * ((const f32x4*)gp)[q]); __builtin_nontemporal_store(x[j], (f32x4*)xr + q); } \
            if (!last) { const float* mod1 = MOD_ROW(l + 1, m); const float r1 = rsqrtf(ssq16(x) * (1.f / DM) + EPSN); prenorm_store(x, r1, gn, mod1, mod1 + 1024, BA + (size_t)(m) * DM, lane); } } while (0)
        for (int m0 = gw; m0 < Mact; m0 += 4 * NGW) { f32x4 yb[4][4], xb[4][4];
#pragma unroll
            for (int i = 0; i < 4; ++i) { const int mi = m0 + i * NGW, mc = mi < Mact ? mi : m0; LOADY(mc, yb[i], 16); load16(XS_ROW(mc), lane, xb[i]); }
#pragma unroll
            for (int i = 0; i < 4; ++i) { const int mi = m0 + i * NGW; if (mi < Mact) R4_ROW(mi, yb[i], xb[i]); } } }
        if (!last) GBAR();
    }
}

extern "C" void kernel_launch(void* const* d_in, const int* in_sizes, int n_in, void* d_out, int out_size, void* d_ws, size_t ws_size, hipStream_t stream) {
    static int grid_blocks = 0;
    if (grid_blocks == 0) {
        if (n_in != 24 || out_size != NLAT * DM || ws_size < WS_END) { fprintf(stderr, "kernel_launch: unexpected shapes n_in %d out %d ws %zu\n", n_in, out_size, ws_size); grid_blocks = -1; return; }
        int dev = 0, cus = 0, per_cu = 0;
        hipGetDevice(&dev); hipDeviceGetAttribute(&cus, hipDeviceAttributeMultiprocessorCount, dev);
        if (hipFuncSetAttribute((const void*)fwd_megakernel, hipFuncAttributeMaxDynamicSharedMemorySize, LDS_BYTES) != hipSuccess) { fprintf(stderr, "kernel_launch: hipFuncSetAttribute failed\n"); grid_blocks = -1; return; }
        if (hipOccupancyMaxActiveBlocksPerMultiprocessor(&per_cu, (const void*)fwd_megakernel, 512, LDS_BYTES) != hipSuccess || per_cu < 1) { fprintf(stderr, "kernel_launch: occupancy query says %d\n", per_cu); per_cu = 1; (void)hipGetLastError(); }
        grid_blocks = cus * per_cu;
    }
    if (grid_blocks < 0) return;
    Params p{};
    for (int i = 0; i < 24; ++i) p.in[i] = (const float*)d_in[i];
    p.out = (float*)d_out; p.ws = (unsigned char*)d_ws;
    void* args[] = {&p};
    hipError_t e = hipLaunchCooperativeKernel((const void*)fwd_megakernel, dim3(grid_blocks), dim3(512), args, LDS_BYTES, stream);
    if (e != hipSuccess) fprintf(stderr, "cooperative launch failed: %s (grid %d)\n", hipGetErrorString(e), grid_blocks);
}
```

```cpp
#include <hip/hip_runtime.h>
#include <hip/hip_cooperative_groups.h>
#include <cstdio>
#include <cstdint>
namespace cg = cooperative_groups;
namespace pg8 {
#define PG8_LAS __attribute__((address_space(3)))
typedef unsigned short bf16_t;
typedef short bf16x8 __attribute__((ext_vector_type(8)));
typedef float f32x4 __attribute__((ext_vector_type(4)));
typedef unsigned u32x4 __attribute__((ext_vector_type(4)));
constexpr int BM = 256, BK = 64, HALF = 128, HTB = HALF * BK * 2  , STAGE_BYTES = 8 * HTB, NXCD = 8, WGM = 8;

__host__ __device__ __forceinline__ int lds_byte(int r, int c) { const int st = (r >> 4) * 2 + (c >> 5), rr = r & 15, cc = c & 31, ob = rr * 64 + cc * 2; return st * 1024 + (ob ^ (((ob >> 9) & 1) << 5)); }
__host__ __device__ __forceinline__ void stage_rc(int b, int& R, int& C) { const int st = b / 1024, sb = b % 1024, swz = sb ^ (((sb >> 9) & 1) << 5); R = (st >> 1) * 16 + swz / 64; C = (st & 1) * 32 + (swz % 64) / 2; }
__host__ __device__ __forceinline__ int perm32(int rho) { const int n = rho >> 4, i = rho & 15; return 8 * (i >> 2) + 4 * n + (i & 3); }

struct Unit { int pm, pn, kq; };
struct Gemm { const bf16_t* A; const bf16_t* Bt; int M, N, K, ld; };

struct StaticOrder {
    int nM, nN, nwg, G, c; bool rev = false;
    __host__ __device__ void init(int M, int N, int G_, int c_) { nM = M / BM; nN = N / BM; nwg = nM * nN; G = G_; c = c_; }
    __host__ __device__ bool next(int i, Unit& u) const {
        const long L = (long)i * G + c; if (L >= nwg) return false;
        int wgid = (int)L; { const int q = nwg / NXCD, r = nwg % NXCD, xcd = wgid % NXCD, off = wgid / NXCD; wgid = (xcd < r ? xcd * (q + 1) : r * (q + 1) + (xcd - r) * q) + off; }
        const int nig = WGM * nN, gid = wgid / nig, fm = gid * WGM, gsz = (nM - fm) < WGM ? (nM - fm) : WGM;
        u.pm = fm + ((wgid % nig) % gsz); u.pn = (wgid % nig) / gsz; u.kq = 0; if (rev) u.pm = nM - 1 - u.pm; return true;
    }
    __device__ __forceinline__ void a_ready(const Unit&) const {}
    __device__ __forceinline__ void done(const Unit&) const {}
};
struct SplitOrder {
    int nN, nsplit, mt0, total, G, c;
    __host__ __device__ void init(int nMt, int nN_, int nsplit_, int mt0_, int G_, int c_) { nN = nN_; nsplit = nsplit_; mt0 = mt0_; total = nMt * nN_ * nsplit_; G = G_; c = c_; }
    __host__ __device__ bool next(int i, Unit& u) const { const int L = i * G + c; if (L >= total) return false; u.kq = L % nsplit; const int t = L / nsplit; u.pn = t % nN; u.pm = mt0 + t / nN; return true; }
    __device__ __forceinline__ void a_ready(const Unit&) const {}
    __device__ __forceinline__ void done(const Unit&) const {}
};

__device__ __forceinline__ unsigned cvt_pk_bf16(float lo, float hi) { unsigned r; asm volatile("v_cvt_pk_bf16_f32 %0, %1, %2" : "=v"(r) : "v"(lo), "v"(hi)); return r; }
typedef float f32x2 __attribute__((ext_vector_type(2)));
template <int ACT> struct EpiBf16 {
    static constexpr bool PERM = true, AFTER_DRAIN = false;
    bf16_t* O; int ldc;
    __device__ __forceinline__ void operator()(const f32x4 (&acc)[2][2][4][2], const Unit& u, int wr, int wc, int fr, int fq) const {
        const int row0 = u.pm * BM + wr * 64 + fr; const int col0 = u.pn * BM + wc * 32 + 8 * fq;
#pragma unroll
        for (int ai = 0; ai < 2; ++ai)
#pragma unroll
            for (int m = 0; m < 4; ++m) { bf16_t* rowp = O + (size_t)(row0 + ai * HALF + m * 16) * ldc + col0;
#pragma unroll
                for (int bj = 0; bj < 2; ++bj) { f32x4 v0 = acc[ai][bj][m][0], v1 = acc[ai][bj][m][1];
                    if (ACT == 2) {
#pragma unroll
                        for (int e = 0; e < 4; ++e) { float a = fmaxf(v0[e], 0.f), b = fmaxf(v1[e], 0.f); v0[e] = a * a; v1[e] = b * b; } }
                    u32x4 w; w.x = cvt_pk_bf16(v0[0], v0[1]); w.y = cvt_pk_bf16(v0[2], v0[3]); w.z = cvt_pk_bf16(v1[0], v1[1]); w.w = cvt_pk_bf16(v1[2], v1[3]);
                    *(u32x4*)(rowp + bj * HALF) = w; } }
    }
};
struct EpiF32Part {
    static constexpr bool PERM = true, AFTER_DRAIN = false;
    float* P; int ldc; int mt0; size_t slice;
    __device__ __forceinline__ void operator()(const f32x4 (&acc)[2][2][4][2], const Unit& u, int wr, int wc, int fr, int fq) const {
        const int row0 = (u.pm - mt0) * BM + wr * 64 + fr; const int col0 = u.pn * BM + wc * 32 + 8 * fq; float* base = P + (size_t)u.kq * slice;
#pragma unroll
        for (int ai = 0; ai < 2; ++ai)
#pragma unroll
            for (int m = 0; m < 4; ++m) { float* rowp = base + (size_t)(row0 + ai * HALF + m * 16) * ldc + col0;
#pragma unroll
                for (int bj = 0; bj < 2; ++bj) { *(f32x4*)(rowp + bj * HALF) = acc[ai][bj][m][0]; *(f32x4*)(rowp + bj * HALF + 4) = acc[ai][bj][m][1]; } }
    }
};
template <class Epi, class Sched, bool ALIGN_EPI = false, bool SP2 = false>
__device__ __forceinline__ void gemm_phase(PG8_LAS unsigned char* lds, const Gemm g, const Sched& S, const Epi& E, int wave_s) {
    int tid = wave_s * 64 + (int)__builtin_amdgcn_mbcnt_hi(~0u, __builtin_amdgcn_mbcnt_lo(~0u, 0u)); asm volatile("" : "+v"(tid));
    const int wid = __builtin_amdgcn_readfirstlane(tid >> 6), lane = tid & 63, wr = wid >> 2, wc = wid & 3, fr = lane & 15, fq = lane >> 4;
    const int K = g.K, LD = g.ld, nt = K / BK;
    unsigned voffA[2], voffB[2];
#pragma unroll
    for (int i = 0; i < 2; ++i) { int R, C; stage_rc(tid * 16 + i * 8192, R, C); const int Rb = Epi::PERM ? ((R & ~31) + perm32(R & 31)) : R;
        voffA[i] = (unsigned)(R * LD + C) * 2u; voffB[i] = (unsigned)(Rb * LD + C) * 2u; }
    const size_t kstep = (size_t)(BK * 2);
    const size_t hstep = (size_t)HALF * LD * 2;
    const size_t tstep = 2 * hstep;
    const unsigned ldsw = (unsigned)wid * 1024u;
    const int aoff = lds_byte(wr * 64 + fr, fq * 8), boff = lds_byte(wc * 32 + fr, fq * 8);
#define PG8_SA(b, h) (((b) * 2 + (h)) * HTB)
#define PG8_SB(b, h) ((4 + (b) * 2 + (h)) * HTB)
#define PG8_STAGE(bufoff, gbase, voff) do { _Pragma("unroll") for (int _i = 0; _i < 2; ++_i) \
        __builtin_amdgcn_global_load_lds((const unsigned*)((const char*)(gbase) + (voff)[_i]), (PG8_LAS unsigned*)(lds + (bufoff) + ldsw + _i * 8192), 16, 0, 0); } while (0)
#define PG8_LDA(dst, b, h) do { _Pragma("unroll") for (int m = 0; m < 4; ++m) _Pragma("unroll") for (int k = 0; k < 2; ++k) dst[m][k] = *(const PG8_LAS bf16x8*)(lds + PG8_SA(b, h) + aoff + m * 2048 + k * 1024); } while (0)
#define PG8_LDB(dst, b, h) do { _Pragma("unroll") for (int n = 0; n < 2; ++n) _Pragma("unroll") for (int k = 0; k < 2; ++k) dst[n][k] = *(const PG8_LAS bf16x8*)(lds + PG8_SB(b, h) + boff + n * 2048 + k * 1024); } while (0)
#define PG8_MMA(ai, bj, At, Bt) do { __builtin_amdgcn_s_setprio(1); _Pragma("unroll") for (int m = 0; m < 4; ++m) _Pragma("unroll") for (int n = 0; n < 2; ++n) _Pragma("unroll") for (int k = 0; k < 2; ++k) \
        acc[ai][bj][m][n] = __builtin_amdgcn_mfma_f32_16x16x32_bf16(Bt[n][k], At[m][k], acc[ai][bj][m][n], 0, 0, 0); __builtin_amdgcn_s_setprio(0); } while (0)
#define PG8_WAIT_V(n) asm volatile("s_waitcnt vmcnt(" #n ")" ::: "memory")
#define PG8_WAIT_L(n) asm volatile("s_waitcnt lgkmcnt(" #n ")" ::: "memory")
#define PG8_BAR __builtin_amdgcn_s_barrier()
#define PG8_SCHED __builtin_amdgcn_sched_barrier(0)
    Unit cur, nxt; int ui = 0;
    if (!S.next(0, cur)) return;
    f32x4 acc[2][2][4][2];
#pragma unroll
    for (int a = 0; a < 2; ++a)
#pragma unroll
        for (int b = 0; b < 2; ++b)
#pragma unroll
            for (int m = 0; m < 4; ++m)
#pragma unroll
                for (int n = 0; n < 2; ++n) acc[a][b][m][n] = (f32x4){0.f, 0.f, 0.f, 0.f};
    bf16x8 At[4][2], B0[2][2], B1[2][2];
    const size_t kqstep = (size_t)K * 2;
    const char* cA = (const char*)g.A + (size_t)cur.pm * tstep + (size_t)cur.kq * kqstep; const char* cB = (const char*)g.Bt + (size_t)cur.pn * tstep + (size_t)cur.kq * kqstep;
    S.a_ready(cur);
    if constexpr (SP2) {
        PG8_STAGE(PG8_SB(0, 0), cB, voffB); PG8_STAGE(PG8_SB(0, 1), cB + hstep, voffB); PG8_STAGE(PG8_SA(0, 0), cA, voffA); PG8_STAGE(PG8_SA(0, 1), cA + hstep, voffA);
        if (wr == 1) PG8_BAR;
        PG8_WAIT_V(2); PG8_BAR;
        PG8_STAGE(PG8_SB(1, 0), cB + kstep, voffB); PG8_STAGE(PG8_SA(1, 0), cA + kstep, voffA); PG8_STAGE(PG8_SB(1, 1), cB + hstep + kstep, voffB);
        PG8_WAIT_V(6); PG8_BAR;
    } else {
        PG8_STAGE(PG8_SB(0, 0), cB, voffB); PG8_STAGE(PG8_SA(0, 0), cA, voffA); PG8_STAGE(PG8_SB(0, 1), cB + hstep, voffB); PG8_STAGE(PG8_SA(0, 1), cA + hstep, voffA);
        if (wr == 1) PG8_BAR;
        PG8_WAIT_V(4); PG8_BAR;
        PG8_STAGE(PG8_SB(1, 0), cB + kstep, voffB); PG8_STAGE(PG8_SA(1, 0), cA + kstep, voffA); PG8_STAGE(PG8_SB(1, 1), cB + hstep + kstep, voffB);
        PG8_WAIT_V(6); PG8_BAR;
    }
    for (;;) {
        const bool has_next = S.next(ui + 1, nxt);
        const char* nA = has_next ? (const char*)g.A + (size_t)nxt.pm * tstep + (size_t)nxt.kq * kqstep : cA; const char* nB = has_next ? (const char*)g.Bt + (size_t)nxt.pn * tstep + (size_t)nxt.kq * kqstep : cB;
        for (int t = 0; t < nt; t += 2) {
            const bool last = (t == nt - 2);
            const char* a1 = cA + (size_t)(t + 1) * kstep;
            const char* a2 = last ? nA : cA + (size_t)(t + 2) * kstep; const char* b2 = last ? nB : cB + (size_t)(t + 2) * kstep;
            const char* a3 = a2 + kstep; const char* b3 = b2 + kstep;
            if (last && has_next) S.a_ready(nxt);
            if constexpr (SP2) {
            PG8_LDB(B0, 0, 0); PG8_LDB(B1, 0, 1); PG8_SCHED; PG8_LDA(At, 0, 0); PG8_STAGE(PG8_SA(1, 1), a1 + hstep, voffA);
            PG8_WAIT_V(8); PG8_WAIT_L(0); PG8_BAR; PG8_MMA(0, 0, At, B0); PG8_MMA(0, 1, At, B1); PG8_BAR; PG8_SCHED;
            PG8_LDA(At, 0, 1); PG8_STAGE(PG8_SB(0, 0), b2, voffB); PG8_STAGE(PG8_SB(0, 1), b2 + hstep, voffB); PG8_STAGE(PG8_SA(0, 0), a2, voffA);
            PG8_WAIT_V(8); PG8_WAIT_L(0); PG8_BAR; PG8_MMA(1, 0, At, B0); PG8_MMA(1, 1, At, B1); PG8_BAR; PG8_SCHED;
            PG8_LDB(B0, 1, 0); PG8_LDB(B1, 1, 1); PG8_SCHED; PG8_LDA(At, 1, 0); PG8_STAGE(PG8_SA(0, 1), a2 + hstep, voffA);
            PG8_WAIT_V(8); PG8_WAIT_L(0); PG8_BAR; PG8_MMA(0, 0, At, B0); PG8_MMA(0, 1, At, B1); PG8_BAR; PG8_SCHED;
            PG8_LDA(At, 1, 1); PG8_STAGE(PG8_SB(1, 0), b3, voffB); PG8_STAGE(PG8_SB(1, 1), b3 + hstep, voffB); PG8_STAGE(PG8_SA(1, 0), a3, voffA);
            PG8_WAIT_V(8); PG8_WAIT_L(0); PG8_BAR; PG8_MMA(1, 0, At, B0); PG8_MMA(1, 1, At, B1); PG8_BAR; PG8_SCHED;
            } else {
            PG8_LDB(B0, 0, 0); PG8_SCHED; PG8_LDA(At, 0, 0); PG8_STAGE(PG8_SA(1, 1), a1 + hstep, voffA);
            PG8_WAIT_L(8); PG8_BAR; PG8_WAIT_L(0); PG8_MMA(0, 0, At, B0); PG8_BAR; PG8_SCHED;
            PG8_LDB(B1, 0, 1); PG8_STAGE(PG8_SB(0, 0), b2, voffB);
            PG8_BAR; PG8_WAIT_L(0); PG8_MMA(0, 1, At, B1); PG8_BAR;
            PG8_LDA(At, 0, 1); PG8_STAGE(PG8_SA(0, 0), a2, voffA);
            PG8_BAR; PG8_WAIT_L(0); PG8_MMA(1, 0, At, B0); PG8_BAR; PG8_SCHED;
            PG8_STAGE(PG8_SB(0, 1), b2 + hstep, voffB);
            PG8_WAIT_V(6); PG8_BAR; PG8_MMA(1, 1, At, B1); PG8_BAR;
            PG8_LDB(B0, 1, 0); PG8_SCHED; PG8_LDA(At, 1, 0); PG8_STAGE(PG8_SA(0, 1), a2 + hstep, voffA);
            PG8_WAIT_L(8); PG8_BAR; PG8_WAIT_L(0); PG8_MMA(0, 0, At, B0); PG8_BAR; PG8_SCHED;
            PG8_LDB(B1, 1, 1); PG8_STAGE(PG8_SB(1, 0), b3, voffB);
            PG8_BAR; PG8_WAIT_L(0); PG8_MMA(0, 1, At, B1); PG8_BAR;
            PG8_LDA(At, 1, 1); PG8_STAGE(PG8_SA(1, 0), a3, voffA);
            PG8_BAR; PG8_WAIT_L(0); PG8_MMA(1, 0, At, B0); PG8_BAR; PG8_SCHED;
            PG8_STAGE(PG8_SB(1, 1), b3 + hstep, voffB);
            PG8_WAIT_V(6); PG8_BAR; PG8_MMA(1, 1, At, B1); PG8_BAR;
            }
        }
        if constexpr (ALIGN_EPI) { if (wr == 0) PG8_BAR; }
        if constexpr (!Epi::AFTER_DRAIN) { E(acc, cur, wr, wc, fr, fq); S.done(cur); }
        if (!has_next) break;
#pragma unroll
        for (int a = 0; a < 2; ++a)
#pragma unroll
            for (int b = 0; b < 2; ++b)
#pragma unroll
                for (int m = 0; m < 4; ++m)
#pragma unroll
                    for (int n = 0; n < 2; ++n) acc[a][b][m][n] = (f32x4){0.f, 0.f, 0.f, 0.f};
        cur = nxt; cA = nA; cB = nB; ++ui;
        if constexpr (ALIGN_EPI) { if (wr == 1) PG8_BAR; }
    }
    PG8_WAIT_V(0);
    if constexpr (!ALIGN_EPI) { if (wr == 0) PG8_BAR; }
    PG8_BAR;
    if constexpr (Epi::AFTER_DRAIN) { E.fused(acc, cur, wr, wc, fr, fq, lds, wid, lane); S.done(cur); }
#undef PG8_SA
#undef PG8_SB
#undef PG8_STAGE
#undef PG8_LDA
#undef PG8_LDB
#undef PG8_MMA
#undef PG8_WAIT_V
#undef PG8_WAIT_L
#undef PG8_BAR
#undef PG8_SCHED
}
}

#define LAS __attribute__((address_space(3)))
typedef unsigned short bf16_t;
typedef short bf16x8 __attribute__((ext_vector_type(8)));
typedef short s16x4 __attribute__((ext_vector_type(4)));
typedef float f32x4 __attribute__((ext_vector_type(4)));
typedef float f32x16 __attribute__((ext_vector_type(16)));
typedef unsigned u32x2 __attribute__((ext_vector_type(2)));
typedef unsigned u32x4 __attribute__((ext_vector_type(4)));
__device__ __forceinline__ unsigned cvtpk(float lo, float hi) { unsigned r; asm volatile("v_cvt_pk_bf16_f32 %0, %1, %2" : "=v"(r) : "v"(lo), "v"(hi)); return r; }
__device__ __forceinline__ float bflo(unsigned w) { return __uint_as_float(w << 16); }
__device__ __forceinline__ float bfhi(unsigned w) { return __uint_as_float(w & 0xffff0000u); }
__device__ __forceinline__ float bf2f(unsigned short h) { return __uint_as_float((unsigned)h << 16); }
__device__ __forceinline__ unsigned short f2bf(float f) { unsigned u = __float_as_uint(f); return (unsigned short)((u + 0x7fffu + ((u >> 16) & 1u)) >> 16); }
__device__ __forceinline__ int lane_id() { return (int)__builtin_amdgcn_mbcnt_hi(~0u, __builtin_amdgcn_mbcnt_lo(~0u, 0u)); }
template <int X> __device__ __forceinline__ float swz_xor(float v) { return __int_as_float(__builtin_amdgcn_ds_swizzle(__float_as_int(v), (X << 10) | 0x1f)); }
template <int CTRL, int ROWMASK> __device__ __forceinline__ float dpp_f(float v) { return __int_as_float(__builtin_amdgcn_update_dpp(0, __float_as_int(v), CTRL, ROWMASK, 0xF, false)); }
__device__ __forceinline__ float wave_sum(float v) {
    v += dpp_f<0xB1, 0xF>(v);
    v += dpp_f<0x4E, 0xF>(v);
    v += dpp_f<0x141, 0xF>(v);
    v += dpp_f<0x140, 0xF>(v);
    v += dpp_f<0x142, 0xA>(v);
    v += dpp_f<0x143, 0xC>(v);
    return __builtin_amdgcn_readlane(v, 63);
}
__device__ __forceinline__ float sigmoidf_(float x) { return __builtin_amdgcn_rcpf(1.f + __expf(-x)); }
__device__ __forceinline__ float rope_inv(int i) { return exp2f(-1.6609640474436813f * (float)i); }

namespace att {
constexpr int NW = 8, QBLK = 32, KVBLK = 64;
constexpr float SCALE = 0.10206207261596575f;
constexpr float THR = 8.f;
constexpr int BUFB = 16384;
constexpr int NRING = 3, OFF_V = 0, OFF_K = NRING * BUFB, OFF_WS = 2 * NRING * BUFB, LDS_BYTES = OFF_WS + NW * 64 * 4;
#define KSWZ(row, colB) ((row) * 256 + ((colB) ^ (((row) & 15) << 4)))
#define SBAR() __builtin_amdgcn_sched_barrier(0)
__device__ __forceinline__ int crow(int r, int hi) { return (r & 3) + 8 * (r >> 2) + 4 * hi; }
constexpr float C2 = SCALE * 1.4426950408889634f;
constexpr float THR2 = THR * 1.4426950408889634f;
#define MX3(a, b, c) __builtin_fmaxf(__builtin_fmaxf((a), (b)), (c))
__device__ __forceinline__ void softmaxT(f32x16& p0, f32x16& p1, float& mref, f32x16& negm, float& l_reg, float& alpha, bf16x8& pa0, bf16x8& pa1, bf16x8& pa2, bf16x8& pa3) {
  float a = MX3(p0[0], p0[1], p1[0]), b = MX3(p0[2], p0[3], p1[1]); a = MX3(a, p1[2], p1[3]);
#pragma unroll
  for (int r = 4; r < 16; r += 4) { a = MX3(a, p0[r], p0[r + 1]); b = MX3(b, p0[r + 2], p0[r + 3]); a = MX3(a, p1[r], p1[r + 1]); b = MX3(b, p1[r + 2], p1[r + 3]); }
  float pmax = __builtin_fmaxf(a, b);
  { auto rr = __builtin_amdgcn_permlane32_swap(__float_as_uint(pmax), __float_as_uint(pmax), false, false);
    pmax = __builtin_fmaxf(__uint_as_float(rr[0]), __uint_as_float(rr[1])); }
  if (__builtin_expect(__all(pmax <= THR2), 1)) { alpha = 1.f; }
  else { const float dl = __builtin_fmaxf(pmax, 0.f); mref += dl; alpha = __builtin_amdgcn_exp2f(-dl); l_reg *= alpha;
#pragma unroll
    for (int r = 0; r < 16; ++r) { p0[r] -= dl; p1[r] -= dl; negm[r] = -mref; }
    asm volatile("" : "+v"(negm)); }
#pragma unroll
  for (int r = 0; r < 16; ++r) { p0[r] = __builtin_amdgcn_exp2f(p0[r]); p1[r] = __builtin_amdgcn_exp2f(p1[r]); }
  { float s0 = p0[0] + p1[0], s1 = p0[1] + p1[1], s2 = p0[2] + p1[2], s3 = p0[3] + p1[3];
#pragma unroll
    for (int r = 4; r < 16; r += 4) { s0 += p0[r] + p1[r]; s1 += p0[r + 1] + p1[r + 1]; s2 += p0[r + 2] + p1[r + 2]; s3 += p0[r + 3] + p1[r + 3]; }
    l_reg += (s0 + s1) + (s2 + s3); }
#define PK4(P, BASE, OUT) do { unsigned a0 = cvtpk(P[BASE + 0], P[BASE + 1]), a1 = cvtpk(P[BASE + 2], P[BASE + 3]);   \
    unsigned b0 = cvtpk(P[BASE + 4], P[BASE + 5]), b1 = cvtpk(P[BASE + 6], P[BASE + 7]);                              \
    auto r0 = __builtin_amdgcn_permlane32_swap(a0, b0, false, false); auto r1 = __builtin_amdgcn_permlane32_swap(a1, b1, false, false); \
    u32x4 w = {r0[0], r1[0], r0[1], r1[1]}; OUT = __builtin_bit_cast(bf16x8, w); } while (0)
  PK4(p0, 0, pa0); PK4(p0, 8, pa1); PK4(p1, 0, pa2); PK4(p1, 8, pa3);
#undef PK4
}
__device__ __forceinline__ void partialSM(f32x16& p0, f32x16& p1, float& mref, f32x16& negm, float& alpha) {
  float a = MX3(p0[0], p0[1], p1[0]), b = MX3(p0[2], p0[3], p1[1]); a = MX3(a, p1[2], p1[3]);
#pragma unroll
  for (int r = 4; r < 16; r += 4) { a = MX3(a, p0[r], p0[r + 1]); b = MX3(b, p0[r + 2], p0[r + 3]); a = MX3(a, p1[r], p1[r + 1]); b = MX3(b, p1[r + 2], p1[r + 3]); }
  float pmax = __builtin_fmaxf(a, b);
  { auto rr = __builtin_amdgcn_permlane32_swap(__float_as_uint(pmax), __float_as_uint(pmax), false, false);
    pmax = __builtin_fmaxf(__uint_as_float(rr[0]), __uint_as_float(rr[1])); }
  if (__builtin_expect(__all(pmax <= THR2), 1)) { alpha = 1.f; }
  else { const float dl = __builtin_fmaxf(pmax, 0.f); mref += dl; alpha = __builtin_amdgcn_exp2f(-dl);
#pragma unroll
    for (int r = 0; r < 16; ++r) { p0[r] -= dl; p1[r] -= dl; negm[r] = -mref; }
    asm volatile("" : "+v"(negm)); }
#pragma unroll
  for (int r = 0; r < 16; ++r) p0[r] = __builtin_amdgcn_exp2f(p0[r]);
}
__device__ __forceinline__ void finishSM(f32x16& p0, f32x16& p1, float& l_reg, bf16x8& pa0, bf16x8& pa1, bf16x8& pa2, bf16x8& pa3) {
#pragma unroll
  for (int r = 0; r < 16; ++r) p1[r] = __builtin_amdgcn_exp2f(p1[r]);
  { float s0 = p0[0] + p1[0], s1 = p0[1] + p1[1], s2 = p0[2] + p1[2], s3 = p0[3] + p1[3];
#pragma unroll
    for (int r = 4; r < 16; r += 4) { s0 += p0[r] + p1[r]; s1 += p0[r + 1] + p1[r + 1]; s2 += p0[r + 2] + p1[r + 2]; s3 += p0[r + 3] + p1[r + 3]; }
    l_reg += (s0 + s1) + (s2 + s3); }
#define PK4(P, BASE, OUT) do { unsigned a0 = cvtpk(P[BASE + 0], P[BASE + 1]), a1 = cvtpk(P[BASE + 2], P[BASE + 3]);   \
    unsigned b0 = cvtpk(P[BASE + 4], P[BASE + 5]), b1 = cvtpk(P[BASE + 6], P[BASE + 7]);                              \
    auto r0 = __builtin_amdgcn_permlane32_swap(a0, b0, false, false); auto r1 = __builtin_amdgcn_permlane32_swap(a1, b1, false, false); \
    u32x4 w = {r0[0], r1[0], r0[1], r1[1]}; OUT = __builtin_bit_cast(bf16x8, w); } while (0)
  PK4(p0, 0, pa0); PK4(p0, 8, pa1); PK4(p1, 0, pa2); PK4(p1, 8, pa3);
#undef PK4
}
__device__ __forceinline__ void qkt(f32x16& p0, f32x16& p1, const LAS unsigned char* Ks, const bf16x8* qr, const f32x16& negm, int r32, int hi) {
  bf16x8 kf[12];
#pragma unroll
  for (int d0 = 0; d0 < 6; ++d0) { const int cb = (d0 * 16 + hi * 8) * 2;
    kf[2 * d0] = *(const LAS bf16x8*)(Ks + KSWZ(r32, cb)); kf[2 * d0 + 1] = *(const LAS bf16x8*)(Ks + KSWZ(32 + r32, cb)); }
  SBAR();
  p0 = __builtin_amdgcn_mfma_f32_32x32x16_bf16(kf[0], qr[0], negm, 0, 0, 0); p1 = __builtin_amdgcn_mfma_f32_32x32x16_bf16(kf[1], qr[0], negm, 0, 0, 0);
#pragma unroll
  for (int d0 = 1; d0 < 6; ++d0) { p0 = __builtin_amdgcn_mfma_f32_32x32x16_bf16(kf[2 * d0], qr[d0], p0, 0, 0, 0); p1 = __builtin_amdgcn_mfma_f32_32x32x16_bf16(kf[2 * d0 + 1], qr[d0], p1, 0, 0, 0); }
}
__device__ __forceinline__ int v_st(int k, int c) { const int kk = (k & ~0xC) | ((k & 4) << 1) | ((k & 8) >> 1); return ((kk >> 3) * 4 + (c >> 5)) * 512 + ((kk & 7) * 32 + (c & 31)) * 2; }
__device__ __forceinline__ int v_rd_base(int lane) { return ((lane & 3) << 3) | (((lane >> 2) & 3) << 6) | (((lane >> 4) & 1) << 5) | (((lane >> 5) & 1) << 8); }
constexpr int v_rd_off(int d0, int ks, int half) { return d0 * 512 + ks * 4096 + half * 2048; }
template <int OFF> __device__ __forceinline__ s16x4 tr_read(int vb) {
  s16x4 r; asm volatile("ds_read_b64_tr_b16 %0, %1 offset:%2" : "=&v"(r) : "v"(vb), "i"(OFF) : "memory"); return r;
}
__device__ __forceinline__ void pv_d0(f32x16* o, int vb, bf16x8 pa0, bf16x8 pa1, bf16x8 pa2, bf16x8 pa3) {
  const s16x4 a0 = tr_read<v_rd_off(0, 0, 0)>(vb), b0 = tr_read<v_rd_off(0, 0, 1)>(vb), a1 = tr_read<v_rd_off(0, 1, 0)>(vb), b1 = tr_read<v_rd_off(0, 1, 1)>(vb);
  const s16x4 a2 = tr_read<v_rd_off(0, 2, 0)>(vb), b2 = tr_read<v_rd_off(0, 2, 1)>(vb), a3 = tr_read<v_rd_off(0, 3, 0)>(vb), b3 = tr_read<v_rd_off(0, 3, 1)>(vb);
  const s16x4 c0 = tr_read<v_rd_off(1, 0, 0)>(vb), d0 = tr_read<v_rd_off(1, 0, 1)>(vb), c1 = tr_read<v_rd_off(1, 1, 0)>(vb), d1 = tr_read<v_rd_off(1, 1, 1)>(vb);
  const s16x4 c2 = tr_read<v_rd_off(1, 2, 0)>(vb), d2 = tr_read<v_rd_off(1, 2, 1)>(vb), c3 = tr_read<v_rd_off(1, 3, 0)>(vb), d3 = tr_read<v_rd_off(1, 3, 1)>(vb);
  asm volatile("s_waitcnt lgkmcnt(0)" ::: "memory"); SBAR();
#define PK(L, H) (bf16x8){L[0], L[1], L[2], L[3], H[0], H[1], H[2], H[3]}
  o[0] = __builtin_amdgcn_mfma_f32_32x32x16_bf16(pa0, PK(a0, b0), o[0], 0, 0, 0); o[1] = __builtin_amdgcn_mfma_f32_32x32x16_bf16(pa0, PK(c0, d0), o[1], 0, 0, 0);
  o[0] = __builtin_amdgcn_mfma_f32_32x32x16_bf16(pa1, PK(a1, b1), o[0], 0, 0, 0); o[1] = __builtin_amdgcn_mfma_f32_32x32x16_bf16(pa1, PK(c1, d1), o[1], 0, 0, 0);
  o[0] = __builtin_amdgcn_mfma_f32_32x32x16_bf16(pa2, PK(a2, b2), o[0], 0, 0, 0); o[1] = __builtin_amdgcn_mfma_f32_32x32x16_bf16(pa2, PK(c2, d2), o[1], 0, 0, 0);
  o[0] = __builtin_amdgcn_mfma_f32_32x32x16_bf16(pa3, PK(a3, b3), o[0], 0, 0, 0); o[1] = __builtin_amdgcn_mfma_f32_32x32x16_bf16(pa3, PK(c3, d3), o[1], 0, 0, 0);
#undef PK
}
__device__ __forceinline__ void attn_unit(const bf16_t* __restrict__ Qb, bool rope_q, int tq0, const bf16_t* __restrict__ KVh, const bf16_t* __restrict__ KR,
                                          int ctx_row0, int lat_row0, int NT, bf16_t* __restrict__ Ob, LAS unsigned char* lds, int wave_s) {
  int tid = wave_s * 64 + lane_id(); asm volatile("" : "+v"(tid));
  const int wid = tid >> 6, lane = tid & 63, r32 = lane & 31, hi = lane >> 5;
  LAS float* al_l = (LAS float*)(lds + OFF_WS) + wid * 64;
  float mref = 0.f, l_reg = 0.f; f32x16 o[2] = {}; f32x16 negm = {}; asm volatile("" : "+v"(negm)); bf16x8 qr[6];
  { const bf16_t* Qw = Qb + (long)(wid * QBLK + r32) * 768;
#pragma unroll
    for (int d0 = 0; d0 < 4; ++d0) { const u32x4 w = *(const u32x4*)(Qw + d0 * 16 + hi * 8);
      u32x4 s = {cvtpk(bflo(w.x) * C2, bfhi(w.x) * C2), cvtpk(bflo(w.y) * C2, bfhi(w.y) * C2), cvtpk(bflo(w.z) * C2, bfhi(w.z) * C2), cvtpk(bflo(w.w) * C2, bfhi(w.w) * C2)};
      qr[d0] = __builtin_bit_cast(bf16x8, s); }
    const int t = tq0 + wid * QBLK + r32;
#pragma unroll
    for (int a = 0; a < 2; ++a) {
      const u32x4 lo = *(const u32x4*)(Qw + 64 + a * 16), hh = *(const u32x4*)(Qw + 64 + a * 16 + 8);
      const float pos = (float)(a == 0 ? (t >> 6) : (t & 63)); float ov[8];
#pragma unroll
      for (int i = 0; i < 8; ++i) { const float ang = rope_q ? pos * rope_inv(i) : 0.f, c = __cosf(ang) * C2, s = __sinf(ang) * C2;
        const float l = (i & 1) ? bfhi(lo[i >> 1]) : bflo(lo[i >> 1]), h = (i & 1) ? bfhi(hh[i >> 1]) : bflo(hh[i >> 1]);
        ov[i] = hi ? (h * c + l * s) : (l * c - h * s); }
      u32x4 w = {cvtpk(ov[0], ov[1]), cvtpk(ov[2], ov[3]), cvtpk(ov[4], ov[5]), cvtpk(ov[6], ov[7])}; qr[4 + a] = __builtin_bit_cast(bf16x8, w);
    }
  }
  const int sr = tid >> 4, sc = (tid & 15) * 8, rr = (tid & 255) >> 2, rc = (tid & 3) * 8;
  const int st0 = (sc < 64) ? OFF_K + KSWZ(sr, sc * 2) : OFF_V + v_st(sr, sc - 64);
  const int st1 = (sc < 64) ? OFF_K + KSWZ(32 + sr, sc * 2) : OFF_V + v_st(32 + sr, sc - 64);
  const int st2 = OFF_K + KSWZ(rr, (64 + rc) * 2);
  const int vb0 = (int)(size_t)(lds + OFF_V) + v_rd_base(lane);
  struct { bf16x8 a0, a1, rp; } sg[2];
#define KROW(t) ((t) < 4 ? ctx_row0 + (t) * KVBLK : lat_row0 + ((t) - 4) * KVBLK)
#define SLOAD(i, t) do { const long k0_ = KROW(t); sg[i].a0 = *(const bf16x8*)(KVh + (k0_ + sr) * 1024 + sc); sg[i].a1 = *(const bf16x8*)(KVh + (k0_ + 32 + sr) * 1024 + sc); \
    sg[i].rp = *(const bf16x8*)(KR + (k0_ + rr) * 32 + rc); } while (0)
#define SWRITE_AT(boff, i) do { *(LAS bf16x8*)(lds + (boff) + st0) = sg[i].a0; *(LAS bf16x8*)(lds + (boff) + st1) = sg[i].a1; *(LAS bf16x8*)(lds + (boff) + st2) = sg[i].rp; } while (0)
#define RESC(a) do { if (__any((a) < 1.f)) { if (hi == 0) al_l[r32] = (a); asm volatile("s_waitcnt lgkmcnt(0)" ::: "memory"); \
    _Pragma("unroll") for (int r = 0; r < 16; ++r) { const float f_ = al_l[crow(r, hi)]; o[0][r] *= f_; o[1][r] *= f_; } } } while (0)
  const int trail = (wave_s >= 4) ? 1 : 0;
  const LAS unsigned char* Kb = lds + OFF_K;
  f32x16 p0, p1; float alpha; bf16x8 pa0, pa1, pa2, pa3;
  SLOAD(0, 0); SLOAD(1, 1);
  asm volatile("s_waitcnt vmcnt(3)" ::: "memory"); SWRITE_AT(0, 0);
  if (trail) { asm volatile("s_waitcnt vmcnt(0)" ::: "memory"); SWRITE_AT(BUFB, 1); SLOAD(1, 2); SLOAD(0, 3); }
  else { SLOAD(0, 2); }
  __syncthreads();
  if (trail) __syncthreads();
  int bV = 0, bK = 0, bN = BUFB, bNN = 2 * BUFB;
#define PHASE_M(j) do { SBAR(); __builtin_amdgcn_s_setprio(2); if ((j) > 0) pv_d0(o, vb0 + bV, pa0, pa1, pa2, pa3); qkt(p0, p1, Kb + bK, qr, negm, r32, hi); __builtin_amdgcn_s_setprio(0); SBAR(); __syncthreads(); } while (0)
#define PHASE_V(j, slot) do { softmaxT(p0, p1, mref, negm, l_reg, alpha, pa0, pa1, pa2, pa3); RESC(alpha); \
    { const int s_ = (j) + 1 + trail; if (s_ < NT) { asm volatile("s_waitcnt vmcnt(3)" ::: "memory"); SWRITE_AT(trail ? bNN : bN, slot); const int s2_ = s_ + 2; SLOAD(slot, s2_ < NT ? s2_ : NT - 1); } } \
    __syncthreads(); bV = bK; bK = bN; bN = bNN; bNN = bV; } while (0)
  for (int j = 0; j < NT; j += 2) {
    PHASE_M(j); PHASE_V(j, 1);
    PHASE_M(j + 1); PHASE_V(j + 1, 0);
  }
  SBAR(); pv_d0(o, vb0 + bV, pa0, pa1, pa2, pa3);
  if (!trail) __syncthreads();
#undef PHASE_M
#undef PHASE_V
  { auto rr_ = __builtin_amdgcn_permlane32_swap(__float_as_uint(l_reg), __float_as_uint(l_reg), false, false); l_reg = __uint_as_float(rr_[0]) + __uint_as_float(rr_[1]); }
  if (hi == 0) al_l[32 + r32] = l_reg; asm volatile("s_waitcnt lgkmcnt(0)" ::: "memory");
  float rli[16];
#pragma unroll
  for (int r = 0; r < 16; ++r) rli[r] = __builtin_amdgcn_rcpf(al_l[32 + crow(r, hi)]);
  bf16_t* Ow = Ob + (long)(wid * QBLK) * 1024;
#pragma unroll
  for (int r = 0; r < 16; ++r) { const int orow = crow(r, hi);
#pragma unroll
    for (int d0 = 0; d0 < 2; ++d0) Ow[(long)orow * 1024 + d0 * 32 + r32] = f2bf(o[d0][r] * rli[r]); }
  __syncthreads();
#undef KROW
#undef SLOAD
#undef SWRITE_AT
#undef RESC
}
}

constexpr int NLAT = 32768, NCTX = 1024, MTOT = 33792, DM = 1024, ZW = 1792, INW = 1696, SEQL = 8192, CTXL = 256, DFF = 4096;
constexpr float EPSN = 1e-6f;
constexpr size_t MiB = 1u << 20;
constexpr size_t WS_MOD = 1 * MiB;
constexpr size_t WS_W = 2 * MiB, W_LAYER = 23 * MiB;
constexpr size_t W_IN = 0, W_Q = 3584 * 1024, W_KV = 4 * MiB, W_O = 4608 * 1024, W_UP = 7 * MiB, W_DN = 15 * MiB;
constexpr size_t WS_A = 48 * MiB;
constexpr size_t WS_B = 114 * MiB;
constexpr size_t WS_Z = WS_B, WS_Q = WS_B + 116 * MiB, WS_KV = WS_B + 166 * MiB, WS_QN = WS_B + 232 * MiB, WS_KVN = WS_B + 249 * MiB, WS_KR = WS_B + 258 * MiB;
constexpr size_t WS_D = 378 * MiB;
constexpr size_t WS_XSC = 444 * MiB;
constexpr size_t WS_PART = 448 * MiB;
constexpr size_t WS_END = 512 * MiB;
static_assert((size_t)MTOT * ZW * 2 <= 116 * MiB && (size_t)MTOT * 768 * 2 <= 50 * MiB && (size_t)MTOT * 1024 * 2 <= 66 * MiB && (size_t)MTOT * 256 * 2 <= 17 * MiB && (size_t)MTOT * 128 * 2 <= 9 * MiB && WS_KR + (size_t)MTOT * 64 <= WS_B + 264 * MiB, "ws map");
constexpr int LDS_BYTES = 147456;

struct Params { const float* in[24]; float* out; unsigned char* ws; };
enum { I_X = 0, I_C, I_CTX, I_CCTX, I_WMOD, I_BMOD, I_GPREMIX, I_GPOSTMIX, I_GPREMLP, I_GPOSTMLP, I_WIN, I_GQ, I_WQB, I_GKV, I_WKVB, I_CDWW, I_CDWB, I_CLNG, I_CLNB, I_SDWW, I_GBR, I_WO, I_WUP, I_WDN };

__device__ __forceinline__ void transpose_item(const float* __restrict__ W, int K, int N, bf16_t* __restrict__ WT, LAS float* scr, int item, int lane) {
    const int nblk = N / 32, kb = item / nblk, nb = item % nblk, k0 = 64 * kb, n0 = 32 * nb;
#pragma unroll 8
    for (int i = 0; i < 32; ++i) { const int kk = 2 * i + (lane >> 5); scr[kk * 33 + (lane & 31)] = W[(size_t)(k0 + kk) * N + n0 + (lane & 31)]; }
    asm volatile("s_waitcnt lgkmcnt(0)" ::: "memory");
    const int c = lane & 7;
#pragma unroll
    for (int j = 0; j < 4; ++j) { const int n = (lane >> 3) + 8 * j; const LAS float* s = scr + (8 * c) * 33 + n;
        u32x4 o; o.x = cvtpk(s[0 * 33], s[1 * 33]); o.y = cvtpk(s[2 * 33], s[3 * 33]); o.z = cvtpk(s[4 * 33], s[5 * 33]); o.w = cvtpk(s[6 * 33], s[7 * 33]);
        *(u32x4*)(WT + (size_t)(n0 + n) * K + k0 + 8 * c) = o; }
    asm volatile("s_waitcnt lgkmcnt(0)" ::: "memory");
}
__device__ __forceinline__ void load16(const float* row, int lane, f32x4 (&v)[4]) {
#pragma unroll
    for (int j = 0; j < 4; ++j) v[j] = __builtin_nontemporal_load((const f32x4*)row + lane + 64 * j);
}
__device__ __forceinline__ void load16bf(const bf16_t* row, int lane, f32x4 (&v)[4]) {
#pragma unroll
    for (int j = 0; j < 4; ++j) { const u32x2 w = __builtin_nontemporal_load((const u32x2*)row + lane + 64 * j); v[j] = (f32x4){bflo(w.x), bfhi(w.x), bflo(w.y), bfhi(w.y)}; }
}
template <int NS> __device__ __forceinline__ void load16part(const float* P, int rowrel, int lane, f32x4 (&v)[4]) {
#pragma unroll
    for (int j = 0; j < 4; ++j) v[j] = (f32x4){0.f, 0.f, 0.f, 0.f};
#pragma unroll
    for (int s0 = 0; s0 < NS; s0 += 4) { f32x4 t[4][4];
#pragma unroll
        for (int s = 0; s < 4; ++s) { const f32x4* q = (const f32x4*)(P + ((size_t)(s0 + s) * 1024 + rowrel) * 1024);
#pragma unroll
            for (int j = 0; j < 4; ++j) t[s][j] = q[lane + 64 * j]; }
#pragma unroll
        for (int s = 0; s < 4; ++s)
#pragma unroll
            for (int j = 0; j < 4; ++j) v[j] += t[s][j]; }
}
__device__ __forceinline__ float ssq16(const f32x4 (&v)[4]) {
    float s = 0.f;
#pragma unroll
    for (int j = 0; j < 4; ++j) s += (v[j].x * v[j].x + v[j].y * v[j].y) + (v[j].z * v[j].z + v[j].w * v[j].w);
    return wave_sum(s);
}
__device__ __forceinline__ void prenorm_store(const f32x4 (&v)[4], float rinv, const float* g, const float* shift, const float* scale, bf16_t* orow, int lane) {
#pragma unroll
    for (int j = 0; j < 4; ++j) { const int q = lane + 64 * j; const f32x4 gg = ((const f32x4*)g)[q], sh = ((const f32x4*)shift)[q], sc = ((const f32x4*)scale)[q];
        const f32x4 h = (v[j] * rinv * gg) * (sc + 1.0f) + sh; u32x2 w; w.x = cvtpk(h.x, h.y); w.y = cvtpk(h.z, h.w); ((u32x2*)orow)[q] = w; }
}

#define XB_TMO      128
#define XB_XCNT(j)  (256  + 64 * (j))
#define XB_XSUB(j)  (1280 + 64 * (j))
#define XB_XGEN(j)  (2304 + 64 * (j))
#define XB_TOP      3328
#define XB_TOPGEN   3392
#define XCD_BAR_WORDS 3456
#define XB_SPIN_CAP (1u << 18)

__device__ __forceinline__ unsigned xb_ld(unsigned* p)              { return __hip_atomic_load(p, __ATOMIC_RELAXED, __HIP_MEMORY_SCOPE_AGENT); }
__device__ __forceinline__ unsigned xb_add(unsigned* p, unsigned v) { return __hip_atomic_fetch_add(p, v, __ATOMIC_RELAXED, __HIP_MEMORY_SCOPE_AGENT); }
__device__ __forceinline__ unsigned xb_xcc_id() { return (unsigned)__builtin_amdgcn_s_getreg((3 << 11) | 20) & 0xFu; }
#define XB_SPIN(cond, bar) do { unsigned _sp = 0; while (cond) { __builtin_amdgcn_s_sleep(1); \
    if ((++_sp & 255u) == 0u) { if (xb_ld(&(bar)[XB_TMO])) break; if (_sp > XB_SPIN_CAP) { atomicAdd(&(bar)[XB_TMO], 1u); break; } } } } while (0)

struct XcdBarrier { unsigned* bar; unsigned x; volatile LAS unsigned* st; };
__device__ __forceinline__ XcdBarrier xcd_barrier_post(unsigned* bar, volatile LAS unsigned* st, bool leader) {
    XcdBarrier b; b.bar = bar; b.x = xb_xcc_id(); b.st = st;
    if (leader) (void)xb_add(&bar[XB_XCNT(b.x)], 1u);
    return b;
}
__device__ __forceinline__ void xcd_barrier_complete(unsigned* bar, unsigned x, unsigned& nloc, unsigned& nx) {
    const unsigned G = gridDim.x * gridDim.y * gridDim.z;
    unsigned sum, cnt, mine, sp = 0u;
    for (;;) {
        sum = 0u; cnt = 0u; mine = 0u;
#pragma unroll
        for (unsigned j = 0; j < 16; ++j) { const unsigned c = xb_ld(&bar[XB_XCNT(j)]); sum += c; cnt += (c > 0u) ? 1u : 0u; mine = (j == x) ? c : mine; }
        if (sum == G) break;
        __builtin_amdgcn_s_sleep(1);
        if ((++sp & 255u) == 0u) { if (xb_ld(&bar[XB_TMO])) break; if (sp > XB_SPIN_CAP) { atomicAdd(&bar[XB_TMO], 1u); break; } }
    }
    nloc = mine > 0u ? mine : 1u; nx = cnt > 0u ? cnt : 1u;
}
__device__ __forceinline__ void xcd_barrier(const XcdBarrier& b, bool leader) {
    asm volatile("s_waitcnt vmcnt(0) lgkmcnt(0)" ::: "memory");
    __syncthreads();
    if (leader) {
        unsigned* bar = b.bar;
        __builtin_amdgcn_s_waitcnt(0);
        unsigned nloc = b.st[0], nx = b.st[1];
        if (nloc == 0u) { xcd_barrier_complete(bar, b.x, nloc, nx); b.st[0] = nloc; b.st[1] = nx; }
        const unsigned old = xb_add(&bar[XB_XSUB(b.x)], 1u);
        const unsigned gen = old / nloc;
        if (old + 1u == (gen + 1u) * nloc) {
            __builtin_amdgcn_fence(__ATOMIC_RELEASE, "agent");
            asm volatile("s_waitcnt vmcnt(0)" ::: "memory");
            const unsigned og = xb_add(&bar[XB_TOP], 1u);
            const unsigned tg = og / nx;
            if (og + 1u == (tg + 1u) * nx) xb_add(&bar[XB_TOPGEN], 1u);
            else XB_SPIN(xb_ld(&bar[XB_TOPGEN]) == tg, bar);
            __builtin_amdgcn_fence(__ATOMIC_ACQUIRE, "agent");
            xb_add(&bar[XB_XGEN(b.x)], 1u);
            asm volatile("s_waitcnt vmcnt(0)" ::: "memory");
        } else {
            XB_SPIN(xb_ld(&bar[XB_XGEN(b.x)]) == gen, bar);
            __builtin_amdgcn_fence(__ATOMIC_ACQUIRE, "agent");
            asm volatile("s_waitcnt vmcnt(0)" ::: "memory");
        }
    }
    __syncthreads();
}
#ifndef PROBE_R1_REPS
#define PROBE_R1_REPS 1
#endif
#ifndef PROBE_P1_REPS
#define PROBE_P1_REPS 1
#endif
#ifndef PROBE_P0_REPS
#define PROBE_P0_REPS 1
#endif
#ifndef PROBE_BAR_REPS
#define PROBE_BAR_REPS 1
#endif
#ifndef PROBE_GEMM_REPS
#define PROBE_GEMM_REPS 1
#endif
#ifndef PROBE_ATT_REPS
#define PROBE_ATT_REPS 1
#endif

__global__ void __launch_bounds__(512, 2) fwd_megakernel(Params p) {
    extern __shared__ __attribute__((aligned(16))) unsigned char lds_raw[];
    LAS unsigned char* lds = (LAS unsigned char*)lds_raw;
    const int wave = __builtin_amdgcn_readfirstlane(threadIdx.x >> 6);
    typedef const __attribute__((address_space(4))) Params* KP;
#define PHASE_IDS() int tid = wave * 64 + lane_id(); asm volatile("" : "+v"(tid)); int G = gridDim.x, blk = blockIdx.x; asm volatile("" : "+s"(G), "+s"(blk)); const int NGW = G * 8; const int lane = tid & 63; const int gw = blk * 8 + wave; (void)lane; (void)gw; (void)NGW; \
    KP pp = (KP)__builtin_amdgcn_kernarg_segment_ptr(); asm volatile("" : "+s"(pp)); unsigned char* ws = pp->ws; (void)ws;
#define PIN(i) (pp->in[i])
#define LOADY(m, y, ns) do { if ((m) >= NLAT) load16part<ns>(WSP(float, WS_PART), (m) - NLAT, lane, y); else load16bf(BY + (size_t)(m) * DM, lane, y); } while (0)
#define XBAR_WORDS ((unsigned*)((KP)__builtin_amdgcn_kernarg_segment_ptr())->ws)
#define XBAR_ST ((volatile LAS unsigned*)(lds + 131072 + 256))
#define GBAR() do { XcdBarrier xb_; xb_.bar = XBAR_WORDS; xb_.x = xb_xcc_id(); xb_.st = XBAR_ST; xcd_barrier(xb_, wave == 0 && lane_id() == 0); } while (0)
#define WSP(T, off) ((T*)(ws + (off)))
#define MOD WSP(float, WS_MOD)
#define BA WSP(bf16_t, WS_A)
#define BH WSP(bf16_t, WS_B)
#define BZ WSP(bf16_t, WS_Z)
#define BQ WSP(bf16_t, WS_Q)
#define BKV WSP(bf16_t, WS_KV)
#define BQN WSP(bf16_t, WS_QN)
#define BKVN WSP(bf16_t, WS_KVN)
#define BKR WSP(bf16_t, WS_KR)
#define BY WSP(bf16_t, WS_D)
#define XSC WSP(float, WS_XSC)
#define XS_ROW(m) ((m) < NLAT ? pp->out + (size_t)(m) * DM : XSC + (size_t)((m) - NLAT) * DM)
#define MOD_ROW(l, m) (MOD + ((l) * 5 + ((m) < NLAT ? (m) / SEQL : 4)) * 6144)

    for (int rp0_ = 0; rp0_ < PROBE_P0_REPS; ++rp0_) {
        PHASE_IDS();
        if (blk == 0) for (int i = tid; i < XCD_BAR_WORDS; i += 512) ((unsigned*)ws)[i] = 0u;
        if (tid < 2) ((LAS unsigned*)(lds + 131072 + 256))[tid] = 0u;
        LAS float* sil = (LAS float*)lds;
        LAS float* part = sil + 5 * 1024;
        for (int it = blk; it < 192; it += G) {
            const int l = it / 96, j0 = (it % 96) * 64;
            for (int i = tid; i < 5 * 1024; i += 512) { const int r = i >> 10, k = i & 1023; const float cv = r < 4 ? PIN(I_C)[r * 1024 + k] : PIN(I_CCTX)[k]; sil[i] = cv * sigmoidf_(cv); }
            __syncthreads();
            const int kg = tid >> 6, jc = tid & 63; const float* wm = PIN(I_WMOD) + (size_t)l * 1024 * 6144 + j0 + jc;
            float a0 = 0.f, a1 = 0.f, a2 = 0.f, a3 = 0.f, a4 = 0.f;
#pragma unroll 8
            for (int k = kg; k < 1024; k += 8) { const float w = wm[(size_t)k * 6144]; a0 += sil[k] * w; a1 += sil[1024 + k] * w; a2 += sil[2048 + k] * w; a3 += sil[3072 + k] * w; a4 += sil[4096 + k] * w; }
            part[(kg * 5 + 0) * 64 + jc] = a0; part[(kg * 5 + 1) * 64 + jc] = a1; part[(kg * 5 + 2) * 64 + jc] = a2; part[(kg * 5 + 3) * 64 + jc] = a3; part[(kg * 5 + 4) * 64 + jc] = a4;
            __syncthreads();
            if (tid < 320) { const int r = tid >> 6; float s = 0.f;
#pragma unroll
                for (int q = 0; q < 8; ++q) s += part[(q * 5 + r) * 64 + jc];
                MOD[(l * 5 + r) * 6144 + j0 + jc] = s + PIN(I_BMOD)[l * 6144 + j0 + jc]; }
            __syncthreads();
        }
        LAS float* scr = (LAS float*)(lds + 32768 + wave * 8704);
        constexpr int T_IN = 16 * 53, T_Q = 4 * 24, T_KV = 2 * 32, T_O = 16 * 32, T_UP = 16 * 128, T_DN = 64 * 32, T_L = T_IN + T_Q + T_KV + T_O + T_UP + T_DN;
        for (int it = gw; it < 2 * T_L; it += NGW) {
            const int l = it / T_L; int r = it % T_L; bf16_t* wl = (bf16_t*)(ws + WS_W + (size_t)l * W_LAYER);
            if (r < T_IN) { transpose_item(PIN(I_WIN) + (size_t)l * 1024 * INW, 1024, INW, (bf16_t*)((unsigned char*)wl + W_IN), scr, r, lane); continue; } r -= T_IN;
            if (r < T_Q) { transpose_item(PIN(I_WQB) + (size_t)l * 256 * 768, 256, 768, (bf16_t*)((unsigned char*)wl + W_Q), scr, r, lane); continue; } r -= T_Q;
            if (r < T_KV) { transpose_item(PIN(I_WKVB) + (size_t)l * 128 * 1024, 128, 1024, (bf16_t*)((unsigned char*)wl + W_KV), scr, r, lane); continue; } r -= T_KV;
            if (r < T_O) { transpose_item(PIN(I_WO) + (size_t)l * 1024 * 1024, 1024, 1024, (bf16_t*)((unsigned char*)wl + W_O), scr, r, lane); continue; } r -= T_O;
            if (r < T_UP) { transpose_item(PIN(I_WUP) + (size_t)l * 1024 * DFF, 1024, DFF, (bf16_t*)((unsigned char*)wl + W_UP), scr, r, lane); continue; } r -= T_UP;
            transpose_item(PIN(I_WDN) + (size_t)l * DFF * 1024, DFF, 1024, (bf16_t*)((unsigned char*)wl + W_DN), scr, r, lane);
        }
        for (int i = blk * 512 + tid; i < 2 * 96 * 128; i += G * 512) { const int l = i / (96 * 128), q = i % (96 * 128);
            ((u32x4*)(ws + WS_W + (size_t)l * W_LAYER + W_IN + (size_t)INW * 2048))[q] = (u32x4){0u, 0u, 0u, 0u}; }
    }
    cg::this_grid().sync();
    (void)xcd_barrier_post(XBAR_WORDS, XBAR_ST, wave == 0 && lane_id() == 0);
    { PHASE_IDS();
#define P1_SRC(m) ((m) < NLAT ? PIN(I_X) + (size_t)(m) * DM : PIN(I_CTX) + (size_t)((m) - NLAT) * DM)
#define P1_ROW(m, v) do { const float* mod = MOD_ROW(0, m); const float rinv = rsqrtf(ssq16(v) * (1.f / DM) + EPSN); prenorm_store(v, rinv, PIN(I_GPREMIX), mod, mod + 1024, BA + (size_t)(m) * DM, lane); } while (0)
    for (int m0 = gw; m0 < MTOT; m0 += 4 * NGW) { f32x4 vb[4][4];
#pragma unroll
        for (int i = 0; i < 4; ++i) { const int mi = m0 + i * NGW; load16(P1_SRC(mi < MTOT ? mi : m0), lane, vb[i]); }
#pragma unroll
        for (int i = 0; i < 4; ++i) { const int mi = m0 + i * NGW; if (mi < MTOT) P1_ROW(mi, vb[i]); } } }
    GBAR();

    for (int l = 0; l < 2; ++l) {
        const bool last = (l == 1);
#define WL (ws + WS_W + (size_t)l * W_LAYER)
        const int Mact = last ? NLAT : MTOT;
        for (int rep_ = 0; rep_ < PROBE_GEMM_REPS; ++rep_) { PHASE_IDS(); pg8::Gemm g{BA, (const bf16_t*)(WL + W_IN), MTOT, ZW, 1024, 1024}; pg8::StaticOrder S; S.init(MTOT, ZW, G, blk); pg8::EpiBf16<0> E{BZ, ZW};
          pg8::gemm_phase<pg8::EpiBf16<0>, pg8::StaticOrder, true, true>(lds, g, S, E, wave); }
        GBAR();
        for (int rr1_ = 0; rr1_ < PROBE_R1_REPS; ++rr1_) {
            PHASE_IDS();
            const float* gq = PIN(I_GQ) + l * 256; const float* gkv = PIN(I_GKV) + l * 128; const float* gbr = PIN(I_GBR) + l * 1024;
            const float* cw = PIN(I_CDWW) + l * 31 * 256; const float* cb = PIN(I_CDWB) + l * 256; const float* lng = PIN(I_CLNG) + l * 256; const float* lnb = PIN(I_CLNB) + l * 256;
            const float* sw = PIN(I_SDWW) + l * 3 * 256;
            LAS float* U = (LAS float*)lds;
            LAS float* WL_ = (LAS float*)(lds + 96256);
            for (int i = tid; i < 31 * 64; i += 512) *(LAS f32x4*)(WL_ + 4 * i) = ((const f32x4*)cw)[i];
            __syncthreads();
            const int lane_o = lane, tid_o = tid;
            for (int ti = blk; ti < 544; ti += G) {
                int tid = tid_o; asm volatile("" : "+v"(tid)); const int lane = tid & 63;
                int seq_base, seq_len, t0; bool is_lat;
                if (ti < 512) { seq_base = (ti >> 7) * SEQL; seq_len = SEQL; t0 = (ti & 127) * 64; is_lat = true; }
                else { const int tc = ti - 512; seq_base = NLAT + (tc >> 3) * CTXL; seq_len = CTXL; t0 = (tc & 7) * 32; is_lat = false; }
                const int TT = is_lat ? 64 : 32; const bool dead = last && !is_lat;
                const int urows = dead ? 0 : (TT + 30) * 32; const bool wact = wave * 8 < TT;
                if (!dead) { u32x4 ua[6], ug[6];
#pragma unroll
                  for (int i = 0; i < 6; ++i) { const int it = tid + 512 * i, rr = it >> 5, c8 = it & 31, t = t0 - 15 + rr; const bool ok = it < urows && t >= 0 && t < seq_len;
                      const bf16_t* zr = BZ + (size_t)(seq_base + (ok ? t : t0)) * ZW; ua[i] = *(const u32x4*)(zr + 416 + 8 * c8); ug[i] = *(const u32x4*)(zr + 672 + 8 * c8); if (!ok) ua[i] = (u32x4){0u, 0u, 0u, 0u}; }
#pragma unroll
                  for (int i = 0; i < 6; ++i) { const int it = tid + 512 * i, rr = it >> 5, c8 = it & 31; const u32x4 a = ua[i], gg = ug[i];
                      if (it < urows) {
                        const f32x4 u0 = {bflo(a.x) * sigmoidf_(bflo(gg.x)), bfhi(a.x) * sigmoidf_(bfhi(gg.x)), bflo(a.y) * sigmoidf_(bflo(gg.y)), bfhi(a.y) * sigmoidf_(bfhi(gg.y))};
                        const f32x4 u1 = {bflo(a.z) * sigmoidf_(bflo(gg.z)), bfhi(a.z) * sigmoidf_(bfhi(gg.z)), bflo(a.w) * sigmoidf_(bflo(gg.w)), bfhi(a.w) * sigmoidf_(bfhi(gg.w))};
                        *(LAS f32x4*)(U + rr * 256 + 8 * c8) = u0; *(LAS f32x4*)(U + rr * 256 + 8 * c8 + 4) = u1; } } }
                if (wact) { const int tw = t0 + wave * 8; const size_t mw = (size_t)seq_base + tw; const bf16_t* zw = BZ + mw * ZW;
                  u32x2 zq[8], bgt[8], cgt[10], hht[10]; unsigned kvv[8]; unsigned short krv[8];
#pragma unroll
                  for (int k8 = 0; k8 < 8; ++k8) { const bf16_t* zr = zw + (size_t)k8 * ZW; zq[k8] = *(const u32x2*)(zr + 4 * lane); kvv[k8] = *(const unsigned*)(zr + 256 + 2 * lane); krv[k8] = zr[384 + (lane & 31)];
                      bgt[k8] = *(const u32x2*)(zr + 928 + 4 * lane); }
#pragma unroll
                  for (int j = 0; j < 10; ++j) { const int tt = tw - 1 + j; const bool ok = tt >= 0 && tt < seq_len; const bf16_t* z2 = BZ + (size_t)(seq_base + (ok ? tt : tw)) * ZW;
                      cgt[j] = *(const u32x2*)(z2 + 1184 + 4 * lane); hht[j] = *(const u32x2*)(z2 + 1440 + 4 * lane); if (!ok) { cgt[j] = (u32x2){0u, 0u}; } }
                  const f32x4 gqv = ((const f32x4*)gq)[lane]; const float gk0 = gkv[2 * lane], gk1 = gkv[2 * lane + 1]; const f32x4 gsc = ((const f32x4*)(gbr + 768))[lane];
                  const f32x4 sw0 = ((const f32x4*)sw)[lane], sw1 = ((const f32x4*)(sw + 256))[lane], sw2 = ((const f32x4*)(sw + 512))[lane];
                  f32x4 pr[10];
#pragma unroll
                  for (int j = 0; j < 10; ++j) pr[j] = (f32x4){bflo(cgt[j].x) * bflo(hht[j].x), bfhi(cgt[j].x) * bfhi(hht[j].x), bflo(cgt[j].y) * bflo(hht[j].y), bfhi(cgt[j].y) * bfhi(hht[j].y)};
#pragma unroll
                  for (int k8 = 0; k8 < 8; ++k8) { const int t = tw + k8; const size_t m = mw + k8;
                    { const u32x2 w = zq[k8]; const f32x4 v = {bflo(w.x), bfhi(w.x), bflo(w.y), bfhi(w.y)};
                      const float ri = rsqrtf(wave_sum((v.x * v.x + v.y * v.y) + (v.z * v.z + v.w * v.w)) * (1.f / 256.f) + EPSN); const f32x4 o = v * ri * gqv;
                      u32x2 ow; ow.x = cvtpk(o.x, o.y); ow.y = cvtpk(o.z, o.w); *(u32x2*)(BQN + m * 256 + 4 * lane) = ow; }
                    { const unsigned w = kvv[k8]; const float v0 = bflo(w), v1 = bfhi(w);
                      const float ri = rsqrtf(wave_sum(v0 * v0 + v1 * v1) * (1.f / 128.f) + EPSN); *(unsigned*)(BKVN + m * 128 + 2 * lane) = cvtpk(v0 * ri * gk0, v1 * ri * gk1); }
                    { const int e = lane & 31; const float v = bf2f(krv[k8]); const float prn = swz_xor<8>(v); float o = v;
                      if (is_lat) { const int a = e >> 4, i = e & 15; const float pos = (float)(a == 0 ? (t >> 6) : (t & 63)); const float ang = pos * rope_inv(i & 7), c = __cosf(ang), s = __sinf(ang);
                          o = (i < 8) ? (v * c - prn * s) : (v * c + prn * s); }
                      if (lane < 32) BKR[m * 32 + e] = f2bf(o); }
                    { const f32x4 acc = pr[k8] * sw0 + pr[k8 + 1] * sw1 + pr[k8 + 2] * sw2; const u32x2 bg = bgt[k8];
                      const f32x4 s = {bflo(bg.x) * acc.x, bfhi(bg.x) * acc.y, bflo(bg.y) * acc.z, bfhi(bg.y) * acc.w};
                      const float ri = rsqrtf(wave_sum((s.x * s.x + s.y * s.y) + (s.z * s.z + s.w * s.w)) * (1.f / 256.f) + EPSN); const f32x4 o = s * ri * gsc;
                      u32x2 ow; ow.x = cvtpk(o.x, o.y); ow.y = cvtpk(o.z, o.w); *(u32x2*)(BA + m * DM + 768 + 4 * lane) = ow; }
                  }
                }
                __syncthreads();
                if (wact && !dead) { int lane = lane_o; asm volatile("" : "+v"(lane)); f32x4 wv[31];
#pragma unroll
                  for (int j = 0; j < 31; ++j) wv[j] = *(const LAS f32x4*)(WL_ + j * 256 + 4 * lane);
                  const f32x4 bias = ((const f32x4*)cb)[lane]; f32x4 acc[8];
#pragma unroll
                  for (int k = 0; k < 8; ++k) acc[k] = bias;
                  const LAS float* Ub = U + (wave * 8) * 256 + 4 * lane;
#pragma unroll
                  for (int i = 0; i < 38; ++i) { const f32x4 u = *(const LAS f32x4*)(Ub + i * 256);
#pragma unroll
                      for (int k = 0; k < 8; ++k) { const int j = i - k; if (j >= 0 && j < 31) acc[k] += u * wv[j]; } }
                  const f32x4 lg = ((const f32x4*)lng)[lane], lb = ((const f32x4*)lnb)[lane], gb = ((const f32x4*)(gbr + 512))[lane];
#pragma unroll
                  for (int k = 0; k < 8; ++k) { const f32x4 a = acc[k]; const float mean = wave_sum((a.x + a.y) + (a.z + a.w)) * (1.f / 256.f); const f32x4 d = a - mean;
                      const float rstd = rsqrtf(wave_sum((d.x * d.x + d.y * d.y) + (d.z * d.z + d.w * d.w)) * (1.f / 256.f) + EPSN); f32x4 y = d * rstd * lg + lb;
                      y = (f32x4){y.x * sigmoidf_(y.x), y.y * sigmoidf_(y.y), y.z * sigmoidf_(y.z), y.w * sigmoidf_(y.w)};
                      const float ri = rsqrtf(wave_sum((y.x * y.x + y.y * y.y) + (y.z * y.z + y.w * y.w)) * (1.f / 256.f) + EPSN); const f32x4 o = y * ri * gb;
                      u32x2 ow; ow.x = cvtpk(o.x, o.y); ow.y = cvtpk(o.z, o.w); *(u32x2*)(BA + ((size_t)seq_base + t0 + wave * 8 + k) * DM + 512 + 4 * lane) = ow; } }
                __syncthreads();
            }
        }
        GBAR();
        for (int rep_ = 0; rep_ < PROBE_GEMM_REPS; ++rep_) { PHASE_IDS(); pg8::Gemm g{BQN, (const bf16_t*)(WL + W_Q), MTOT, 768, 256, 256}; pg8::StaticOrder S; S.init(MTOT, 768, G, blk); pg8::EpiBf16<0> E{BQ, 768};
          pg8::gemm_phase<pg8::EpiBf16<0>, pg8::StaticOrder, true, true>(lds, g, S, E, wave); }
        for (int rep_ = 0; rep_ < PROBE_GEMM_REPS; ++rep_) { PHASE_IDS(); pg8::Gemm g{BKVN, (const bf16_t*)(WL + W_KV), MTOT, 1024, 128, 128}; pg8::StaticOrder S; S.init(MTOT, 1024, G, blk); pg8::EpiBf16<0> E{BKV, 1024};
          pg8::gemm_phase<pg8::EpiBf16<0>, pg8::StaticOrder, true, true>(lds, g, S, E, wave); }
        GBAR();
        {
            PHASE_IDS();
            const int nunits = last ? 1024 : 1056;
            for (int rep_ = 0; rep_ < PROBE_ATT_REPS; ++rep_)
            for (int u = blk; u < nunits; u += G) {
                if (u < 1024) { const int bh = (u & 7) + 8 * (u >> 8), qb = (u >> 3) & 31, b = bh >> 3, h = bh & 7; const int q0 = b * SEQL + qb * 256;
                    att::attn_unit(BQ + (size_t)q0 * 768 + h * 96, true, qb * 256, BKV + h * 128, BKR, NLAT + b * CTXL, b * SEQL, 132, BA + (size_t)q0 * DM + h * 64, lds, wave); }
                else { const int uc = u - 1024, b = uc >> 3, h = uc & 7; const int q0 = NLAT + b * CTXL;
                    att::attn_unit(BQ + (size_t)q0 * 768 + h * 96, false, 0, BKV + h * 128, BKR, q0, 0, 4, BA + (size_t)q0 * DM + h * 64, lds, wave); }
            }
        }
        GBAR();
        { PHASE_IDS(); const float* gbr = PIN(I_GBR) + l * 1024; const f32x4 g0 = ((const f32x4*)gbr)[2 * lane], g1 = ((const f32x4*)gbr)[2 * lane + 1];
          for (int m0 = gw; m0 < Mact; m0 += 4 * NGW) { u32x4 w[4];
#pragma unroll
              for (int i = 0; i < 4; ++i) { const int m = m0 + i * NGW; w[i] = ((const u32x4*)(BA + (size_t)(m < Mact ? m : m0) * DM))[lane]; }
#pragma unroll
              for (int i = 0; i < 4; ++i) { const int m = m0 + i * NGW; if (m < Mact) {
                  const float v[8] = {bflo(w[i].x), bfhi(w[i].x), bflo(w[i].y), bfhi(w[i].y), bflo(w[i].z), bfhi(w[i].z), bflo(w[i].w), bfhi(w[i].w)}; float s = 0.f;
#pragma unroll
                  for (int q = 0; q < 8; ++q) s += v[q] * v[q];
                  const float ri = rsqrtf(wave_sum(s) * (1.f / 512.f) + EPSN);
                  u32x4 o; o.x = cvtpk(v[0] * ri * g0.x, v[1] * ri * g0.y); o.y = cvtpk(v[2] * ri * g0.z, v[3] * ri * g0.w); o.z = cvtpk(v[4] * ri * g1.x, v[5] * ri * g1.y); o.w = cvtpk(v[6] * ri * g1.z, v[7] * ri * g1.w);
                  ((u32x4*)(BA + (size_t)m * DM))[lane] = o; } } } }
        GBAR();
        { PHASE_IDS(); pg8::Gemm g{BA, (const bf16_t*)(WL + W_O), NLAT, 1024, 1024, 1024}; pg8::StaticOrder S; S.init(NLAT, 1024, G, blk); pg8::EpiBf16<0> E{BY, 1024};
          pg8::gemm_phase<pg8::EpiBf16<0>, pg8::StaticOrder, true, true>(lds, g, S, E, wave); }
        if (!last) { PHASE_IDS(); pg8::Gemm g{BA, (const bf16_t*)(WL + W_O), MTOT, 1024, 256, 1024}; pg8::SplitOrder S; S.init(4, 4, 4, 128, G, blk); pg8::EpiF32Part E{WSP(float, WS_PART), 1024, 128, (size_t)1024 * 1024};
          pg8::gemm_phase<pg8::EpiF32Part, pg8::SplitOrder, true, true>(lds, g, S, E, wave); }
        GBAR();
        { PHASE_IDS(); const float* gp = PIN(I_GPOSTMIX) + l * DM; const float* gm = PIN(I_GPREMLP) + l * DM;
#define R3_SRC(m) ((l == 0) ? ((m) < NLAT ? PIN(I_X) + (size_t)(m) * DM : PIN(I_CTX) + (size_t)((m) - NLAT) * DM) : (const float*)XS_ROW(m))
#define R3_ROW(m, y, x) do { const float* mod = MOD_ROW(l, m); float* dst = XS_ROW(m); const float ry = rsqrtf(ssq16(y) * (1.f / DM) + EPSN); \
            _Pragma("unroll") for (int j = 0; j < 4; ++j) { const int q = lane + 64 * j; x[j] = x[j] + ((const f32x4*)(mod + 2048))[q] * (y[j] * ry * ((const f32x4*)gp)[q]); __builtin_nontemporal_store(x[j], (f32x4*)dst + q); } \
            const float r1 = rsqrtf(ssq16(x) * (1.f / DM) + EPSN); prenorm_store(x, r1, gm, mod + 3072, mod + 4096, BA + (size_t)(m) * DM, lane); } while (0)
        for (int m0 = gw; m0 < Mact; m0 += 4 * NGW) { f32x4 yb[4][4], xb[4][4];
#pragma unroll
            for (int i = 0; i < 4; ++i) { const int mi = m0 + i * NGW, mc = mi < Mact ? mi : m0; LOADY(mc, yb[i], 4); load16(R3_SRC(mc), lane, xb[i]); }
#pragma unroll
            for (int i = 0; i < 4; ++i) { const int mi = m0 + i * NGW; if (mi < Mact) R3_ROW(mi, yb[i], xb[i]); } } }
        GBAR();
        for (int rep_ = 0; rep_ < PROBE_GEMM_REPS; ++rep_) { PHASE_IDS(); pg8::Gemm g{BA, (const bf16_t*)(WL + W_UP), Mact, DFF, 1024, 1024}; pg8::StaticOrder S; S.init(Mact, DFF, G, blk); pg8::EpiBf16<2> E{BH, DFF};
          pg8::gemm_phase<pg8::EpiBf16<2>, pg8::StaticOrder, true, true>(lds, g, S, E, wave); }
        GBAR();
        { PHASE_IDS(); pg8::Gemm g{BH, (const bf16_t*)(WL + W_DN), NLAT, 1024, DFF, DFF}; pg8::StaticOrder S; S.init(NLAT, 1024, G, blk); S.rev = true; pg8::EpiBf16<0> E{BY, 1024};
          pg8::gemm_phase<pg8::EpiBf16<0>, pg8::StaticOrder, true, true>(lds, g, S, E, wave); }
        if (!last) { PHASE_IDS(); pg8::Gemm g{BH, (const bf16_t*)(WL + W_DN), MTOT, 1024, 256, DFF}; pg8::SplitOrder S; S.init(4, 4, 16, 128, G, blk); pg8::EpiF32Part E{WSP(float, WS_PART), 1024, 128, (size_t)1024 * 1024};
          pg8::gemm_phase<pg8::EpiF32Part, pg8::SplitOrder, true, true>(lds, g, S, E, wave); }
        GBAR();
        { PHASE_IDS(); const float* gp = PIN(I_GPOSTMLP) + l * DM; const float* gn = PIN(I_GPREMIX) + (last ? 0 : (l + 1) * DM);
#define R4_ROW(m, y, x) do { const float* mod = MOD_ROW(l, m); float* xr = XS_ROW(m); const float ry = rsqrtf(ssq16(y) * (1.f / DM) + EPSN); \
            _Pragma("unroll") for (int j = 0; j < 4; ++j) { const int q = lane + 64 * j; x[j] = x[j] + ((const f32x4*)(mod + 5120))[q] * (y[j] * ry * ((const f32x4*)gp)[q]); __builtin_nontemporal_store(x[j], (f32x4*)xr + q); } \
            if (!last) { const float* mod1 = MOD_ROW(l + 1, m); const float r1 = rsqrtf(ssq16(x) * (1.f / DM) + EPSN); prenorm_store(x, r1, gn, mod1, mod1 + 1024, BA + (size_t)(m) * DM, lane); } } while (0)
        for (int m0 = gw; m0 < Mact; m0 += 4 * NGW) { f32x4 yb[4][4], xb[4][4];
#pragma unroll
            for (int i = 0; i < 4; ++i) { const int mi = m0 + i * NGW, mc = mi < Mact ? mi : m0; LOADY(mc, yb[i], 16); load16(XS_ROW(mc), lane, xb[i]); }
#pragma unroll
            for (int i = 0; i < 4; ++i) { const int mi = m0 + i * NGW; if (mi < Mact) R4_ROW(mi, yb[i], xb[i]); } } }
        if (!last) GBAR();
    }
}

extern "C" void kernel_launch(void* const* d_in, const int* in_sizes, int n_in, void* d_out, int out_size, void* d_ws, size_t ws_size, hipStream_t stream) {
    static int grid_blocks = 0;
    if (grid_blocks == 0) {
        if (n_in != 24 || out_size != NLAT * DM || ws_size < WS_END) { fprintf(stderr, "kernel_launch: unexpected shapes n_in %d out %d ws %zu\n", n_in, out_size, ws_size); grid_blocks = -1; return; }
        int dev = 0, cus = 0, per_cu = 0;
        hipGetDevice(&dev); hipDeviceGetAttribute(&cus, hipDeviceAttributeMultiprocessorCount, dev);
        if (hipFuncSetAttribute((const void*)fwd_megakernel, hipFuncAttributeMaxDynamicSharedMemorySize, LDS_BYTES) != hipSuccess) { fprintf(stderr, "kernel_launch: hipFuncSetAttribute failed\n"); grid_blocks = -1; return; }
        if (hipOccupancyMaxActiveBlocksPerMultiprocessor(&per_cu, (const void*)fwd_megakernel, 512, LDS_BYTES) != hipSuccess || per_cu < 1) { fprintf(stderr, "kernel_launch: occupancy query says %d\n", per_cu); per_cu = 1; (void)hipGetLastError(); }
        grid_blocks = cus * per_cu;
    }
    if (grid_blocks < 0) return;
    Params p{};
    for (int i = 0; i < 24; ++i) p.in[i] = (const float*)d_in[i];
    p.out = (float*)d_out; p.ws = (unsigned char*)d_ws;
    void* args[] = {&p};
    hipError_t e = hipLaunchCooperativeKernel((const void*)fwd_megakernel, dim3(grid_blocks), dim3(512), args, LDS_BYTES, stream);
    if (e != hipSuccess) fprintf(stderr, "cooperative launch failed: %s (grid %d)\n", hipGetErrorString(e), grid_blocks);
}
```

```cpp
#include <hip/hip_runtime.h>
#include <hip/hip_cooperative_groups.h>
#include <cstdio>
#include <cstdint>
namespace cg = cooperative_groups;
namespace pg8 {
#define PG8_LAS __attribute__((address_space(3)))
typedef unsigned short bf16_t;
typedef short bf16x8 __attribute__((ext_vector_type(8)));
typedef float f32x4 __attribute__((ext_vector_type(4)));
typedef unsigned u32x4 __attribute__((ext_vector_type(4)));
constexpr int BM = 256, BK = 64, HALF = 128, HTB = HALF * BK * 2  , STAGE_BYTES = 8 * HTB, NXCD = 8, WGM = 8;

__host__ __device__ __forceinline__ int lds_byte(int r, int c) { const int st = (r >> 4) * 2 + (c >> 5), rr = r & 15, cc = c & 31, ob = rr * 64 + cc * 2; return st * 1024 + (ob ^ (((ob >> 9) & 1) << 5)); }
__host__ __device__ __forceinline__ void stage_rc(int b, int& R, int& C) { const int st = b / 1024, sb = b % 1024, swz = sb ^ (((sb >> 9) & 1) << 5); R = (st >> 1) * 16 + swz / 64; C = (st & 1) * 32 + (swz % 64) / 2; }
__host__ __device__ __forceinline__ int perm32(int rho) { const int n = rho >> 4, i = rho & 15; return 8 * (i >> 2) + 4 * n + (i & 3); }

struct Unit { int pm, pn, kq; };
struct Gemm { const bf16_t* A; const bf16_t* Bt; int M, N, K, ld; };

struct StaticOrder {
    int nM, nN, nwg, G, c; bool rev = false;
    __host__ __device__ void init(int M, int N, int G_, int c_) { nM = M / BM; nN = N / BM; nwg = nM * nN; G = G_; c = c_; }
    __host__ __device__ bool next(int i, Unit& u) const {
        const long L = (long)i * G + c; if (L >= nwg) return false;
        int wgid = (int)L; { const int q = nwg / NXCD, r = nwg % NXCD, xcd = wgid % NXCD, off = wgid / NXCD; wgid = (xcd < r ? xcd * (q + 1) : r * (q + 1) + (xcd - r) * q) + off; }
        const int nig = WGM * nN, gid = wgid / nig, fm = gid * WGM, gsz = (nM - fm) < WGM ? (nM - fm) : WGM;
        u.pm = fm + ((wgid % nig) % gsz); u.pn = (wgid % nig) / gsz; u.kq = 0; if (rev) u.pm = nM - 1 - u.pm; return true;
    }
    __device__ __forceinline__ void a_ready(const Unit&) const {}
    __device__ __forceinline__ void done(const Unit&) const {}
};
struct SplitOrder {
    int nN, nsplit, mt0, total, G, c;
    __host__ __device__ void init(int nMt, int nN_, int nsplit_, int mt0_, int G_, int c_) { nN = nN_; nsplit = nsplit_; mt0 = mt0_; total = nMt * nN_ * nsplit_; G = G_; c = c_; }
    __host__ __device__ bool next(int i, Unit& u) const { const int L = i * G + c; if (L >= total) return false; u.kq = L % nsplit; const int t = L / nsplit; u.pn = t % nN; u.pm = mt0 + t / nN; return true; }
    __device__ __forceinline__ void a_ready(const Unit&) const {}
    __device__ __forceinline__ void done(const Unit&) const {}
};

__device__ __forceinline__ unsigned cvt_pk_bf16(float lo, float hi) { unsigned r; asm volatile("v_cvt_pk_bf16_f32 %0, %1, %2" : "=v"(r) : "v"(lo), "v"(hi)); return r; }
typedef float f32x2 __attribute__((ext_vector_type(2)));
template <int ACT> struct EpiBf16 {
    static constexpr bool PERM = true, AFTER_DRAIN = false;
    bf16_t* O; int ldc;
    __device__ __forceinline__ void operator()(const f32x4 (&acc)[2][2][4][2], const Unit& u, int wr, int wc, int fr, int fq) const {
        const int row0 = u.pm * BM + wr * 64 + fr; const int col0 = u.pn * BM + wc * 32 + 8 * fq;
#pragma unroll
        for (int ai = 0; ai < 2; ++ai)
#pragma unroll
            for (int m = 0; m < 4; ++m) { bf16_t* rowp = O + (size_t)(row0 + ai * HALF + m * 16) * ldc + col0;
#pragma unroll
                for (int bj = 0; bj < 2; ++bj) { f32x4 v0 = acc[ai][bj][m][0], v1 = acc[ai][bj][m][1];
                    if (ACT == 2) {
#pragma unroll
                        for (int e = 0; e < 4; ++e) { float a = fmaxf(v0[e], 0.f), b = fmaxf(v1[e], 0.f); v0[e] = a * a; v1[e] = b * b; } }
                    u32x4 w; w.x = cvt_pk_bf16(v0[0], v0[1]); w.y = cvt_pk_bf16(v0[2], v0[3]); w.z = cvt_pk_bf16(v1[0], v1[1]); w.w = cvt_pk_bf16(v1[2], v1[3]);
                    *(u32x4*)(rowp + bj * HALF) = w; } }
    }
};
struct EpiF32Part {
    static constexpr bool PERM = true, AFTER_DRAIN = false;
    float* P; int ldc; int mt0; size_t slice;
    __device__ __forceinline__ void operator()(const f32x4 (&acc)[2][2][4][2], const Unit& u, int wr, int wc, int fr, int fq) const {
        const int row0 = (u.pm - mt0) * BM + wr * 64 + fr; const int col0 = u.pn * BM + wc * 32 + 8 * fq; float* base = P + (size_t)u.kq * slice;
#pragma unroll
        for (int ai = 0; ai < 2; ++ai)
#pragma unroll
            for (int m = 0; m < 4; ++m) { float* rowp = base + (size_t)(row0 + ai * HALF + m * 16) * ldc + col0;
#pragma unroll
                for (int bj = 0; bj < 2; ++bj) { *(f32x4*)(rowp + bj * HALF) = acc[ai][bj][m][0]; *(f32x4*)(rowp + bj * HALF + 4) = acc[ai][bj][m][1]; } }
    }
};
template <class Epi, class Sched, bool ALIGN_EPI = false, bool SP2 = false>
__device__ __forceinline__ void gemm_phase(PG8_LAS unsigned char* lds, const Gemm g, const Sched& S, const Epi& E, int wave_s) {
    int tid = wave_s * 64 + (int)__builtin_amdgcn_mbcnt_hi(~0u, __builtin_amdgcn_mbcnt_lo(~0u, 0u)); asm volatile("" : "+v"(tid));
    const int wid = __builtin_amdgcn_readfirstlane(tid >> 6), lane = tid & 63, wr = wid >> 2, wc = wid & 3, fr = lane & 15, fq = lane >> 4;
    const int K = g.K, LD = g.ld, nt = K / BK;
    unsigned voffA[2], voffB[2];
#pragma unroll
    for (int i = 0; i < 2; ++i) { int R, C; stage_rc(tid * 16 + i * 8192, R, C); const int Rb = Epi::PERM ? ((R & ~31) + perm32(R & 31)) : R;
        voffA[i] = (unsigned)(R * LD + C) * 2u; voffB[i] = (unsigned)(Rb * LD + C) * 2u; }
    const size_t kstep = (size_t)(BK * 2);
    const size_t hstep = (size_t)HALF * LD * 2;
    const size_t tstep = 2 * hstep;
    const unsigned ldsw = (unsigned)wid * 1024u;
    const int aoff = lds_byte(wr * 64 + fr, fq * 8), boff = lds_byte(wc * 32 + fr, fq * 8);
#define PG8_SA(b, h) (((b) * 2 + (h)) * HTB)
#define PG8_SB(b, h) ((4 + (b) * 2 + (h)) * HTB)
#define PG8_STAGE(bufoff, gbase, voff) do { _Pragma("unroll") for (int _i = 0; _i < 2; ++_i) \
        __builtin_amdgcn_global_load_lds((const unsigned*)((const char*)(gbase) + (voff)[_i]), (PG8_LAS unsigned*)(lds + (bufoff) + ldsw + _i * 8192), 16, 0, 0); } while (0)
#define PG8_LDA(dst, b, h) do { _Pragma("unroll") for (int m = 0; m < 4; ++m) _Pragma("unroll") for (int k = 0; k < 2; ++k) dst[m][k] = *(const PG8_LAS bf16x8*)(lds + PG8_SA(b, h) + aoff + m * 2048 + k * 1024); } while (0)
#define PG8_LDB(dst, b, h) do { _Pragma("unroll") for (int n = 0; n < 2; ++n) _Pragma("unroll") for (int k = 0; k < 2; ++k) dst[n][k] = *(const PG8_LAS bf16x8*)(lds + PG8_SB(b, h) + boff + n * 2048 + k * 1024); } while (0)
#define PG8_MMA(ai, bj, At, Bt) do { __builtin_amdgcn_s_setprio(1); _Pragma("unroll") for (int m = 0; m < 4; ++m) _Pragma("unroll") for (int n = 0; n < 2; ++n) _Pragma("unroll") for (int k = 0; k < 2; ++k) \
        acc[ai][bj][m][n] = __builtin_amdgcn_mfma_f32_16x16x32_bf16(Bt[n][k], At[m][k], acc[ai][bj][m][n], 0, 0, 0); __builtin_amdgcn_s_setprio(0); } while (0)
#define PG8_WAIT_V(n) asm volatile("s_waitcnt vmcnt(" #n ")" ::: "memory")
#define PG8_WAIT_L(n) asm volatile("s_waitcnt lgkmcnt(" #n ")" ::: "memory")
#define PG8_BAR __builtin_amdgcn_s_barrier()
#define PG8_SCHED __builtin_amdgcn_sched_barrier(0)
    Unit cur, nxt; int ui = 0;
    if (!S.next(0, cur)) return;
    f32x4 acc[2][2][4][2];
#pragma unroll
    for (int a = 0; a < 2; ++a)
#pragma unroll
        for (int b = 0; b < 2; ++b)
#pragma unroll
            for (int m = 0; m < 4; ++m)
#pragma unroll
                for (int n = 0; n < 2; ++n) acc[a][b][m][n] = (f32x4){0.f, 0.f, 0.f, 0.f};
    bf16x8 At[4][2], B0[2][2], B1[2][2];
    const size_t kqstep = (size_t)K * 2;
    const char* cA = (const char*)g.A + (size_t)cur.pm * tstep + (size_t)cur.kq * kqstep; const char* cB = (const char*)g.Bt + (size_t)cur.pn * tstep + (size_t)cur.kq * kqstep;
    S.a_ready(cur);
    if constexpr (SP2) {
        PG8_STAGE(PG8_SB(0, 0), cB, voffB); PG8_STAGE(PG8_SB(0, 1), cB + hstep, voffB); PG8_STAGE(PG8_SA(0, 0), cA, voffA); PG8_STAGE(PG8_SA(0, 1), cA + hstep, voffA);
        if (wr == 1) PG8_BAR;
        PG8_WAIT_V(2); PG8_BAR;
        PG8_STAGE(PG8_SB(1, 0), cB + kstep, voffB); PG8_STAGE(PG8_SA(1, 0), cA + kstep, voffA); PG8_STAGE(PG8_SB(1, 1), cB + hstep + kstep, voffB);
        PG8_WAIT_V(6); PG8_BAR;
    } else {
        PG8_STAGE(PG8_SB(0, 0), cB, voffB); PG8_STAGE(PG8_SA(0, 0), cA, voffA); PG8_STAGE(PG8_SB(0, 1), cB + hstep, voffB); PG8_STAGE(PG8_SA(0, 1), cA + hstep, voffA);
        if (wr == 1) PG8_BAR;
        PG8_WAIT_V(4); PG8_BAR;
        PG8_STAGE(PG8_SB(1, 0), cB + kstep, voffB); PG8_STAGE(PG8_SA(1, 0), cA + kstep, voffA); PG8_STAGE(PG8_SB(1, 1), cB + hstep + kstep, voffB);
        PG8_WAIT_V(6); PG8_BAR;
    }
    for (;;) {
        const bool has_next = S.next(ui + 1, nxt);
        const char* nA = has_next ? (const char*)g.A + (size_t)nxt.pm * tstep + (size_t)nxt.kq * kqstep : cA; const char* nB = has_next ? (const char*)g.Bt + (size_t)nxt.pn * tstep + (size_t)nxt.kq * kqstep : cB;
        for (int t = 0; t < nt; t += 2) {
            const bool last = (t == nt - 2);
            const char* a1 = cA + (size_t)(t + 1) * kstep;
            const char* a2 = last ? nA : cA + (size_t)(t + 2) * kstep; const char* b2 = last ? nB : cB + (size_t)(t + 2) * kstep;
            const char* a3 = a2 + kstep; const char* b3 = b2 + kstep;
            if (last && has_next) S.a_ready(nxt);
            if constexpr (SP2) {
            PG8_LDB(B0, 0, 0); PG8_LDB(B1, 0, 1); PG8_SCHED; PG8_LDA(At, 0, 0); PG8_STAGE(PG8_SA(1, 1), a1 + hstep, voffA);
            PG8_WAIT_V(8); PG8_WAIT_L(0); PG8_BAR; PG8_MMA(0, 0, At, B0); PG8_MMA(0, 1, At, B1); PG8_BAR; PG8_SCHED;
            PG8_LDA(At, 0, 1); PG8_STAGE(PG8_SB(0, 0), b2, voffB); PG8_STAGE(PG8_SB(0, 1), b2 + hstep, voffB); PG8_STAGE(PG8_SA(0, 0), a2, voffA);
            PG8_WAIT_V(8); PG8_WAIT_L(0); PG8_BAR; PG8_MMA(1, 0, At, B0); PG8_MMA(1, 1, At, B1); PG8_BAR; PG8_SCHED;
            PG8_LDB(B0, 1, 0); PG8_LDB(B1, 1, 1); PG8_SCHED; PG8_LDA(At, 1, 0); PG8_STAGE(PG8_SA(0, 1), a2 + hstep, voffA);
            PG8_WAIT_V(8); PG8_WAIT_L(0); PG8_BAR; PG8_MMA(0, 0, At, B0); PG8_MMA(0, 1, At, B1); PG8_BAR; PG8_SCHED;
            PG8_LDA(At, 1, 1); PG8_STAGE(PG8_SB(1, 0), b3, voffB); PG8_STAGE(PG8_SB(1, 1), b3 + hstep, voffB); PG8_STAGE(PG8_SA(1, 0), a3, voffA);
            PG8_WAIT_V(8); PG8_WAIT_L(0); PG8_BAR; PG8_MMA(1, 0, At, B0); PG8_MMA(1, 1, At, B1); PG8_BAR; PG8_SCHED;
            } else {
            PG8_LDB(B0, 0, 0); PG8_SCHED; PG8_LDA(At, 0, 0); PG8_STAGE(PG8_SA(1, 1), a1 + hstep, voffA);
            PG8_WAIT_L(8); PG8_BAR; PG8_WAIT_L(0); PG8_MMA(0, 0, At, B0); PG8_BAR; PG8_SCHED;
            PG8_LDB(B1, 0, 1); PG8_STAGE(PG8_SB(0, 0), b2, voffB);
            PG8_BAR; PG8_WAIT_L(0); PG8_MMA(0, 1, At, B1); PG8_BAR;
            PG8_LDA(At, 0, 1); PG8_STAGE(PG8_SA(0, 0), a2, voffA);
            PG8_BAR; PG8_WAIT_L(0); PG8_MMA(1, 0, At, B0); PG8_BAR; PG8_SCHED;
            PG8_STAGE(PG8_SB(0, 1), b2 + hstep, voffB);
            PG8_WAIT_V(6); PG8_BAR; PG8_MMA(1, 1, At, B1); PG8_BAR;
            PG8_LDB(B0, 1, 0); PG8_SCHED; PG8_LDA(At, 1, 0); PG8_STAGE(PG8_SA(0, 1), a2 + hstep, voffA);
            PG8_WAIT_L(8); PG8_BAR; PG8_WAIT_L(0); PG8_MMA(0, 0, At, B0); PG8_BAR; PG8_SCHED;
            PG8_LDB(B1, 1, 1); PG8_STAGE(PG8_SB(1, 0), b3, voffB);
            PG8_BAR; PG8_WAIT_L(0); PG8_MMA(0, 1, At, B1); PG8_BAR;
            PG8_LDA(At, 1, 1); PG8_STAGE(PG8_SA(1, 0), a3, voffA);
            PG8_BAR; PG8_WAIT_L(0); PG8_MMA(1, 0, At, B0); PG8_BAR; PG8_SCHED;
            PG8_STAGE(PG8_SB(1, 1), b3 + hstep, voffB);
            PG8_WAIT_V(6); PG8_BAR; PG8_MMA(1, 1, At, B1); PG8_BAR;
            }
        }
        if constexpr (ALIGN_EPI) { if (wr == 0) PG8_BAR; }
        if constexpr (!Epi::AFTER_DRAIN) { E(acc, cur, wr, wc, fr, fq); S.done(cur); }
        if (!has_next) break;
#pragma unroll
        for (int a = 0; a < 2; ++a)
#pragma unroll
            for (int b = 0; b < 2; ++b)
#pragma unroll
                for (int m = 0; m < 4; ++m)
#pragma unroll
                    for (int n = 0; n < 2; ++n) acc[a][b][m][n] = (f32x4){0.f, 0.f, 0.f, 0.f};
        cur = nxt; cA = nA; cB = nB; ++ui;
        if constexpr (ALIGN_EPI) { if (wr == 1) PG8_BAR; }
    }
    PG8_WAIT_V(0);
    if constexpr (!ALIGN_EPI) { if (wr == 0) PG8_BAR; }
    PG8_BAR;
    if constexpr (Epi::AFTER_DRAIN) { E.fused(acc, cur, wr, wc, fr, fq, lds, wid, lane); S.done(cur); }
#undef PG8_SA
#undef PG8_SB
#undef PG8_STAGE
#undef PG8_LDA
#undef PG8_LDB
#undef PG8_MMA
#undef PG8_WAIT_V
#undef PG8_WAIT_L
#undef PG8_BAR
#undef PG8_SCHED
}
}

#define LAS __attribute__((address_space(3)))
typedef unsigned short bf16_t;
typedef short bf16x8 __attribute__((ext_vector_type(8)));
typedef short s16x4 __attribute__((ext_vector_type(4)));
typedef float f32x4 __attribute__((ext_vector_type(4)));
typedef float f32x16 __attribute__((ext_vector_type(16)));
typedef unsigned u32x2 __attribute__((ext_vector_type(2)));
typedef unsigned u32x4 __attribute__((ext_vector_type(4)));
__device__ __forceinline__ unsigned cvtpk(float lo, float hi) { unsigned r; asm volatile("v_cvt_pk_bf16_f32 %0, %1, %2" : "=v"(r) : "v"(lo), "v"(hi)); return r; }
__device__ __forceinline__ float bflo(unsigned w) { return __uint_as_float(w << 16); }
__device__ __forceinline__ float bfhi(unsigned w) { return __uint_as_float(w & 0xffff0000u); }
__device__ __forceinline__ float bf2f(unsigned short h) { return __uint_as_float((unsigned)h << 16); }
__device__ __forceinline__ unsigned short f2bf(float f) { unsigned u = __float_as_uint(f); return (unsigned short)((u + 0x7fffu + ((u >> 16) & 1u)) >> 16); }
__device__ __forceinline__ int lane_id() { return (int)__builtin_amdgcn_mbcnt_hi(~0u, __builtin_amdgcn_mbcnt_lo(~0u, 0u)); }
template <int X> __device__ __forceinline__ float swz_xor(float v) { return __int_as_float(__builtin_amdgcn_ds_swizzle(__float_as_int(v), (X << 10) | 0x1f)); }
template <int CTRL, int ROWMASK> __device__ __forceinline__ float dpp_f(float v) { return __int_as_float(__builtin_amdgcn_update_dpp(0, __float_as_int(v), CTRL, ROWMASK, 0xF, false)); }
__device__ __forceinline__ float wave_sum(float v) {
    v += dpp_f<0xB1, 0xF>(v);
    v += dpp_f<0x4E, 0xF>(v);
    v += dpp_f<0x141, 0xF>(v);
    v += dpp_f<0x140, 0xF>(v);
    v += dpp_f<0x142, 0xA>(v);
    v += dpp_f<0x143, 0xC>(v);
    return __builtin_amdgcn_readlane(v, 63);
}
__device__ __forceinline__ float sigmoidf_(float x) { return __builtin_amdgcn_rcpf(1.f + __expf(-x)); }
__device__ __forceinline__ float rope_inv(int i) { return exp2f(-1.6609640474436813f * (float)i); }

namespace att {
constexpr int NW = 8, QBLK = 32, KVBLK = 64;
constexpr float SCALE = 0.10206207261596575f;
constexpr float THR = 8.f;
constexpr int BUFB = 16384;
constexpr int NRING = 3, OFF_V = 0, OFF_K = NRING * BUFB, OFF_WS = 2 * NRING * BUFB, LDS_BYTES = OFF_WS + NW * 64 * 4;
#define KSWZ(row, colB) ((row) * 256 + ((colB) ^ (((row) & 15) << 4)))
#define SBAR() __builtin_amdgcn_sched_barrier(0)
__device__ __forceinline__ int crow(int r, int hi) { return (r & 3) + 8 * (r >> 2) + 4 * hi; }
constexpr float C2 = SCALE * 1.4426950408889634f;
constexpr float THR2 = THR * 1.4426950408889634f;
#define MX3(a, b, c) __builtin_fmaxf(__builtin_fmaxf((a), (b)), (c))
__device__ __forceinline__ void softmaxT(f32x16& p0, f32x16& p1, float& mref, f32x16& negm, float& l_reg, float& alpha, bf16x8& pa0, bf16x8& pa1, bf16x8& pa2, bf16x8& pa3) {
  float a = MX3(p0[0], p0[1], p1[0]), b = MX3(p0[2], p0[3], p1[1]); a = MX3(a, p1[2], p1[3]);
#pragma unroll
  for (int r = 4; r < 16; r += 4) { a = MX3(a, p0[r], p0[r + 1]); b = MX3(b, p0[r + 2], p0[r + 3]); a = MX3(a, p1[r], p1[r + 1]); b = MX3(b, p1[r + 2], p1[r + 3]); }
  float pmax = __builtin_fmaxf(a, b);
  { auto rr = __builtin_amdgcn_permlane32_swap(__float_as_uint(pmax), __float_as_uint(pmax), false, false);
    pmax = __builtin_fmaxf(__uint_as_float(rr[0]), __uint_as_float(rr[1])); }
  if (__builtin_expect(__all(pmax <= THR2), 1)) { alpha = 1.f; }
  else { const float dl = __builtin_fmaxf(pmax, 0.f); mref += dl; alpha = __builtin_amdgcn_exp2f(-dl); l_reg *= alpha;
#pragma unroll
    for (int r = 0; r < 16; ++r) { p0[r] -= dl; p1[r] -= dl; negm[r] = -mref; }
    asm volatile("" : "+v"(negm)); }
#pragma unroll
  for (int r = 0; r < 16; ++r) { p0[r] = __builtin_amdgcn_exp2f(p0[r]); p1[r] = __builtin_amdgcn_exp2f(p1[r]); }
  { float s0 = p0[0] + p1[0], s1 = p0[1] + p1[1], s2 = p0[2] + p1[2], s3 = p0[3] + p1[3];
#pragma unroll
    for (int r = 4; r < 16; r += 4) { s0 += p0[r] + p1[r]; s1 += p0[r + 1] + p1[r + 1]; s2 += p0[r + 2] + p1[r + 2]; s3 += p0[r + 3] + p1[r + 3]; }
    l_reg += (s0 + s1) + (s2 + s3); }
#define PK4(P, BASE, OUT) do { unsigned a0 = cvtpk(P[BASE + 0], P[BASE + 1]), a1 = cvtpk(P[BASE + 2], P[BASE + 3]);   \
    unsigned b0 = cvtpk(P[BASE + 4], P[BASE + 5]), b1 = cvtpk(P[BASE + 6], P[BASE + 7]);                              \
    auto r0 = __builtin_amdgcn_permlane32_swap(a0, b0, false, false); auto r1 = __builtin_amdgcn_permlane32_swap(a1, b1, false, false); \
    u32x4 w = {r0[0], r1[0], r0[1], r1[1]}; OUT = __builtin_bit_cast(bf16x8, w); } while (0)
  PK4(p0, 0, pa0); PK4(p0, 8, pa1); PK4(p1, 0, pa2); PK4(p1, 8, pa3);
#undef PK4
}
__device__ __forceinline__ void partialSM(f32x16& p0, f32x16& p1, float& mref, f32x16& negm, float& alpha) {
  float a = MX3(p0[0], p0[1], p1[0]), b = MX3(p0[2], p0[3], p1[1]); a = MX3(a, p1[2], p1[3]);
#pragma unroll
  for (int r = 4; r < 16; r += 4) { a = MX3(a, p0[r], p0[r + 1]); b = MX3(b, p0[r + 2], p0[r + 3]); a = MX3(a, p1[r], p1[r + 1]); b = MX3(b, p1[r + 2], p1[r + 3]); }
  float pmax = __builtin_fmaxf(a, b);
  { auto rr = __builtin_amdgcn_permlane32_swap(__float_as_uint(pmax), __float_as_uint(pmax), false, false);
    pmax = __builtin_fmaxf(__uint_as_float(rr[0]), __uint_as_float(rr[1])); }
  if (__builtin_expect(__all(pmax <= THR2), 1)) { alpha = 1.f; }
  else { const float dl = __builtin_fmaxf(pmax, 0.f); mref += dl; alpha = __builtin_amdgcn_exp2f(-dl);
#pragma unroll
    for (int r = 0; r < 16; ++r) { p0[r] -= dl; p1[r] -= dl; negm[r] = -mref; }
    asm volatile("" : "+v"(negm)); }
#pragma unroll
  for (int r = 0; r < 16; ++r) p0[r] = __builtin_amdgcn_exp2f(p0[r]);
}
__device__ __forceinline__ void finishSM(f32x16& p0, f32x16& p1, float& l_reg, bf16x8& pa0, bf16x8& pa1, bf16x8& pa2, bf16x8& pa3) {
#pragma unroll
  for (int r = 0; r < 16; ++r) p1[r] = __builtin_amdgcn_exp2f(p1[r]);
  { float s0 = p0[0] + p1[0], s1 = p0[1] + p1[1], s2 = p0[2] + p1[2], s3 = p0[3] + p1[3];
#pragma unroll
    for (int r = 4; r < 16; r += 4) { s0 += p0[r] + p1[r]; s1 += p0[r + 1] + p1[r + 1]; s2 += p0[r + 2] + p1[r + 2]; s3 += p0[r + 3] + p1[r + 3]; }
    l_reg += (s0 + s1) + (s2 + s3); }
#define PK4(P, BASE, OUT) do { unsigned a0 = cvtpk(P[BASE + 0], P[BASE + 1]), a1 = cvtpk(P[BASE + 2], P[BASE + 3]);   \
    unsigned b0 = cvtpk(P[BASE + 4], P[BASE + 5]), b1 = cvtpk(P[BASE + 6], P[BASE + 7]);                              \
    auto r0 = __builtin_amdgcn_permlane32_swap(a0, b0, false, false); auto r1 = __builtin_amdgcn_permlane32_swap(a1, b1, false, false); \
    u32x4 w = {r0[0], r1[0], r0[1], r1[1]}; OUT = __builtin_bit_cast(bf16x8, w); } while (0)
  PK4(p0, 0, pa0); PK4(p0, 8, pa1); PK4(p1, 0, pa2); PK4(p1, 8, pa3);
#undef PK4
}
__device__ __forceinline__ void qkt(f32x16& p0, f32x16& p1, const LAS unsigned char* Ks, const bf16x8* qr, const f32x16& negm, int r32, int hi) {
  bf16x8 kf[12];
#pragma unroll
  for (int d0 = 0; d0 < 6; ++d0) { const int cb = (d0 * 16 + hi * 8) * 2;
    kf[2 * d0] = *(const LAS bf16x8*)(Ks + KSWZ(r32, cb)); kf[2 * d0 + 1] = *(const LAS bf16x8*)(Ks + KSWZ(32 + r32, cb)); }
  SBAR();
  p0 = __builtin_amdgcn_mfma_f32_32x32x16_bf16(kf[0], qr[0], negm, 0, 0, 0); p1 = __builtin_amdgcn_mfma_f32_32x32x16_bf16(kf[1], qr[0], negm, 0, 0, 0);
#pragma unroll
  for (int d0 = 1; d0 < 6; ++d0) { p0 = __builtin_amdgcn_mfma_f32_32x32x16_bf16(kf[2 * d0], qr[d0], p0, 0, 0, 0); p1 = __builtin_amdgcn_mfma_f32_32x32x16_bf16(kf[2 * d0 + 1], qr[d0], p1, 0, 0, 0); }
}
__device__ __forceinline__ int v_st(int k, int c) { const int kk = (k & ~0xC) | ((k & 4) << 1) | ((k & 8) >> 1); return ((kk >> 3) * 4 + (c >> 5)) * 512 + ((kk & 7) * 32 + (c & 31)) * 2; }
__device__ __forceinline__ int v_rd_base(int lane) { return ((lane & 3) << 3) | (((lane >> 2) & 3) << 6) | (((lane >> 4) & 1) << 5) | (((lane >> 5) & 1) << 8); }
constexpr int v_rd_off(int d0, int ks, int half) { return d0 * 512 + ks * 4096 + half * 2048; }
template <int OFF> __device__ __forceinline__ s16x4 tr_read(int vb) {
  s16x4 r; asm volatile("ds_read_b64_tr_b16 %0, %1 offset:%2" : "=&v"(r) : "v"(vb), "i"(OFF) : "memory"); return r;
}
__device__ __forceinline__ void pv_d0(f32x16* o, int vb, bf16x8 pa0, bf16x8 pa1, bf16x8 pa2, bf16x8 pa3) {
  const s16x4 a0 = tr_read<v_rd_off(0, 0, 0)>(vb), b0 = tr_read<v_rd_off(0, 0, 1)>(vb), a1 = tr_read<v_rd_off(0, 1, 0)>(vb), b1 = tr_read<v_rd_off(0, 1, 1)>(vb);
  const s16x4 a2 = tr_read<v_rd_off(0, 2, 0)>(vb), b2 = tr_read<v_rd_off(0, 2, 1)>(vb), a3 = tr_read<v_rd_off(0, 3, 0)>(vb), b3 = tr_read<v_rd_off(0, 3, 1)>(vb);
  const s16x4 c0 = tr_read<v_rd_off(1, 0, 0)>(vb), d0 = tr_read<v_rd_off(1, 0, 1)>(vb), c1 = tr_read<v_rd_off(1, 1, 0)>(vb), d1 = tr_read<v_rd_off(1, 1, 1)>(vb);
  const s16x4 c2 = tr_read<v_rd_off(1, 2, 0)>(vb), d2 = tr_read<v_rd_off(1, 2, 1)>(vb), c3 = tr_read<v_rd_off(1, 3, 0)>(vb), d3 = tr_read<v_rd_off(1, 3, 1)>(vb);
  asm volatile("s_waitcnt lgkmcnt(0)" ::: "memory"); SBAR();
#define PK(L, H) (bf16x8){L[0], L[1], L[2], L[3], H[0], H[1], H[2], H[3]}
  o[0] = __builtin_amdgcn_mfma_f32_32x32x16_bf16(pa0, PK(a0, b0), o[0], 0, 0, 0); o[1] = __builtin_amdgcn_mfma_f32_32x32x16_bf16(pa0, PK(c0, d0), o[1], 0, 0, 0);
  o[0] = __builtin_amdgcn_mfma_f32_32x32x16_bf16(pa1, PK(a1, b1), o[0], 0, 0, 0); o[1] = __builtin_amdgcn_mfma_f32_32x32x16_bf16(pa1, PK(c1, d1), o[1], 0, 0, 0);
  o[0] = __builtin_amdgcn_mfma_f32_32x32x16_bf16(pa2, PK(a2, b2), o[0], 0, 0, 0); o[1] = __builtin_amdgcn_mfma_f32_32x32x16_bf16(pa2, PK(c2, d2), o[1], 0, 0, 0);
  o[0] = __builtin_amdgcn_mfma_f32_32x32x16_bf16(pa3, PK(a3, b3), o[0], 0, 0, 0); o[1] = __builtin_amdgcn_mfma_f32_32x32x16_bf16(pa3, PK(c3, d3), o[1], 0, 0, 0);
#undef PK
}
__device__ __forceinline__ void attn_unit(const bf16_t* __restrict__ Qb, bool rope_q, int tq0, const bf16_t* __restrict__ KVh, const bf16_t* __restrict__ KR,
                                          int ctx_row0, int lat_row0, int NT, bf16_t* __restrict__ Ob, LAS unsigned char* lds, int wave_s) {
  int tid = wave_s * 64 + lane_id(); asm volatile("" : "+v"(tid));
  const int wid = tid >> 6, lane = tid & 63, r32 = lane & 31, hi = lane >> 5;
  LAS float* al_l = (LAS float*)(lds + OFF_WS) + wid * 64;
  float mref = 0.f, l_reg = 0.f; f32x16 o[2] = {}; f32x16 negm = {}; asm volatile("" : "+v"(negm)); bf16x8 qr[6];
  { const bf16_t* Qw = Qb + (long)(wid * QBLK + r32) * 768;
#pragma unroll
    for (int d0 = 0; d0 < 4; ++d0) { const u32x4 w = *(const u32x4*)(Qw + d0 * 16 + hi * 8);
      u32x4 s = {cvtpk(bflo(w.x) * C2, bfhi(w.x) * C2), cvtpk(bflo(w.y) * C2, bfhi(w.y) * C2), cvtpk(bflo(w.z) * C2, bfhi(w.z) * C2), cvtpk(bflo(w.w) * C2, bfhi(w.w) * C2)};
      qr[d0] = __builtin_bit_cast(bf16x8, s); }
    const int t = tq0 + wid * QBLK + r32;
#pragma unroll
    for (int a = 0; a < 2; ++a) {
      const u32x4 lo = *(const u32x4*)(Qw + 64 + a * 16), hh = *(const u32x4*)(Qw + 64 + a * 16 + 8);
      const float pos = (float)(a == 0 ? (t >> 6) : (t & 63)); float ov[8];
#pragma unroll
      for (int i = 0; i < 8; ++i) { const float ang = rope_q ? pos * rope_inv(i) : 0.f, c = __cosf(ang) * C2, s = __sinf(ang) * C2;
        const float l = (i & 1) ? bfhi(lo[i >> 1]) : bflo(lo[i >> 1]), h = (i & 1) ? bfhi(hh[i >> 1]) : bflo(hh[i >> 1]);
        ov[i] = hi ? (h * c + l * s) : (l * c - h * s); }
      u32x4 w = {cvtpk(ov[0], ov[1]), cvtpk(ov[2], ov[3]), cvtpk(ov[4], ov[5]), cvtpk(ov[6], ov[7])}; qr[4 + a] = __builtin_bit_cast(bf16x8, w);
    }
  }
  const int sr = tid >> 4, sc = (tid & 15) * 8, rr = (tid & 255) >> 2, rc = (tid & 3) * 8;
  const int st0 = (sc < 64) ? OFF_K + KSWZ(sr, sc * 2) : OFF_V + v_st(sr, sc - 64);
  const int st1 = (sc < 64) ? OFF_K + KSWZ(32 + sr, sc * 2) : OFF_V + v_st(32 + sr, sc - 64);
  const int st2 = OFF_K + KSWZ(rr, (64 + rc) * 2);
  const int vb0 = (int)(size_t)(lds + OFF_V) + v_rd_base(lane);
  struct { bf16x8 a0, a1, rp; } sg[2];
#define KROW(t) ((t) < 4 ? ctx_row0 + (t) * KVBLK : lat_row0 + ((t) - 4) * KVBLK)
#define SLOAD(i, t) do { const long k0_ = KROW(t); sg[i].a0 = *(const bf16x8*)(KVh + (k0_ + sr) * 1024 + sc); sg[i].a1 = *(const bf16x8*)(KVh + (k0_ + 32 + sr) * 1024 + sc); \
    sg[i].rp = *(const bf16x8*)(KR + (k0_ + rr) * 32 + rc); } while (0)
#define SWRITE_AT(boff, i) do { *(LAS bf16x8*)(lds + (boff) + st0) = sg[i].a0; *(LAS bf16x8*)(lds + (boff) + st1) = sg[i].a1; *(LAS bf16x8*)(lds + (boff) + st2) = sg[i].rp; } while (0)
#define RESC(a) do { if (__any((a) < 1.f)) { if (hi == 0) al_l[r32] = (a); asm volatile("s_waitcnt lgkmcnt(0)" ::: "memory"); \
    _Pragma("unroll") for (int r = 0; r < 16; ++r) { const float f_ = al_l[crow(r, hi)]; o[0][r] *= f_; o[1][r] *= f_; } } } while (0)
  const int trail = (wave_s >= 4) ? 1 : 0;
  const LAS unsigned char* Kb = lds + OFF_K;
  f32x16 p0, p1; float alpha; bf16x8 pa0, pa1, pa2, pa3;
  SLOAD(0, 0); SLOAD(1, 1);
  asm volatile("s_waitcnt vmcnt(3)" ::: "memory"); SWRITE_AT(0, 0);
  if (trail) { asm volatile("s_waitcnt vmcnt(0)" ::: "memory"); SWRITE_AT(BUFB, 1); SLOAD(1, 2); SLOAD(0, 3); }
  else { SLOAD(0, 2); }
  __syncthreads();
  if (trail) __syncthreads();
  int bV = 0, bK = 0, bN = BUFB, bNN = 2 * BUFB;
#define PHASE_M(j) do { SBAR(); __builtin_amdgcn_s_setprio(2); if ((j) > 0) pv_d0(o, vb0 + bV, pa0, pa1, pa2, pa3); qkt(p0, p1, Kb + bK, qr, negm, r32, hi); __builtin_amdgcn_s_setprio(0); SBAR(); __syncthreads(); } while (0)
#define PHASE_V(j, slot) do { softmaxT(p0, p1, mref, negm, l_reg, alpha, pa0, pa1, pa2, pa3); RESC(alpha); \
    { const int s_ = (j) + 1 + trail; if (s_ < NT) { asm volatile("s_waitcnt vmcnt(3)" ::: "memory"); SWRITE_AT(trail ? bNN : bN, slot); const int s2_ = s_ + 2; SLOAD(slot, s2_ < NT ? s2_ : NT - 1); } } \
    __syncthreads(); bV = bK; bK = bN; bN = bNN; bNN = bV; } while (0)
  for (int j = 0; j < NT; j += 2) {
    PHASE_M(j); PHASE_V(j, 1);
    PHASE_M(j + 1); PHASE_V(j + 1, 0);
  }
  SBAR(); pv_d0(o, vb0 + bV, pa0, pa1, pa2, pa3);
  if (!trail) __syncthreads();
#undef PHASE_M
#undef PHASE_V
  { auto rr_ = __builtin_amdgcn_permlane32_swap(__float_as_uint(l_reg), __float_as_uint(l_reg), false, false); l_reg = __uint_as_float(rr_[0]) + __uint_as_float(rr_[1]); }
  if (hi == 0) al_l[32 + r32] = l_reg; asm volatile("s_waitcnt lgkmcnt(0)" ::: "memory");
  float rli[16];
#pragma unroll
  for (int r = 0; r < 16; ++r) rli[r] = __builtin_amdgcn_rcpf(al_l[32 + crow(r, hi)]);
  bf16_t* Ow = Ob + (long)(wid * QBLK) * 1024;
#pragma unroll
  for (int r = 0; r < 16; ++r) { const int orow = crow(r, hi);
#pragma unroll
    for (int d0 = 0; d0 < 2; ++d0) Ow[(long)orow * 1024 + d0 * 32 + r32] = f2bf(o[d0][r] * rli[r]); }
  __syncthreads();
#undef KROW
#undef SLOAD
#undef SWRITE_AT
#undef RESC
}
}

constexpr int NLAT = 32768, NCTX = 1024, MTOT = 33792, DM = 1024, ZW = 1792, INW = 1696, SEQL = 8192, CTXL = 256, DFF = 4096;
constexpr float EPSN = 1e-6f;
constexpr size_t MiB = 1u << 20;
constexpr size_t WS_MOD = 1 * MiB;
constexpr size_t WS_W = 2 * MiB, W_LAYER = 23 * MiB;
constexpr size_t W_IN = 0, W_Q = 3584 * 1024, W_KV = 4 * MiB, W_O = 4608 * 1024, W_UP = 7 * MiB, W_DN = 15 * MiB;
constexpr size_t WS_A = 48 * MiB;
constexpr size_t WS_B = 114 * MiB;
constexpr size_t WS_Z = WS_B, WS_Q = WS_B + 116 * MiB, WS_KV = WS_B + 166 * MiB, WS_QN = WS_B + 232 * MiB, WS_KVN = WS_B + 249 * MiB, WS_KR = WS_B + 258 * MiB;
constexpr size_t WS_D = 378 * MiB;
constexpr size_t WS_XSC = 444 * MiB;
constexpr size_t WS_PART = 448 * MiB;
constexpr size_t WS_END = 512 * MiB;
static_assert((size_t)MTOT * ZW * 2 <= 116 * MiB && (size_t)MTOT * 768 * 2 <= 50 * MiB && (size_t)MTOT * 1024 * 2 <= 66 * MiB && (size_t)MTOT * 256 * 2 <= 17 * MiB && (size_t)MTOT * 128 * 2 <= 9 * MiB && WS_KR + (size_t)MTOT * 64 <= WS_B + 264 * MiB, "ws map");
constexpr int LDS_BYTES = 147456;

struct Params { const float* in[24]; float* out; unsigned char* ws; };
enum { I_X = 0, I_C, I_CTX, I_CCTX, I_WMOD, I_BMOD, I_GPREMIX, I_GPOSTMIX, I_GPREMLP, I_GPOSTMLP, I_WIN, I_GQ, I_WQB, I_GKV, I_WKVB, I_CDWW, I_CDWB, I_CLNG, I_CLNB, I_SDWW, I_GBR, I_WO, I_WUP, I_WDN };

__device__ __forceinline__ void transpose_item(const float* __restrict__ W, int K, int N, bf16_t* __restrict__ WT, LAS float* scr, int item, int lane) {
    const int nblk = N / 32, kb = item / nblk, nb = item % nblk, k0 = 64 * kb, n0 = 32 * nb;
#pragma unroll 8
    for (int i = 0; i < 32; ++i) { const int kk = 2 * i + (lane >> 5); scr[kk * 33 + (lane & 31)] = W[(size_t)(k0 + kk) * N + n0 + (lane & 31)]; }
    asm volatile("s_waitcnt lgkmcnt(0)" ::: "memory");
    const int c = lane & 7;
#pragma unroll
    for (int j = 0; j < 4; ++j) { const int n = (lane >> 3) + 8 * j; const LAS float* s = scr + (8 * c) * 33 + n;
        u32x4 o; o.x = cvtpk(s[0 * 33], s[1 * 33]); o.y = cvtpk(s[2 * 33], s[3 * 33]); o.z = cvtpk(s[4 * 33], s[5 * 33]); o.w = cvtpk(s[6 * 33], s[7 * 33]);
        *(u32x4*)(WT + (size_t)(n0 + n) * K + k0 + 8 * c) = o; }
    asm volatile("s_waitcnt lgkmcnt(0)" ::: "memory");
}
__device__ __forceinline__ void load16(const float* row, int lane, f32x4 (&v)[4]) {
#pragma unroll
    for (int j = 0; j < 4; ++j) v[j] = __builtin_nontemporal_load((const f32x4*)row + lane + 64 * j);
}
__device__ __forceinline__ void load16bf(const bf16_t* row, int lane, f32x4 (&v)[4]) {
#pragma unroll
    for (int j = 0; j < 4; ++j) { const u32x2 w = __builtin_nontemporal_load((const u32x2*)row + lane + 64 * j); v[j] = (f32x4){bflo(w.x), bfhi(w.x), bflo(w.y), bfhi(w.y)}; }
}
template <int NS> __device__ __forceinline__ void load16part(const float* P, int rowrel, int lane, f32x4 (&v)[4]) {
#pragma unroll
    for (int j = 0; j < 4; ++j) v[j] = (f32x4){0.f, 0.f, 0.f, 0.f};
#pragma unroll
    for (int s0 = 0; s0 < NS; s0 += 4) { f32x4 t[4][4];
#pragma unroll
        for (int s = 0; s < 4; ++s) { const f32x4* q = (const f32x4*)(P + ((size_t)(s0 + s) * 1024 + rowrel) * 1024);
#pragma unroll
            for (int j = 0; j < 4; ++j) t[s][j] = q[lane + 64 * j]; }
#pragma unroll
        for (int s = 0; s < 4; ++s)
#pragma unroll
            for (int j = 0; j < 4; ++j) v[j] += t[s][j]; }
}
__device__ __forceinline__ float ssq16(const f32x4 (&v)[4]) {
    float s = 0.f;
#pragma unroll
    for (int j = 0; j < 4; ++j) s += (v[j].x * v[j].x + v[j].y * v[j].y) + (v[j].z * v[j].z + v[j].w * v[j].w);
    return wave_sum(s);
}
__device__ __forceinline__ void prenorm_store(const f32x4 (&v)[4], float rinv, const float* g, const float* shift, const float* scale, bf16_t* orow, int lane) {
#pragma unroll
    for (int j = 0; j < 4; ++j) { const int q = lane + 64 * j; const f32x4 gg = ((const f32x4*)g)[q], sh = ((const f32x4*)shift)[q], sc = ((const f32x4*)scale)[q];
        const f32x4 h = (v[j] * rinv * gg) * (sc + 1.0f) + sh; u32x2 w; w.x = cvtpk(h.x, h.y); w.y = cvtpk(h.z, h.w); ((u32x2*)orow)[q] = w; }
}

#define XB_TMO      128
#define XB_XCNT(j)  (256  + 64 * (j))
#define XB_XSUB(j)  (1280 + 64 * (j))
#define XB_XGEN(j)  (2304 + 64 * (j))
#define XB_TOP      3328
#define XB_TOPGEN   3392
#define XCD_BAR_WORDS 3456
#define XB_SPIN_CAP (1u << 18)

__device__ __forceinline__ unsigned xb_ld(unsigned* p)              { return __hip_atomic_load(p, __ATOMIC_RELAXED, __HIP_MEMORY_SCOPE_AGENT); }
__device__ __forceinline__ unsigned xb_add(unsigned* p, unsigned v) { return __hip_atomic_fetch_add(p, v, __ATOMIC_RELAXED, __HIP_MEMORY_SCOPE_AGENT); }
__device__ __forceinline__ unsigned xb_xcc_id() { return (unsigned)__builtin_amdgcn_s_getreg((3 << 11) | 20) & 0xFu; }
#define XB_SPIN(cond, bar) do { unsigned _sp = 0; while (cond) { __builtin_amdgcn_s_sleep(1); \
    if ((++_sp & 255u) == 0u) { if (xb_ld(&(bar)[XB_TMO])) break; if (_sp > XB_SPIN_CAP) { atomicAdd(&(bar)[XB_TMO], 1u); break; } } } } while (0)

struct XcdBarrier { unsigned* bar; unsigned x; volatile LAS unsigned* st; };
__device__ __forceinline__ XcdBarrier xcd_barrier_post(unsigned* bar, volatile LAS unsigned* st, bool leader) {
    XcdBarrier b; b.bar = bar; b.x = xb_xcc_id(); b.st = st;
    if (leader) (void)xb_add(&bar[XB_XCNT(b.x)], 1u);
    return b;
}
__device__ __forceinline__ void xcd_barrier_complete(unsigned* bar, unsigned x, unsigned& nloc, unsigned& nx) {
    const unsigned G = gridDim.x * gridDim.y * gridDim.z;
    unsigned sum, cnt, mine, sp = 0u;
    for (;;) {
        sum = 0u; cnt = 0u; mine = 0u;
#pragma unroll
        for (unsigned j = 0; j < 16; ++j) { const unsigned c = xb_ld(&bar[XB_XCNT(j)]); sum += c; cnt += (c > 0u) ? 1u : 0u; mine = (j == x) ? c : mine; }
        if (sum == G) break;
        __builtin_amdgcn_s_sleep(1);
        if ((++sp & 255u) == 0u) { if (xb_ld(&bar[XB_TMO])) break; if (sp > XB_SPIN_CAP) { atomicAdd(&bar[XB_TMO], 1u); break; } }
    }
    nloc = mine > 0u ? mine : 1u; nx = cnt > 0u ? cnt : 1u;
}
__device__ __forceinline__ void xcd_barrier(const XcdBarrier& b, bool leader) {
    asm volatile("s_waitcnt vmcnt(0) lgkmcnt(0)" ::: "memory");
    __syncthreads();
    if (leader) {
        unsigned* bar = b.bar;
        __builtin_amdgcn_s_waitcnt(0);
        unsigned nloc = b.st[0], nx = b.st[1];
        if (nloc == 0u) { xcd_barrier_complete(bar, b.x, nloc, nx); b.st[0] = nloc; b.st[1] = nx; }
        const unsigned old = xb_add(&bar[XB_XSUB(b.x)], 1u);
        const unsigned gen = old / nloc;
        if (old + 1u == (gen + 1u) * nloc) {
            __builtin_amdgcn_fence(__ATOMIC_RELEASE, "agent");
            asm volatile("s_waitcnt vmcnt(0)" ::: "memory");
            const unsigned og = xb_add(&bar[XB_TOP], 1u);
            const unsigned tg = og / nx;
            if (og + 1u == (tg + 1u) * nx) xb_add(&bar[XB_TOPGEN], 1u);
            else XB_SPIN(xb_ld(&bar[XB_TOPGEN]) == tg, bar);
            __builtin_amdgcn_fence(__ATOMIC_ACQUIRE, "agent");
            xb_add(&bar[XB_XGEN(b.x)], 1u);
            asm volatile("s_waitcnt vmcnt(0)" ::: "memory");
        } else {
            XB_SPIN(xb_ld(&bar[XB_XGEN(b.x)]) == gen, bar);
            __builtin_amdgcn_fence(__ATOMIC_ACQUIRE, "agent");
            asm volatile("s_waitcnt vmcnt(0)" ::: "memory");
        }
    }
    __syncthreads();
}
#ifndef PROBE_R1_REPS
#define PROBE_R1_REPS 1
#endif
#ifndef PROBE_P1_REPS
#define PROBE_P1_REPS 1
#endif
#ifndef PROBE_P0_REPS
#define PROBE_P0_REPS 1
#endif
#ifndef PROBE_BAR_REPS
#define PROBE_BAR_REPS 1
#endif
#ifndef PROBE_GEMM_REPS
#define PROBE_GEMM_REPS 1
#endif
#ifndef PROBE_ATT_REPS
#define PROBE_ATT_REPS 1
#endif

__global__ void __launch_bounds__(512, 2) fwd_megakernel(Params p) {
    extern __shared__ __attribute__((aligned(16))) unsigned char lds_raw[];
    LAS unsigned char* lds = (LAS unsigned char*)lds_raw;
    const int wave = __builtin_amdgcn_readfirstlane(threadIdx.x >> 6);
    typedef const __attribute__((address_space(4))) Params* KP;
#define PHASE_IDS() int tid = wave * 64 + lane_id(); asm volatile("" : "+v"(tid)); int G = gridDim.x, blk = blockIdx.x; asm volatile("" : "+s"(G), "+s"(blk)); const int NGW = G * 8; const int lane = tid & 63; const int gw = blk * 8 + wave; (void)lane; (void)gw; (void)NGW; \
    KP pp = (KP)__builtin_amdgcn_kernarg_segment_ptr(); asm volatile("" : "+s"(pp)); unsigned char* ws = pp->ws; (void)ws;
#define PIN(i) (pp->in[i])
#define LOADY(m, y, ns) do { if ((m) >= NLAT) load16part<ns>(WSP(float, WS_PART), (m) - NLAT, lane, y); else load16bf(BY + (size_t)(m) * DM, lane, y); } while (0)
#define XBAR_WORDS ((unsigned*)((KP)__builtin_amdgcn_kernarg_segment_ptr())->ws)
#define XBAR_ST ((volatile LAS unsigned*)(lds + 131072 + 256))
#define GBAR() do { XcdBarrier xb_; xb_.bar = XBAR_WORDS; xb_.x = xb_xcc_id(); xb_.st = XBAR_ST; xcd_barrier(xb_, wave == 0 && lane_id() == 0); } while (0)
#define WSP(T, off) ((T*)(ws + (off)))
#define MOD WSP(float, WS_MOD)
#define BA WSP(bf16_t, WS_A)
#define BH WSP(bf16_t, WS_B)
#define BZ WSP(bf16_t, WS_Z)
#define BQ WSP(bf16_t, WS_Q)
#define BKV WSP(bf16_t, WS_KV)
#define BQN WSP(bf16_t, WS_QN)
#define BKVN WSP(bf16_t, WS_KVN)
#define BKR WSP(bf16_t, WS_KR)
#define BY WSP(bf16_t, WS_D)
#define XSC WSP(float, WS_XSC)
#define XS_ROW(m) ((m) < NLAT ? pp->out + (size_t)(m) * DM : XSC + (size_t)((m) - NLAT) * DM)
#define MOD_ROW(l, m) (MOD + ((l) * 5 + ((m) < NLAT ? (m) / SEQL : 4)) * 6144)

    for (int rp0_ = 0; rp0_ < PROBE_P0_REPS; ++rp0_) {
        PHASE_IDS();
        if (blk == 0) for (int i = tid; i < XCD_BAR_WORDS; i += 512) ((unsigned*)ws)[i] = 0u;
        if (tid < 2) ((LAS unsigned*)(lds + 131072 + 256))[tid] = 0u;
        LAS float* sil = (LAS float*)lds;
        LAS float* part = sil + 5 * 1024;
        for (int it = blk; it < 192; it += G) {
            const int l = it / 96, j0 = (it % 96) * 64;
            for (int i = tid; i < 5 * 1024; i += 512) { const int r = i >> 10, k = i & 1023; const float cv = r < 4 ? PIN(I_C)[r * 1024 + k] : PIN(I_CCTX)[k]; sil[i] = cv * sigmoidf_(cv); }
            __syncthreads();
            const int kg = tid >> 6, jc = tid & 63; const float* wm = PIN(I_WMOD) + (size_t)l * 1024 * 6144 + j0 + jc;
            float a0 = 0.f, a1 = 0.f, a2 = 0.f, a3 = 0.f, a4 = 0.f;
#pragma unroll 8
            for (int k = kg; k < 1024; k += 8) { const float w = wm[(size_t)k * 6144]; a0 += sil[k] * w; a1 += sil[1024 + k] * w; a2 += sil[2048 + k] * w; a3 += sil[3072 + k] * w; a4 += sil[4096 + k] * w; }
            part[(kg * 5 + 0) * 64 + jc] = a0; part[(kg * 5 + 1) * 64 + jc] = a1; part[(kg * 5 + 2) * 64 + jc] = a2; part[(kg * 5 + 3) * 64 + jc] = a3; part[(kg * 5 + 4) * 64 + jc] = a4;
            __syncthreads();
            if (tid < 320) { const int r = tid >> 6; float s = 0.f;
#pragma unroll
                for (int q = 0; q < 8; ++q) s += part[(q * 5 + r) * 64 + jc];
                MOD[(l * 5 + r) * 6144 + j0 + jc] = s + PIN(I_BMOD)[l * 6144 + j0 + jc]; }
            __syncthreads();
        }
        LAS float* scr = (LAS float*)(lds + 32768 + wave * 8704);
        constexpr int T_IN = 16 * 53, T_Q = 4 * 24, T_KV = 2 * 32, T_O = 16 * 32, T_UP = 16 * 128, T_DN = 64 * 32, T_L = T_IN + T_Q + T_KV + T_O + T_UP + T_DN;
        for (int it = gw; it < 2 * T_L; it += NGW) {
            const int l = it / T_L; int r = it % T_L; bf16_t* wl = (bf16_t*)(ws + WS_W + (size_t)l * W_LAYER);
            if (r < T_IN) { transpose_item(PIN(I_WIN) + (size_t)l * 1024 * INW, 1024, INW, (bf16_t*)((unsigned char*)wl + W_IN), scr, r, lane); continue; } r -= T_IN;
            if (r < T_Q) { transpose_item(PIN(I_WQB) + (size_t)l * 256 * 768, 256, 768, (bf16_t*)((unsigned char*)wl + W_Q), scr, r, lane); continue; } r -= T_Q;
            if (r < T_KV) { transpose_item(PIN(I_WKVB) + (size_t)l * 128 * 1024, 128, 1024, (bf16_t*)((unsigned char*)wl + W_KV), scr, r, lane); continue; } r -= T_KV;
            if (r < T_O) { transpose_item(PIN(I_WO) + (size_t)l * 1024 * 1024, 1024, 1024, (bf16_t*)((unsigned char*)wl + W_O), scr, r, lane); continue; } r -= T_O;
            if (r < T_UP) { transpose_item(PIN(I_WUP) + (size_t)l * 1024 * DFF, 1024, DFF, (bf16_t*)((unsigned char*)wl + W_UP), scr, r, lane); continue; } r -= T_UP;
            transpose_item(PIN(I_WDN) + (size_t)l * DFF * 1024, DFF, 1024, (bf16_t*)((unsigned char*)wl + W_DN), scr, r, lane);
        }
        for (int i = blk * 512 + tid; i < 2 * 96 * 128; i += G * 512) { const int l = i / (96 * 128), q = i % (96 * 128);
            ((u32x4*)(ws + WS_W + (size_t)l * W_LAYER + W_IN + (size_t)INW * 2048))[q] = (u32x4){0u, 0u, 0u, 0u}; }
    }
    cg::this_grid().sync();
    (void)xcd_barrier_post(XBAR_WORDS, XBAR_ST, wave == 0 && lane_id() == 0);
    { PHASE_IDS();
#define P1_SRC(m) ((m) < NLAT ? PIN(I_X) + (size_t)(m) * DM : PIN(I_CTX) + (size_t)((m) - NLAT) * DM)
#define P1_ROW(m, v) do { const float* mod = MOD_ROW(0, m); const float rinv = rsqrtf(ssq16(v) * (1.f / DM) + EPSN); prenorm_store(v, rinv, PIN(I_GPREMIX), mod, mod + 1024, BA + (size_t)(m) * DM, lane); } while (0)
    for (int m0 = gw; m0 < MTOT; m0 += 4 * NGW) { f32x4 vb[4][4];
#pragma unroll
        for (int i = 0; i < 4; ++i) { const int mi = m0 + i * NGW; load16(P1_SRC(mi < MTOT ? mi : m0), lane, vb[i]); }
#pragma unroll
        for (int i = 0; i < 4; ++i) { const int mi = m0 + i * NGW; if (mi < MTOT) P1_ROW(mi, vb[i]); } } }
    GBAR();

    for (int l = 0; l < 2; ++l) {
        const bool last = (l == 1);
#define WL (ws + WS_W + (size_t)l * W_LAYER)
        const int Mact = last ? NLAT : MTOT;
        for (int rep_ = 0; rep_ < PROBE_GEMM_REPS; ++rep_) { PHASE_IDS(); pg8::Gemm g{BA, (const bf16_t*)(WL + W_IN), MTOT, ZW, 1024, 1024}; pg8::StaticOrder S; S.init(MTOT, ZW, G, blk); pg8::EpiBf16<0> E{BZ, ZW};
          pg8::gemm_phase<pg8::EpiBf16<0>, pg8::StaticOrder, true, true>(lds, g, S, E, wave); }
        GBAR();
        for (int rr1_ = 0; rr1_ < PROBE_R1_REPS; ++rr1_) {
            PHASE_IDS();
            const float* gq = PIN(I_GQ) + l * 256; const float* gkv = PIN(I_GKV) + l * 128; const float* gbr = PIN(I_GBR) + l * 1024;
            const float* cw = PIN(I_CDWW) + l * 31 * 256; const float* cb = PIN(I_CDWB) + l * 256; const float* lng = PIN(I_CLNG) + l * 256; const float* lnb = PIN(I_CLNB) + l * 256;
            const float* sw = PIN(I_SDWW) + l * 3 * 256;
            LAS float* U = (LAS float*)lds;
            LAS float* WL_ = (LAS float*)(lds + 96256);
            for (int i = tid; i < 31 * 64; i += 512) *(LAS f32x4*)(WL_ + 4 * i) = ((const f32x4*)cw)[i];
            __syncthreads();
            const int lane_o = lane, tid_o = tid;
            for (int ti = blk; ti < 544; ti += G) {
                int tid = tid_o; asm volatile("" : "+v"(tid)); const int lane = tid & 63;
                int seq_base, seq_len, t0; bool is_lat;
                if (ti < 512) { seq_base = (ti >> 7) * SEQL; seq_len = SEQL; t0 = (ti & 127) * 64; is_lat = true; }
                else { const int tc = ti - 512; seq_base = NLAT + (tc >> 3) * CTXL; seq_len = CTXL; t0 = (tc & 7) * 32; is_lat = false; }
                const int TT = is_lat ? 64 : 32; const bool dead = last && !is_lat;
                const int urows = dead ? 0 : (TT + 30) * 32; const bool wact = wave * 8 < TT;
                if (!dead) { u32x4 ua[6], ug[6];
#pragma unroll
                  for (int i = 0; i < 6; ++i) { const int it = tid + 512 * i, rr = it >> 5, c8 = it & 31, t = t0 - 15 + rr; const bool ok = it < urows && t >= 0 && t < seq_len;
                      const bf16_t* zr = BZ + (size_t)(seq_base + (ok ? t : t0)) * ZW; ua[i] = *(const u32x4*)(zr + 416 + 8 * c8); ug[i] = *(const u32x4*)(zr + 672 + 8 * c8); if (!ok) ua[i] = (u32x4){0u, 0u, 0u, 0u}; }
#pragma unroll
                  for (int i = 0; i < 6; ++i) { const int it = tid + 512 * i, rr = it >> 5, c8 = it & 31; const u32x4 a = ua[i], gg = ug[i];
                      if (it < urows) {
                        const f32x4 u0 = {bflo(a.x) * sigmoidf_(bflo(gg.x)), bfhi(a.x) * sigmoidf_(bfhi(gg.x)), bflo(a.y) * sigmoidf_(bflo(gg.y)), bfhi(a.y) * sigmoidf_(bfhi(gg.y))};
                        const f32x4 u1 = {bflo(a.z) * sigmoidf_(bflo(gg.z)), bfhi(a.z) * sigmoidf_(bfhi(gg.z)), bflo(a.w) * sigmoidf_(bflo(gg.w)), bfhi(a.w) * sigmoidf_(bfhi(gg.w))};
                        *(LAS f32x4*)(U + rr * 256 + 8 * c8) = u0; *(LAS f32x4*)(U + rr * 256 + 8 * c8 + 4) = u1; } } }
                if (wact) { const int tw = t0 + wave * 8; const size_t mw = (size_t)seq_base + tw; const bf16_t* zw = BZ + mw * ZW;
                  u32x2 zq[8], bgt[8], cgt[10], hht[10]; unsigned kvv[8]; unsigned short krv[8];
#pragma unroll
                  for (int k8 = 0; k8 < 8; ++k8) { const bf16_t* zr = zw + (size_t)k8 * ZW; zq[k8] = *(const u32x2*)(zr + 4 * lane); kvv[k8] = *(const unsigned*)(zr + 256 + 2 * lane); krv[k8] = zr[384 + (lane & 31)];
                      bgt[k8] = *(const u32x2*)(zr + 928 + 4 * lane); }
#pragma unroll
                  for (int j = 0; j < 10; ++j) { const int tt = tw - 1 + j; const bool ok = tt >= 0 && tt < seq_len; const bf16_t* z2 = BZ + (size_t)(seq_base + (ok ? tt : tw)) * ZW;
                      cgt[j] = *(const u32x2*)(z2 + 1184 + 4 * lane); hht[j] = *(const u32x2*)(z2 + 1440 + 4 * lane); if (!ok) { cgt[j] = (u32x2){0u, 0u}; } }
                  const f32x4 gqv = ((const f32x4*)gq)[lane]; const float gk0 = gkv[2 * lane], gk1 = gkv[2 * lane + 1]; const f32x4 gsc = ((const f32x4*)(gbr + 768))[lane];
                  const f32x4 sw0 = ((const f32x4*)sw)[lane], sw1 = ((const f32x4*)(sw + 256))[lane], sw2 = ((const f32x4*)(sw + 512))[lane];
                  f32x4 pr[10];
#pragma unroll
                  for (int j = 0; j < 10; ++j) pr[j] = (f32x4){bflo(cgt[j].x) * bflo(hht[j].x), bfhi(cgt[j].x) * bfhi(hht[j].x), bflo(cgt[j].y) * bflo(hht[j].y), bfhi(cgt[j].y) * bfhi(hht[j].y)};
#pragma unroll
                  for (int k8 = 0; k8 < 8; ++k8) { const int t = tw + k8; const size_t m = mw + k8;
                    { const u32x2 w = zq[k8]; const f32x4 v = {bflo(w.x), bfhi(w.x), bflo(w.y), bfhi(w.y)};
                      const float ri = rsqrtf(wave_sum((v.x * v.x + v.y * v.y) + (v.z * v.z + v.w * v.w)) * (1.f / 256.f) + EPSN); const f32x4 o = v * ri * gqv;
                      u32x2 ow; ow.x = cvtpk(o.x, o.y); ow.y = cvtpk(o.z, o.w); *(u32x2*)(BQN + m * 256 + 4 * lane) = ow; }
                    { const unsigned w = kvv[k8]; const float v0 = bflo(w), v1 = bfhi(w);
                      const float ri = rsqrtf(wave_sum(v0 * v0 + v1 * v1) * (1.f / 128.f) + EPSN); *(unsigned*)(BKVN + m * 128 + 2 * lane) = cvtpk(v0 * ri * gk0, v1 * ri * gk1); }
                    { const int e = lane & 31; const float v = bf2f(krv[k8]); const float prn = swz_xor<8>(v); float o = v;
                      if (is_lat) { const int a = e >> 4, i = e & 15; const float pos = (float)(a == 0 ? (t >> 6) : (t & 63)); const float ang = pos * rope_inv(i & 7), c = __cosf(ang), s = __sinf(ang);
                          o = (i < 8) ? (v * c - prn * s) : (v * c + prn * s); }
                      if (lane < 32) BKR[m * 32 + e] = f2bf(o); }
                    { const f32x4 acc = pr[k8] * sw0 + pr[k8 + 1] * sw1 + pr[k8 + 2] * sw2; const u32x2 bg = bgt[k8];
                      const f32x4 s = {bflo(bg.x) * acc.x, bfhi(bg.x) * acc.y, bflo(bg.y) * acc.z, bfhi(bg.y) * acc.w};
                      const float ri = rsqrtf(wave_sum((s.x * s.x + s.y * s.y) + (s.z * s.z + s.w * s.w)) * (1.f / 256.f) + EPSN); const f32x4 o = s * ri * gsc;
                      u32x2 ow; ow.x = cvtpk(o.x, o.y); ow.y = cvtpk(o.z, o.w); *(u32x2*)(BA + m * DM + 768 + 4 * lane) = ow; }
                  }
                }
                __syncthreads();
                if (wact && !dead) { int lane = lane_o; asm volatile("" : "+v"(lane)); f32x4 wv[31];
#pragma unroll
                  for (int j = 0; j < 31; ++j) wv[j] = *(const LAS f32x4*)(WL_ + j * 256 + 4 * lane);
                  const f32x4 bias = ((const f32x4*)cb)[lane]; f32x4 acc[8];
#pragma unroll
                  for (int k = 0; k < 8; ++k) acc[k] = bias;
                  const LAS float* Ub = U + (wave * 8) * 256 + 4 * lane;
#pragma unroll
                  for (int i = 0; i < 38; ++i) { const f32x4 u = *(const LAS f32x4*)(Ub + i * 256);
#pragma unroll
                      for (int k = 0; k < 8; ++k) { const int j = i - k; if (j >= 0 && j < 31) acc[k] += u * wv[j]; } }
                  const f32x4 lg = ((const f32x4*)lng)[lane], lb = ((const f32x4*)lnb)[lane], gb = ((const f32x4*)(gbr + 512))[lane];
#pragma unroll
                  for (int k = 0; k < 8; ++k) { const f32x4 a = acc[k]; const float mean = wave_sum((a.x + a.y) + (a.z + a.w)) * (1.f / 256.f); const f32x4 d = a - mean;
                      const float rstd = rsqrtf(wave_sum((d.x * d.x + d.y * d.y) + (d.z * d.z + d.w * d.w)) * (1.f / 256.f) + EPSN); f32x4 y = d * rstd * lg + lb;
                      y = (f32x4){y.x * sigmoidf_(y.x), y.y * sigmoidf_(y.y), y.z * sigmoidf_(y.z), y.w * sigmoidf_(y.w)};
                      const float ri = rsqrtf(wave_sum((y.x * y.x + y.y * y.y) + (y.z * y.z + y.w * y.w)) * (1.f / 256.f) + EPSN); const f32x4 o = y * ri * gb;
                      u32x2 ow; ow.x = cvtpk(o.x, o.y); ow.y = cvtpk(o.z, o.w); *(u32x2*)(BA + ((size_t)seq_base + t0 + wave * 8 + k) * DM + 512 + 4 * lane) = ow; } }
                __syncthreads();
            }
        }
        GBAR();
        for (int rep_ = 0; rep_ < PROBE_GEMM_REPS; ++rep_) { PHASE_IDS(); pg8::Gemm g{BQN, (const bf16_t*)(WL + W_Q), MTOT, 768, 256, 256}; pg8::StaticOrder S; S.init(MTOT, 768, G, blk); pg8::EpiBf16<0> E{BQ, 768};
          pg8::gemm_phase<pg8::EpiBf16<0>, pg8::StaticOrder, true, true>(lds, g, S, E, wave); }
        for (int rep_ = 0; rep_ < PROBE_GEMM_REPS; ++rep_) { PHASE_IDS(); pg8::Gemm g{BKVN, (const bf16_t*)(WL + W_KV), MTOT, 1024, 128, 128}; pg8::StaticOrder S; S.init(MTOT, 1024, G, blk); pg8::EpiBf16<0> E{BKV, 1024};
          pg8::gemm_phase<pg8::EpiBf16<0>, pg8::StaticOrder, true, true>(lds, g, S, E, wave); }
        GBAR();
        {
            PHASE_IDS();
            const int nunits = last ? 1024 : 1056;
            for (int rep_ = 0; rep_ < PROBE_ATT_REPS; ++rep_)
            for (int u = blk; u < nunits; u += G) {
                if (u < 1024) { const int bh = (u & 7) + 8 * (u >> 8), qb = (u >> 3) & 31, b = bh >> 3, h = bh & 7; const int q0 = b * SEQL + qb * 256;
                    att::attn_unit(BQ + (size_t)q0 * 768 + h * 96, true, qb * 256, BKV + h * 128, BKR, NLAT + b * CTXL, b * SEQL, 132, BA + (size_t)q0 * DM + h * 64, lds, wave); }
                else { const int uc = u - 1024, b = uc >> 3, h = uc & 7; const int q0 = NLAT + b * CTXL;
                    att::attn_unit(BQ + (size_t)q0 * 768 + h * 96, false, 0, BKV + h * 128, BKR, q0, 0, 4, BA + (size_t)q0 * DM + h * 64, lds, wave); }
            }
        }
        GBAR();
        { PHASE_IDS(); const float* gbr = PIN(I_GBR) + l * 1024; const f32x4 g0 = ((const f32x4*)gbr)[2 * lane], g1 = ((const f32x4*)gbr)[2 * lane + 1];
          for (int m0 = gw; m0 < Mact; m0 += 4 * NGW) { u32x4 w[4];
#pragma unroll
              for (int i = 0; i < 4; ++i) { const int m = m0 + i * NGW; w[i] = ((const u32x4*)(BA + (size_t)(m < Mact ? m : m0) * DM))[lane]; }
#pragma unroll
              for (int i = 0; i < 4; ++i) { const int m = m0 + i * NGW; if (m < Mact) {
                  const float v[8] = {bflo(w[i].x), bfhi(w[i].x), bflo(w[i].y), bfhi(w[i].y), bflo(w[i].z), bfhi(w[i].z), bflo(w[i].w), bfhi(w[i].w)}; float s = 0.f;
#pragma unroll
                  for (int q = 0; q < 8; ++q) s += v[q] * v[q];
                  const float ri = rsqrtf(wave_sum(s) * (1.f / 512.f) + EPSN);
                  u32x4 o; o.x = cvtpk(v[0] * ri * g0.x, v[1] * ri * g0.y); o.y = cvtpk(v[2] * ri * g0.z, v[3] * ri * g0.w); o.z = cvtpk(v[4] * ri * g1.x, v[5] * ri * g1.y); o.w = cvtpk(v[6] * ri * g1.z, v[7] * ri * g1.w);
                  ((u32x4*)(BA + (size_t)m * DM))[lane] = o; } } } }
        GBAR();
        { PHASE_IDS(); pg8::Gemm g{BA, (const bf16_t*)(WL + W_O), NLAT, 1024, 1024, 1024}; pg8::StaticOrder S; S.init(NLAT, 1024, G, blk); pg8::EpiBf16<0> E{BY, 1024};
          pg8::gemm_phase<pg8::EpiBf16<0>, pg8::StaticOrder, true, true>(lds, g, S, E, wave); }
        if (!last) { PHASE_IDS(); pg8::Gemm g{BA, (const bf16_t*)(WL + W_O), MTOT, 1024, 256, 1024}; pg8::SplitOrder S; S.init(4, 4, 4, 128, G, blk); pg8::EpiF32Part E{WSP(float, WS_PART), 1024, 128, (size_t)1024 * 1024};
          pg8::gemm_phase<pg8::EpiF32Part, pg8::SplitOrder, true, true>(lds, g, S, E, wave); }
        GBAR();
        { PHASE_IDS(); const float* gp = PIN(I_GPOSTMIX) + l * DM; const float* gm = PIN(I_GPREMLP) + l * DM;
#define R3_SRC(m) ((l == 0) ? ((m) < NLAT ? PIN(I_X) + (size_t)(m) * DM : PIN(I_CTX) + (size_t)((m) - NLAT) * DM) : (const float*)XS_ROW(m))
#define R3_ROW(m, y, x) do { const float* mod = MOD_ROW(l, m); float* dst = XS_ROW(m); const float ry = rsqrtf(ssq16(y) * (1.f / DM) + EPSN); \
            _Pragma("unroll") for (int j = 0; j < 4; ++j) { const int q = lane + 64 * j; x[j] = x[j] + ((const f32x4*)(mod + 2048))[q] * (y[j] * ry * ((const f32x4*)gp)[q]); __builtin_nontemporal_store(x[j], (f32x4*)dst + q); } \
            const float r1 = rsqrtf(ssq16(x) * (1.f / DM) + EPSN); prenorm_store(x, r1, gm, mod + 3072, mod + 4096, BA + (size_t)(m) * DM, lane); } while (0)
        if (NGW == 2048) {
        for (int m0 = gw; m0 < Mact; m0 += 4 * NGW) { f32x4 yb[4][4], xb[4][4]; const float* mod = MOD_ROW(l, m0);
#pragma unroll
            for (int i = 0; i < 4; ++i) { const int mi = m0 + i * NGW, mc = mi < Mact ? mi : m0; LOADY(mc, yb[i], 4); load16(R3_SRC(mc), lane, xb[i]); }
            float r1[4];
            { f32x4 gt[4], gv[4];
#pragma unroll
              for (int j = 0; j < 4; ++j) { gt[j] = ((const f32x4*)(mod + 2048))[lane + 64 * j]; gv[j] = ((const f32x4*)gp)[lane + 64 * j]; }
#pragma unroll
              for (int i = 0; i < 4; ++i) { const int mi = m0 + i * NGW; r1[i] = 0.f; if (mi < Mact) { float* dst = XS_ROW(mi); const float ry = rsqrtf(ssq16(yb[i]) * (1.f / DM) + EPSN);
#pragma unroll
                  for (int j = 0; j < 4; ++j) { xb[i][j] = xb[i][j] + gt[j] * (yb[i][j] * ry * gv[j]); __builtin_nontemporal_store(xb[i][j], (f32x4*)dst + lane + 64 * j); }
                  r1[i] = rsqrtf(ssq16(xb[i]) * (1.f / DM) + EPSN); } } }
            { f32x4 gv[4], sh[4], sc[4];
#pragma unroll
              for (int j = 0; j < 4; ++j) { gv[j] = ((const f32x4*)gm)[lane + 64 * j]; sh[j] = ((const f32x4*)(mod + 3072))[lane + 64 * j]; sc[j] = ((const f32x4*)(mod + 4096))[lane + 64 * j] + 1.0f; }
#pragma unroll
              for (int i = 0; i < 4; ++i) { const int mi = m0 + i * NGW; if (mi < Mact) { bf16_t* orow = BA + (size_t)mi * DM;
#pragma unroll
                  for (int j = 0; j < 4; ++j) { const f32x4 h = (xb[i][j] * r1[i] * gv[j]) * sc[j] + sh[j]; u32x2 w; w.x = cvtpk(h.x, h.y); w.y = cvtpk(h.z, h.w); ((u32x2*)orow)[lane + 64 * j] = w; } } } } }
        } else
        for (int m0 = gw; m0 < Mact; m0 += 4 * NGW) { f32x4 yb[4][4], xb[4][4];
#pragma unroll
            for (int i = 0; i < 4; ++i) { const int mi = m0 + i * NGW, mc = mi < Mact ? mi : m0; LOADY(mc, yb[i], 4); load16(R3_SRC(mc), lane, xb[i]); }
#pragma unroll
            for (int i = 0; i < 4; ++i) { const int mi = m0 + i * NGW; if (mi < Mact) R3_ROW(mi, yb[i], xb[i]); } } }
        GBAR();
        for (int rep_ = 0; rep_ < PROBE_GEMM_REPS; ++rep_) { PHASE_IDS(); pg8::Gemm g{BA, (const bf16_t*)(WL + W_UP), Mact, DFF, 1024, 1024}; pg8::StaticOrder S; S.init(Mact, DFF, G, blk); pg8::EpiBf16<2> E{BH, DFF};
          pg8::gemm_phase<pg8::EpiBf16<2>, pg8::StaticOrder, true, true>(lds, g, S, E, wave); }
        GBAR();
        { PHASE_IDS(); pg8::Gemm g{BH, (const bf16_t*)(WL + W_DN), NLAT, 1024, DFF, DFF}; pg8::StaticOrder S; S.init(NLAT, 1024, G, blk); S.rev = true; pg8::EpiBf16<0> E{BY, 1024};
          pg8::gemm_phase<pg8::EpiBf16<0>, pg8::StaticOrder, true, true>(lds, g, S, E, wave); }
        if (!last) { PHASE_IDS(); pg8::Gemm g{BH, (const bf16_t*)(WL + W_DN), MTOT, 1024, 256, DFF}; pg8::SplitOrder S; S.init(4, 4, 16, 128, G, blk); pg8::EpiF32Part E{WSP(float, WS_PART), 1024, 128, (size_t)1024 * 1024};
          pg8::gemm_phase<pg8::EpiF32Part, pg8::SplitOrder, true, true>(lds, g, S, E, wave); }
        GBAR();
        { PHASE_IDS(); const float* gp = PIN(I_GPOSTMLP) + l * DM; const float* gn = PIN(I_GPREMIX) + (last ? 0 : (l + 1) * DM);
#define R4_ROW(m, y, x) do { const float* mod = MOD_ROW(l, m); float* xr = XS_ROW(m); const float ry = rsqrtf(ssq16(y) * (1.f / DM) + EPSN); \
            _Pragma("unroll") for (int j = 0; j < 4; ++j) { const int q = lane + 64 * j; x[j] = x[j] + ((const f32x4*)(mod + 5120))[q] * (y[j] * ry * ((const f32x4*)gp)[q]); __builtin_nontemporal_store(x[j], (f32x4*)xr + q); } \
            if (!last) { const float* mod1 = MOD_ROW(l + 1, m); const float r1 = rsqrtf(ssq16(x) * (1.f / DM) + EPSN); prenorm_store(x, r1, gn, mod1, mod1 + 1024, BA + (size_t)(m) * DM, lane); } } while (0)
        if (NGW == 2048) {
        for (int m0 = gw; m0 < Mact; m0 += 4 * NGW) { f32x4 yb[4][4], xb[4][4]; const float* mod = MOD_ROW(l, m0);
#pragma unroll
            for (int i = 0; i < 4; ++i) { const int mi = m0 + i * NGW, mc = mi < Mact ? mi : m0; LOADY(mc, yb[i], 16); load16(XS_ROW(mc), lane, xb[i]); }
            float r1[4];
            { f32x4 gt[4], gv[4];
#pragma unroll
              for (int j = 0; j < 4; ++j) { gt[j] = ((const f32x4*)(mod + 5120))[lane + 64 * j]; gv[j] = ((const f32x4*)gp)[lane + 64 * j]; }
#pragma unroll
              for (int i = 0; i < 4; ++i) { const int mi = m0 + i * NGW; r1[i] = 0.f; if (mi < Mact) { float* xr = XS_ROW(mi); const float ry = rsqrtf(ssq16(yb[i]) * (1.f / DM) + EPSN);
#pragma unroll
                  for (int j = 0; j < 4; ++j) { xb[i][j] = xb[i][j] + gt[j] * (yb[i][j] * ry * gv[j]); __builtin_nontemporal_store(xb[i][j], (f32x4*)xr + lane + 64 * j); }
                  if (!last) r1[i] = rsqrtf(ssq16(xb[i]) * (1.f / DM) + EPSN); } } }
            if (!last) { const float* mod1 = MOD_ROW(l + 1, m0); f32x4 gv[4], sh[4], sc[4];
#pragma unroll
              for (int j = 0; j < 4; ++j) { gv[j] = ((const f32x4*)gn)[lane + 64 * j]; sh[j] = ((const f32x4*)mod1)[lane + 64 * j]; sc[j] = ((const f32x4*)(mod1 + 1024))[lane + 64 * j] + 1.0f; }
#pragma unroll
              for (int i = 0; i < 4; ++i) { const int mi = m0 + i * NGW; if (mi < Mact) { bf16_t* orow = BA + (size_t)mi * DM;
#pragma unroll
                  for (int j = 0; j < 4; ++j) { const f32x4 h = (xb[i][j] * r1[i] * gv[j]) * sc[j] + sh[j]; u32x2 w; w.x = cvtpk(h.x, h.y); w.y = cvtpk(h.z, h.w); ((u32x2*)orow)[lane + 64 * j] = w; } } } } }
        } else
        for (int m0 = gw; m0 < Mact; m0 += 4 * NGW) { f32x4 yb[4][4], xb[4][4];
#pragma unroll
            for (int i = 0; i < 4; ++i) { const int mi = m0 + i * NGW, mc = mi < Mact ? mi : m0; LOADY(mc, yb[i], 16); load16(XS_ROW(mc), lane, xb[i]); }
#pragma unroll
            for (int i = 0; i < 4; ++i) { const int mi = m0 + i * NGW; if (mi < Mact) R4_ROW(mi, yb[i], xb[i]); } } }
        if (!last) GBAR();
    }
}

extern "C" void kernel_launch(void* const* d_in, const int* in_sizes, int n_in, void* d_out, int out_size, void* d_ws, size_t ws_size, hipStream_t stream) {
    static int grid_blocks = 0;
    if (grid_blocks == 0) {
        if (n_in != 24 || out_size != NLAT * DM || ws_size < WS_END) { fprintf(stderr, "kernel_launch: unexpected shapes n_in %d out %d ws %zu\n", n_in, out_size, ws_size); grid_blocks = -1; return; }
        int dev = 0, cus = 0, per_cu = 0;
        hipGetDevice(&dev); hipDeviceGetAttribute(&cus, hipDeviceAttributeMultiprocessorCount, dev);
        if (hipFuncSetAttribute((const void*)fwd_megakernel, hipFuncAttributeMaxDynamicSharedMemorySize, LDS_BYTES) != hipSuccess) { fprintf(stderr, "kernel_launch: hipFuncSetAttribute failed\n"); grid_blocks = -1; return; }
        if (hipOccupancyMaxActiveBlocksPerMultiprocessor(&per_cu, (const void*)fwd_megakernel, 512, LDS_BYTES) != hipSuccess || per_cu < 1) { fprintf(stderr, "kernel_launch: occupancy query says %d\n", per_cu); per_cu = 1; (void)hipGetLastError(); }
        grid_blocks = cus * per_cu;
    }
    if (grid_blocks < 0) return;
    Params p{};
    for (int i = 0; i < 24; ++i) p.in[i] = (const float*)d_in[i];
    p.out = (float*)d_out; p.ws = (unsigned char*)d_ws;
    void* args[] = {&p};
    hipError_t e = hipLaunchCooperativeKernel((const void*)fwd_megakernel, dim3(grid_blocks), dim3(512), args, LDS_BYTES, stream);
    if (e != hipSuccess) fprintf(stderr, "cooperative launch failed: %s (grid %d)\n", hipGetErrorString(e), grid_blocks);
}
```

```cpp
#include <hip/hip_runtime.h>
#include <hip/hip_cooperative_groups.h>
#include <cstdio>
#include <cstdint>
namespace cg = cooperative_groups;
namespace pg8 {
#define PG8_LAS __attribute__((address_space(3)))
typedef unsigned short bf16_t;
typedef short bf16x8 __attribute__((ext_vector_type(8)));
typedef float f32x4 __attribute__((ext_vector_type(4)));
typedef unsigned u32x4 __attribute__((ext_vector_type(4)));
constexpr int BM = 256, BK = 64, HALF = 128, HTB = HALF * BK * 2  , STAGE_BYTES = 8 * HTB, NXCD = 8, WGM = 8;

__host__ __device__ __forceinline__ int lds_byte(int r, int c) { const int st = (r >> 4) * 2 + (c >> 5), rr = r & 15, cc = c & 31, ob = rr * 64 + cc * 2; return st * 1024 + (ob ^ (((ob >> 9) & 1) << 5)); }
__host__ __device__ __forceinline__ void stage_rc(int b, int& R, int& C) { const int st = b / 1024, sb = b % 1024, swz = sb ^ (((sb >> 9) & 1) << 5); R = (st >> 1) * 16 + swz / 64; C = (st & 1) * 32 + (swz % 64) / 2; }
__host__ __device__ __forceinline__ int perm32(int rho) { const int n = rho >> 4, i = rho & 15; return 8 * (i >> 2) + 4 * n + (i & 3); }

struct Unit { int pm, pn, kq; };
struct Gemm { const bf16_t* A; const bf16_t* Bt; int M, N, K, ld; };

struct StaticOrder {
    int nM, nN, nwg, G, c; bool rev = false;
    __host__ __device__ void init(int M, int N, int G_, int c_) { nM = M / BM; nN = N / BM; nwg = nM * nN; G = G_; c = c_; }
    __host__ __device__ bool next(int i, Unit& u) const {
        const long L = (long)i * G + c; if (L >= nwg) return false;
        int wgid = (int)L; { const int q = nwg / NXCD, r = nwg % NXCD, xcd = wgid % NXCD, off = wgid / NXCD; wgid = (xcd < r ? xcd * (q + 1) : r * (q + 1) + (xcd - r) * q) + off; }
        const int nig = WGM * nN, gid = wgid / nig, fm = gid * WGM, gsz = (nM - fm) < WGM ? (nM - fm) : WGM;
        u.pm = fm + ((wgid % nig) % gsz); u.pn = (wgid % nig) / gsz; u.kq = 0; if (rev) u.pm = nM - 1 - u.pm; return true;
    }
    __device__ __forceinline__ void a_ready(const Unit&) const {}
    __device__ __forceinline__ void done(const Unit&) const {}
};
struct SplitOrder {
    int nN, nsplit, mt0, total, G, c;
    __host__ __device__ void init(int nMt, int nN_, int nsplit_, int mt0_, int G_, int c_) { nN = nN_; nsplit = nsplit_; mt0 = mt0_; total = nMt * nN_ * nsplit_; G = G_; c = c_; }
    __host__ __device__ bool next(int i, Unit& u) const { const int L = i * G + c; if (L >= total) return false; u.kq = L % nsplit; const int t = L / nsplit; u.pn = t % nN; u.pm = mt0 + t / nN; return true; }
    __device__ __forceinline__ void a_ready(const Unit&) const {}
    __device__ __forceinline__ void done(const Unit&) const {}
};

__device__ __forceinline__ unsigned cvt_pk_bf16(float lo, float hi) { unsigned r; asm volatile("v_cvt_pk_bf16_f32 %0, %1, %2" : "=v"(r) : "v"(lo), "v"(hi)); return r; }
typedef float f32x2 __attribute__((ext_vector_type(2)));
template <int ACT> struct EpiBf16 {
    static constexpr bool PERM = true, AFTER_DRAIN = false;
    bf16_t* O; int ldc;
    __device__ __forceinline__ void operator()(const f32x4 (&acc)[2][2][4][2], const Unit& u, int wr, int wc, int fr, int fq) const {
        const int row0 = u.pm * BM + wr * 64 + fr; const int col0 = u.pn * BM + wc * 32 + 8 * fq;
#pragma unroll
        for (int ai = 0; ai < 2; ++ai)
#pragma unroll
            for (int m = 0; m < 4; ++m) { bf16_t* rowp = O + (size_t)(row0 + ai * HALF + m * 16) * ldc + col0;
#pragma unroll
                for (int bj = 0; bj < 2; ++bj) { f32x4 v0 = acc[ai][bj][m][0], v1 = acc[ai][bj][m][1];
                    if (ACT == 2) {
#pragma unroll
                        for (int e = 0; e < 4; ++e) { float a = fmaxf(v0[e], 0.f), b = fmaxf(v1[e], 0.f); v0[e] = a * a; v1[e] = b * b; } }
                    u32x4 w; w.x = cvt_pk_bf16(v0[0], v0[1]); w.y = cvt_pk_bf16(v0[2], v0[3]); w.z = cvt_pk_bf16(v1[0], v1[1]); w.w = cvt_pk_bf16(v1[2], v1[3]);
                    *(u32x4*)(rowp + bj * HALF) = w; } }
    }
};
struct EpiF32Part {
    static constexpr bool PERM = true, AFTER_DRAIN = false;
    float* P; int ldc; int mt0; size_t slice;
    __device__ __forceinline__ void operator()(const f32x4 (&acc)[2][2][4][2], const Unit& u, int wr, int wc, int fr, int fq) const {
        const int row0 = (u.pm - mt0) * BM + wr * 64 + fr; const int col0 = u.pn * BM + wc * 32 + 8 * fq; float* base = P + (size_t)u.kq * slice;
#pragma unroll
        for (int ai = 0; ai < 2; ++ai)
#pragma unroll
            for (int m = 0; m < 4; ++m) { float* rowp = base + (size_t)(row0 + ai * HALF + m * 16) * ldc + col0;
#pragma unroll
                for (int bj = 0; bj < 2; ++bj) { *(f32x4*)(rowp + bj * HALF) = acc[ai][bj][m][0]; *(f32x4*)(rowp + bj * HALF + 4) = acc[ai][bj][m][1]; } }
    }
};
template <class Epi, class Sched, bool ALIGN_EPI = false, bool SP2 = false>
__device__ __forceinline__ void gemm_phase(PG8_LAS unsigned char* lds, const Gemm g, const Sched& S, const Epi& E, int wave_s) {
    int tid = wave_s * 64 + (int)__builtin_amdgcn_mbcnt_hi(~0u, __builtin_amdgcn_mbcnt_lo(~0u, 0u)); asm volatile("" : "+v"(tid));
    const int wid = __builtin_amdgcn_readfirstlane(tid >> 6), lane = tid & 63, wr = wid >> 2, wc = wid & 3, fr = lane & 15, fq = lane >> 4;
    const int K = g.K, LD = g.ld, nt = K / BK;
    unsigned voffA[2], voffB[2];
#pragma unroll
    for (int i = 0; i < 2; ++i) { int R, C; stage_rc(tid * 16 + i * 8192, R, C); const int Rb = Epi::PERM ? ((R & ~31) + perm32(R & 31)) : R;
        voffA[i] = (unsigned)(R * LD + C) * 2u; voffB[i] = (unsigned)(Rb * LD + C) * 2u; }
    const size_t kstep = (size_t)(BK * 2);
    const size_t hstep = (size_t)HALF * LD * 2;
    const size_t tstep = 2 * hstep;
    const unsigned ldsw = (unsigned)wid * 1024u;
    const int aoff = lds_byte(wr * 64 + fr, fq * 8), boff = lds_byte(wc * 32 + fr, fq * 8);
#define PG8_SA(b, h) (((b) * 2 + (h)) * HTB)
#define PG8_SB(b, h) ((4 + (b) * 2 + (h)) * HTB)
#define PG8_STAGE(bufoff, gbase, voff) do { _Pragma("unroll") for (int _i = 0; _i < 2; ++_i) \
        __builtin_amdgcn_global_load_lds((const unsigned*)((const char*)(gbase) + (voff)[_i]), (PG8_LAS unsigned*)(lds + (bufoff) + ldsw + _i * 8192), 16, 0, 0); } while (0)
#define PG8_LDA(dst, b, h) do { _Pragma("unroll") for (int m = 0; m < 4; ++m) _Pragma("unroll") for (int k = 0; k < 2; ++k) dst[m][k] = *(const PG8_LAS bf16x8*)(lds + PG8_SA(b, h) + aoff + m * 2048 + k * 1024); } while (0)
#define PG8_LDB(dst, b, h) do { _Pragma("unroll") for (int n = 0; n < 2; ++n) _Pragma("unroll") for (int k = 0; k < 2; ++k) dst[n][k] = *(const PG8_LAS bf16x8*)(lds + PG8_SB(b, h) + boff + n * 2048 + k * 1024); } while (0)
#define PG8_MMA(ai, bj, At, Bt) do { __builtin_amdgcn_s_setprio(1); _Pragma("unroll") for (int m = 0; m < 4; ++m) _Pragma("unroll") for (int n = 0; n < 2; ++n) _Pragma("unroll") for (int k = 0; k < 2; ++k) \
        acc[ai][bj][m][n] = __builtin_amdgcn_mfma_f32_16x16x32_bf16(Bt[n][k], At[m][k], acc[ai][bj][m][n], 0, 0, 0); __builtin_amdgcn_s_setprio(0); } while (0)
#define PG8_WAIT_V(n) asm volatile("s_waitcnt vmcnt(" #n ")" ::: "memory")
#define PG8_WAIT_L(n) asm volatile("s_waitcnt lgkmcnt(" #n ")" ::: "memory")
#define PG8_BAR __builtin_amdgcn_s_barrier()
#define PG8_SCHED __builtin_amdgcn_sched_barrier(0)
    Unit cur, nxt; int ui = 0;
    if (!S.next(0, cur)) return;
    f32x4 acc[2][2][4][2];
#pragma unroll
    for (int a = 0; a < 2; ++a)
#pragma unroll
        for (int b = 0; b < 2; ++b)
#pragma unroll
            for (int m = 0; m < 4; ++m)
#pragma unroll
                for (int n = 0; n < 2; ++n) acc[a][b][m][n] = (f32x4){0.f, 0.f, 0.f, 0.f};
    bf16x8 At[4][2], B0[2][2], B1[2][2];
    const size_t kqstep = (size_t)K * 2;
    const char* cA = (const char*)g.A + (size_t)cur.pm * tstep + (size_t)cur.kq * kqstep; const char* cB = (const char*)g.Bt + (size_t)cur.pn * tstep + (size_t)cur.kq * kqstep;
    S.a_ready(cur);
    if constexpr (SP2) {
        PG8_STAGE(PG8_SB(0, 0), cB, voffB); PG8_STAGE(PG8_SB(0, 1), cB + hstep, voffB); PG8_STAGE(PG8_SA(0, 0), cA, voffA); PG8_STAGE(PG8_SA(0, 1), cA + hstep, voffA);
        if (wr == 1) PG8_BAR;
        PG8_WAIT_V(2); PG8_BAR;
        PG8_STAGE(PG8_SB(1, 0), cB + kstep, voffB); PG8_STAGE(PG8_SA(1, 0), cA + kstep, voffA); PG8_STAGE(PG8_SB(1, 1), cB + hstep + kstep, voffB);
        PG8_WAIT_V(6); PG8_BAR;
    } else {
        PG8_STAGE(PG8_SB(0, 0), cB, voffB); PG8_STAGE(PG8_SA(0, 0), cA, voffA); PG8_STAGE(PG8_SB(0, 1), cB + hstep, voffB); PG8_STAGE(PG8_SA(0, 1), cA + hstep, voffA);
        if (wr == 1) PG8_BAR;
        PG8_WAIT_V(4); PG8_BAR;
        PG8_STAGE(PG8_SB(1, 0), cB + kstep, voffB); PG8_STAGE(PG8_SA(1, 0), cA + kstep, voffA); PG8_STAGE(PG8_SB(1, 1), cB + hstep + kstep, voffB);
        PG8_WAIT_V(6); PG8_BAR;
    }
    for (;;) {
        const bool has_next = S.next(ui + 1, nxt);
        const char* nA = has_next ? (const char*)g.A + (size_t)nxt.pm * tstep + (size_t)nxt.kq * kqstep : cA; const char* nB = has_next ? (const char*)g.Bt + (size_t)nxt.pn * tstep + (size_t)nxt.kq * kqstep : cB;
        for (int t = 0; t < nt; t += 2) {
            const bool last = (t == nt - 2);
            const char* a1 = cA + (size_t)(t + 1) * kstep;
            const char* a2 = last ? nA : cA + (size_t)(t + 2) * kstep; const char* b2 = last ? nB : cB + (size_t)(t + 2) * kstep;
            const char* a3 = a2 + kstep; const char* b3 = b2 + kstep;
            if (last && has_next) S.a_ready(nxt);
            if constexpr (SP2) {
            PG8_LDB(B0, 0, 0); PG8_LDB(B1, 0, 1); PG8_SCHED; PG8_LDA(At, 0, 0); PG8_STAGE(PG8_SA(1, 1), a1 + hstep, voffA);
            PG8_WAIT_V(8); PG8_WAIT_L(0); PG8_BAR; PG8_MMA(0, 0, At, B0); PG8_MMA(0, 1, At, B1); PG8_BAR; PG8_SCHED;
            PG8_LDA(At, 0, 1); PG8_STAGE(PG8_SB(0, 0), b2, voffB); PG8_STAGE(PG8_SB(0, 1), b2 + hstep, voffB); PG8_STAGE(PG8_SA(0, 0), a2, voffA);
            PG8_WAIT_V(8); PG8_WAIT_L(0); PG8_BAR; PG8_MMA(1, 0, At, B0); PG8_MMA(1, 1, At, B1); PG8_BAR; PG8_SCHED;
            PG8_LDB(B0, 1, 0); PG8_LDB(B1, 1, 1); PG8_SCHED; PG8_LDA(At, 1, 0); PG8_STAGE(PG8_SA(0, 1), a2 + hstep, voffA);
            PG8_WAIT_V(8); PG8_WAIT_L(0); PG8_BAR; PG8_MMA(0, 0, At, B0); PG8_MMA(0, 1, At, B1); PG8_BAR; PG8_SCHED;
            PG8_LDA(At, 1, 1); PG8_STAGE(PG8_SB(1, 0), b3, voffB); PG8_STAGE(PG8_SB(1, 1), b3 + hstep, voffB); PG8_STAGE(PG8_SA(1, 0), a3, voffA);
            PG8_WAIT_V(8); PG8_WAIT_L(0); PG8_BAR; PG8_MMA(1, 0, At, B0); PG8_MMA(1, 1, At, B1); PG8_BAR; PG8_SCHED;
            } else {
            PG8_LDB(B0, 0, 0); PG8_SCHED; PG8_LDA(At, 0, 0); PG8_STAGE(PG8_SA(1, 1), a1 + hstep, voffA);
            PG8_WAIT_L(8); PG8_BAR; PG8_WAIT_L(0); PG8_MMA(0, 0, At, B0); PG8_BAR; PG8_SCHED;
            PG8_LDB(B1, 0, 1); PG8_STAGE(PG8_SB(0, 0), b2, voffB);
            PG8_BAR; PG8_WAIT_L(0); PG8_MMA(0, 1, At, B1); PG8_BAR;
            PG8_LDA(At, 0, 1); PG8_STAGE(PG8_SA(0, 0), a2, voffA);
            PG8_BAR; PG8_WAIT_L(0); PG8_MMA(1, 0, At, B0); PG8_BAR; PG8_SCHED;
            PG8_STAGE(PG8_SB(0, 1), b2 + hstep, voffB);
            PG8_WAIT_V(6); PG8_BAR; PG8_MMA(1, 1, At, B1); PG8_BAR;
            PG8_LDB(B0, 1, 0); PG8_SCHED; PG8_LDA(At, 1, 0); PG8_STAGE(PG8_SA(0, 1), a2 + hstep, voffA);
            PG8_WAIT_L(8); PG8_BAR; PG8_WAIT_L(0); PG8_MMA(0, 0, At, B0); PG8_BAR; PG8_SCHED;
            PG8_LDB(B1, 1, 1); PG8_STAGE(PG8_SB(1, 0), b3, voffB);
            PG8_BAR; PG8_WAIT_L(0); PG8_MMA(0, 1, At, B1); PG8_BAR;
            PG8_LDA(At, 1, 1); PG8_STAGE(PG8_SA(1, 0), a3, voffA);
            PG8_BAR; PG8_WAIT_L(0); PG8_MMA(1, 0, At, B0); PG8_BAR; PG8_SCHED;
            PG8_STAGE(PG8_SB(1, 1), b3 + hstep, voffB);
            PG8_WAIT_V(6); PG8_BAR; PG8_MMA(1, 1, At, B1); PG8_BAR;
            }
        }
        if constexpr (ALIGN_EPI) { if (wr == 0) PG8_BAR; }
        if constexpr (!Epi::AFTER_DRAIN) { E(acc, cur, wr, wc, fr, fq); S.done(cur); }
        if (!has_next) break;
#pragma unroll
        for (int a = 0; a < 2; ++a)
#pragma unroll
            for (int b = 0; b < 2; ++b)
#pragma unroll
                for (int m = 0; m < 4; ++m)
#pragma unroll
                    for (int n = 0; n < 2; ++n) acc[a][b][m][n] = (f32x4){0.f, 0.f, 0.f, 0.f};
        cur = nxt; cA = nA; cB = nB; ++ui;
        if constexpr (ALIGN_EPI) { if (wr == 1) PG8_BAR; }
    }
    PG8_WAIT_V(0);
    if constexpr (!ALIGN_EPI) { if (wr == 0) PG8_BAR; }
    PG8_BAR;
    if constexpr (Epi::AFTER_DRAIN) { E.fused(acc, cur, wr, wc, fr, fq, lds, wid, lane); S.done(cur); }
#undef PG8_SA
#undef PG8_SB
#undef PG8_STAGE
#undef PG8_LDA
#undef PG8_LDB
#undef PG8_MMA
#undef PG8_WAIT_V
#undef PG8_WAIT_L
#undef PG8_BAR
#undef PG8_SCHED
}
}

#define LAS __attribute__((address_space(3)))
typedef unsigned short bf16_t;
typedef short bf16x8 __attribute__((ext_vector_type(8)));
typedef short s16x4 __attribute__((ext_vector_type(4)));
typedef float f32x4 __attribute__((ext_vector_type(4)));
typedef float f32x16 __attribute__((ext_vector_type(16)));
typedef unsigned u32x2 __attribute__((ext_vector_type(2)));
typedef unsigned u32x4 __attribute__((ext_vector_type(4)));
__device__ __forceinline__ unsigned cvtpk(float lo, float hi) { unsigned r; asm volatile("v_cvt_pk_bf16_f32 %0, %1, %2" : "=v"(r) : "v"(lo), "v"(hi)); return r; }
__device__ __forceinline__ float bflo(unsigned w) { return __uint_as_float(w << 16); }
__device__ __forceinline__ float bfhi(unsigned w) { return __uint_as_float(w & 0xffff0000u); }
__device__ __forceinline__ float bf2f(unsigned short h) { return __uint_as_float((unsigned)h << 16); }
__device__ __forceinline__ unsigned short f2bf(float f) { unsigned u = __float_as_uint(f); return (unsigned short)((u + 0x7fffu + ((u >> 16) & 1u)) >> 16); }
__device__ __forceinline__ int lane_id() { return (int)__builtin_amdgcn_mbcnt_hi(~0u, __builtin_amdgcn_mbcnt_lo(~0u, 0u)); }
template <int X> __device__ __forceinline__ float swz_xor(float v) { return __int_as_float(__builtin_amdgcn_ds_swizzle(__float_as_int(v), (X << 10) | 0x1f)); }
template <int CTRL, int ROWMASK> __device__ __forceinline__ float dpp_f(float v) { return __int_as_float(__builtin_amdgcn_update_dpp(0, __float_as_int(v), CTRL, ROWMASK, 0xF, false)); }
__device__ __forceinline__ float wave_sum(float v) {
    v += dpp_f<0xB1, 0xF>(v);
    v += dpp_f<0x4E, 0xF>(v);
    v += dpp_f<0x141, 0xF>(v);
    v += dpp_f<0x140, 0xF>(v);
    v += dpp_f<0x142, 0xA>(v);
    v += dpp_f<0x143, 0xC>(v);
    return __builtin_amdgcn_readlane(v, 63);
}
__device__ __forceinline__ float sigmoidf_(float x) { return __builtin_amdgcn_rcpf(1.f + __expf(-x)); }
__device__ __forceinline__ float rope_inv(int i) { return exp2f(-1.6609640474436813f * (float)i); }

namespace att {
constexpr int NW = 8, QBLK = 32, KVBLK = 64;
constexpr float SCALE = 0.10206207261596575f;
constexpr float THR = 8.f;
constexpr int BUFB = 16384;
constexpr int NRING = 3, OFF_V = 0, OFF_K = NRING * BUFB, OFF_WS = 2 * NRING * BUFB, LDS_BYTES = OFF_WS + NW * 64 * 4;
#define KSWZ(row, colB) ((row) * 256 + ((colB) ^ (((row) & 15) << 4)))
#define SBAR() __builtin_amdgcn_sched_barrier(0)
__device__ __forceinline__ int crow(int r, int hi) { return (r & 3) + 8 * (r >> 2) + 4 * hi; }
constexpr float C2 = SCALE * 1.4426950408889634f;
constexpr float THR2 = THR * 1.4426950408889634f;
#define MX3(a, b, c) __builtin_fmaxf(__builtin_fmaxf((a), (b)), (c))
__device__ __forceinline__ void softmaxT(f32x16& p0, f32x16& p1, float& mref, f32x16& negm, float& l_reg, float& alpha, bf16x8& pa0, bf16x8& pa1, bf16x8& pa2, bf16x8& pa3) {
  float a = MX3(p0[0], p0[1], p1[0]), b = MX3(p0[2], p0[3], p1[1]); a = MX3(a, p1[2], p1[3]);
#pragma unroll
  for (int r = 4; r < 16; r += 4) { a = MX3(a, p0[r], p0[r + 1]); b = MX3(b, p0[r + 2], p0[r + 3]); a = MX3(a, p1[r], p1[r + 1]); b = MX3(b, p1[r + 2], p1[r + 3]); }
  float pmax = __builtin_fmaxf(a, b);
  { auto rr = __builtin_amdgcn_permlane32_swap(__float_as_uint(pmax), __float_as_uint(pmax), false, false);
    pmax = __builtin_fmaxf(__uint_as_float(rr[0]), __uint_as_float(rr[1])); }
  if (__builtin_expect(__all(pmax <= THR2), 1)) { alpha = 1.f; }
  else { const float dl = __builtin_fmaxf(pmax, 0.f); mref += dl; alpha = __builtin_amdgcn_exp2f(-dl); l_reg *= alpha;
#pragma unroll
    for (int r = 0; r < 16; ++r) { p0[r] -= dl; p1[r] -= dl; negm[r] = -mref; }
    asm volatile("" : "+v"(negm)); }
#pragma unroll
  for (int r = 0; r < 16; ++r) { p0[r] = __builtin_amdgcn_exp2f(p0[r]); p1[r] = __builtin_amdgcn_exp2f(p1[r]); }
  { float s0 = p0[0] + p1[0], s1 = p0[1] + p1[1], s2 = p0[2] + p1[2], s3 = p0[3] + p1[3];
#pragma unroll
    for (int r = 4; r < 16; r += 4) { s0 += p0[r] + p1[r]; s1 += p0[r + 1] + p1[r + 1]; s2 += p0[r + 2] + p1[r + 2]; s3 += p0[r + 3] + p1[r + 3]; }
    l_reg += (s0 + s1) + (s2 + s3); }
#define PK4(P, BASE, OUT) do { unsigned a0 = cvtpk(P[BASE + 0], P[BASE + 1]), a1 = cvtpk(P[BASE + 2], P[BASE + 3]);   \
    unsigned b0 = cvtpk(P[BASE + 4], P[BASE + 5]), b1 = cvtpk(P[BASE + 6], P[BASE + 7]);                              \
    auto r0 = __builtin_amdgcn_permlane32_swap(a0, b0, false, false); auto r1 = __builtin_amdgcn_permlane32_swap(a1, b1, false, false); \
    u32x4 w = {r0[0], r1[0], r0[1], r1[1]}; OUT = __builtin_bit_cast(bf16x8, w); } while (0)
  PK4(p0, 0, pa0); PK4(p0, 8, pa1); PK4(p1, 0, pa2); PK4(p1, 8, pa3);
#undef PK4
}
__device__ __forceinline__ void partialSM(f32x16& p0, f32x16& p1, float& mref, f32x16& negm, float& alpha) {
  float a = MX3(p0[0], p0[1], p1[0]), b = MX3(p0[2], p0[3], p1[1]); a = MX3(a, p1[2], p1[3]);
#pragma unroll
  for (int r = 4; r < 16; r += 4) { a = MX3(a, p0[r], p0[r + 1]); b = MX3(b, p0[r + 2], p0[r + 3]); a = MX3(a, p1[r], p1[r + 1]); b = MX3(b, p1[r + 2], p1[r + 3]); }
  float pmax = __builtin_fmaxf(a, b);
  { auto rr = __builtin_amdgcn_permlane32_swap(__float_as_uint(pmax), __float_as_uint(pmax), false, false);
    pmax = __builtin_fmaxf(__uint_as_float(rr[0]), __uint_as_float(rr[1])); }
  if (__builtin_expect(__all(pmax <= THR2), 1)) { alpha = 1.f; }
  else { const float dl = __builtin_fmaxf(pmax, 0.f); mref += dl; alpha = __builtin_amdgcn_exp2f(-dl);
#pragma unroll
    for (int r = 0; r < 16; ++r) { p0[r] -= dl; p1[r] -= dl; negm[r] = -mref; }
    asm volatile("" : "+v"(negm)); }
#pragma unroll
  for (int r = 0; r < 16; ++r) p0[r] = __builtin_amdgcn_exp2f(p0[r]);
}
__device__ __forceinline__ void finishSM(f32x16& p0, f32x16& p1, float& l_reg, bf16x8& pa0, bf16x8& pa1, bf16x8& pa2, bf16x8& pa3) {
#pragma unroll
  for (int r = 0; r < 16; ++r) p1[r] = __builtin_amdgcn_exp2f(p1[r]);
  { float s0 = p0[0] + p1[0], s1 = p0[1] + p1[1], s2 = p0[2] + p1[2], s3 = p0[3] + p1[3];
#pragma unroll
    for (int r = 4; r < 16; r += 4) { s0 += p0[r] + p1[r]; s1 += p0[r + 1] + p1[r + 1]; s2 += p0[r + 2] + p1[r + 2]; s3 += p0[r + 3] + p1[r + 3]; }
    l_reg += (s0 + s1) + (s2 + s3); }
#define PK4(P, BASE, OUT) do { unsigned a0 = cvtpk(P[BASE + 0], P[BASE + 1]), a1 = cvtpk(P[BASE + 2], P[BASE + 3]);   \
    unsigned b0 = cvtpk(P[BASE + 4], P[BASE + 5]), b1 = cvtpk(P[BASE + 6], P[BASE + 7]);                              \
    auto r0 = __builtin_amdgcn_permlane32_swap(a0, b0, false, false); auto r1 = __builtin_amdgcn_permlane32_swap(a1, b1, false, false); \
    u32x4 w = {r0[0], r1[0], r0[1], r1[1]}; OUT = __builtin_bit_cast(bf16x8, w); } while (0)
  PK4(p0, 0, pa0); PK4(p0, 8, pa1); PK4(p1, 0, pa2); PK4(p1, 8, pa3);
#undef PK4
}
__device__ __forceinline__ void qkt(f32x16& p0, f32x16& p1, const LAS unsigned char* Ks, const bf16x8* qr, const f32x16& negm, int r32, int hi) {
  bf16x8 kf[12];
#pragma unroll
  for (int d0 = 0; d0 < 6; ++d0) { const int cb = (d0 * 16 + hi * 8) * 2;
    kf[2 * d0] = *(const LAS bf16x8*)(Ks + KSWZ(r32, cb)); kf[2 * d0 + 1] = *(const LAS bf16x8*)(Ks + KSWZ(32 + r32, cb)); }
  SBAR();
  p0 = __builtin_amdgcn_mfma_f32_32x32x16_bf16(kf[0], qr[0], negm, 0, 0, 0); p1 = __builtin_amdgcn_mfma_f32_32x32x16_bf16(kf[1], qr[0], negm, 0, 0, 0);
#pragma unroll
  for (int d0 = 1; d0 < 6; ++d0) { p0 = __builtin_amdgcn_mfma_f32_32x32x16_bf16(kf[2 * d0], qr[d0], p0, 0, 0, 0); p1 = __builtin_amdgcn_mfma_f32_32x32x16_bf16(kf[2 * d0 + 1], qr[d0], p1, 0, 0, 0); }
}
__device__ __forceinline__ int v_st(int k, int c) { const int kk = (k & ~0xC) | ((k & 4) << 1) | ((k & 8) >> 1); return ((kk >> 3) * 4 + (c >> 5)) * 512 + ((kk & 7) * 32 + (c & 31)) * 2; }
__device__ __forceinline__ int v_rd_base(int lane) { return ((lane & 3) << 3) | (((lane >> 2) & 3) << 6) | (((lane >> 4) & 1) << 5) | (((lane >> 5) & 1) << 8); }
constexpr int v_rd_off(int d0, int ks, int half) { return d0 * 512 + ks * 4096 + half * 2048; }
template <int OFF> __device__ __forceinline__ s16x4 tr_read(int vb) {
  s16x4 r; asm volatile("ds_read_b64_tr_b16 %0, %1 offset:%2" : "=&v"(r) : "v"(vb), "i"(OFF) : "memory"); return r;
}
__device__ __forceinline__ void pv_d0(f32x16* o, int vb, bf16x8 pa0, bf16x8 pa1, bf16x8 pa2, bf16x8 pa3) {
  const s16x4 a0 = tr_read<v_rd_off(0, 0, 0)>(vb), b0 = tr_read<v_rd_off(0, 0, 1)>(vb), a1 = tr_read<v_rd_off(0, 1, 0)>(vb), b1 = tr_read<v_rd_off(0, 1, 1)>(vb);
  const s16x4 a2 = tr_read<v_rd_off(0, 2, 0)>(vb), b2 = tr_read<v_rd_off(0, 2, 1)>(vb), a3 = tr_read<v_rd_off(0, 3, 0)>(vb), b3 = tr_read<v_rd_off(0, 3, 1)>(vb);
  const s16x4 c0 = tr_read<v_rd_off(1, 0, 0)>(vb), d0 = tr_read<v_rd_off(1, 0, 1)>(vb), c1 = tr_read<v_rd_off(1, 1, 0)>(vb), d1 = tr_read<v_rd_off(1, 1, 1)>(vb);
  const s16x4 c2 = tr_read<v_rd_off(1, 2, 0)>(vb), d2 = tr_read<v_rd_off(1, 2, 1)>(vb), c3 = tr_read<v_rd_off(1, 3, 0)>(vb), d3 = tr_read<v_rd_off(1, 3, 1)>(vb);
  asm volatile("s_waitcnt lgkmcnt(0)" ::: "memory"); SBAR();
#define PK(L, H) (bf16x8){L[0], L[1], L[2], L[3], H[0], H[1], H[2], H[3]}
  o[0] = __builtin_amdgcn_mfma_f32_32x32x16_bf16(pa0, PK(a0, b0), o[0], 0, 0, 0); o[1] = __builtin_amdgcn_mfma_f32_32x32x16_bf16(pa0, PK(c0, d0), o[1], 0, 0, 0);
  o[0] = __builtin_amdgcn_mfma_f32_32x32x16_bf16(pa1, PK(a1, b1), o[0], 0, 0, 0); o[1] = __builtin_amdgcn_mfma_f32_32x32x16_bf16(pa1, PK(c1, d1), o[1], 0, 0, 0);
  o[0] = __builtin_amdgcn_mfma_f32_32x32x16_bf16(pa2, PK(a2, b2), o[0], 0, 0, 0); o[1] = __builtin_amdgcn_mfma_f32_32x32x16_bf16(pa2, PK(c2, d2), o[1], 0, 0, 0);
  o[0] = __builtin_amdgcn_mfma_f32_32x32x16_bf16(pa3, PK(a3, b3), o[0], 0, 0, 0); o[1] = __builtin_amdgcn_mfma_f32_32x32x16_bf16(pa3, PK(c3, d3), o[1], 0, 0, 0);
#undef PK
}
__device__ __forceinline__ void attn_unit(const bf16_t* __restrict__ Qb, bool rope_q, int tq0, const bf16_t* __restrict__ KVh, const bf16_t* __restrict__ KR,
                                          int ctx_row0, int lat_row0, int NT, bf16_t* __restrict__ Ob, LAS unsigned char* lds, int wave_s) {
  int tid = wave_s * 64 + lane_id(); asm volatile("" : "+v"(tid));
  const int wid = tid >> 6, lane = tid & 63, r32 = lane & 31, hi = lane >> 5;
  LAS float* al_l = (LAS float*)(lds + OFF_WS) + wid * 64;
  float mref = 0.f, l_reg = 0.f; f32x16 o[2] = {}; f32x16 negm = {}; asm volatile("" : "+v"(negm)); bf16x8 qr[6];
  { const bf16_t* Qw = Qb + (long)(wid * QBLK + r32) * 768;
#pragma unroll
    for (int d0 = 0; d0 < 4; ++d0) { const u32x4 w = *(const u32x4*)(Qw + d0 * 16 + hi * 8);
      u32x4 s = {cvtpk(bflo(w.x) * C2, bfhi(w.x) * C2), cvtpk(bflo(w.y) * C2, bfhi(w.y) * C2), cvtpk(bflo(w.z) * C2, bfhi(w.z) * C2), cvtpk(bflo(w.w) * C2, bfhi(w.w) * C2)};
      qr[d0] = __builtin_bit_cast(bf16x8, s); }
    const int t = tq0 + wid * QBLK + r32;
#pragma unroll
    for (int a = 0; a < 2; ++a) {
      const u32x4 lo = *(const u32x4*)(Qw + 64 + a * 16), hh = *(const u32x4*)(Qw + 64 + a * 16 + 8);
      const float pos = (float)(a == 0 ? (t >> 6) : (t & 63)); float ov[8];
#pragma unroll
      for (int i = 0; i < 8; ++i) { const float ang = rope_q ? pos * rope_inv(i) : 0.f, c = __cosf(ang) * C2, s = __sinf(ang) * C2;
        const float l = (i & 1) ? bfhi(lo[i >> 1]) : bflo(lo[i >> 1]), h = (i & 1) ? bfhi(hh[i >> 1]) : bflo(hh[i >> 1]);
        ov[i] = hi ? (h * c + l * s) : (l * c - h * s); }
      u32x4 w = {cvtpk(ov[0], ov[1]), cvtpk(ov[2], ov[3]), cvtpk(ov[4], ov[5]), cvtpk(ov[6], ov[7])}; qr[4 + a] = __builtin_bit_cast(bf16x8, w);
    }
  }
  const int sr = tid >> 4, sc = (tid & 15) * 8, rr = (tid & 255) >> 2, rc = (tid & 3) * 8;
  const int st0 = (sc < 64) ? OFF_K + KSWZ(sr, sc * 2) : OFF_V + v_st(sr, sc - 64);
  const int st1 = (sc < 64) ? OFF_K + KSWZ(32 + sr, sc * 2) : OFF_V + v_st(32 + sr, sc - 64);
  const int st2 = OFF_K + KSWZ(rr, (64 + rc) * 2);
  const int vb0 = (int)(size_t)(lds + OFF_V) + v_rd_base(lane);
  struct { bf16x8 a0, a1, rp; } sg[2];
#define KROW(t) ((t) < 4 ? ctx_row0 + (t) * KVBLK : lat_row0 + ((t) - 4) * KVBLK)
#define SLOAD(i, t) do { const long k0_ = KROW(t); sg[i].a0 = *(const bf16x8*)(KVh + (k0_ + sr) * 1024 + sc); sg[i].a1 = *(const bf16x8*)(KVh + (k0_ + 32 + sr) * 1024 + sc); \
    sg[i].rp = *(const bf16x8*)(KR + (k0_ + rr) * 32 + rc); } while (0)
#define SWRITE_AT(boff, i) do { *(LAS bf16x8*)(lds + (boff) + st0) = sg[i].a0; *(LAS bf16x8*)(lds + (boff) + st1) = sg[i].a1; *(LAS bf16x8*)(lds + (boff) + st2) = sg[i].rp; } while (0)
#define RESC(a) do { if (__any((a) < 1.f)) { if (hi == 0) al_l[r32] = (a); asm volatile("s_waitcnt lgkmcnt(0)" ::: "memory"); \
    _Pragma("unroll") for (int r = 0; r < 16; ++r) { const float f_ = al_l[crow(r, hi)]; o[0][r] *= f_; o[1][r] *= f_; } } } while (0)
  const int trail = (wave_s >= 4) ? 1 : 0;
  const LAS unsigned char* Kb = lds + OFF_K;
  f32x16 p0, p1; float alpha; bf16x8 pa0, pa1, pa2, pa3;
  SLOAD(0, 0); SLOAD(1, 1);
  asm volatile("s_waitcnt vmcnt(3)" ::: "memory"); SWRITE_AT(0, 0);
  if (trail) { asm volatile("s_waitcnt vmcnt(0)" ::: "memory"); SWRITE_AT(BUFB, 1); SLOAD(1, 2); SLOAD(0, 3); }
  else { SLOAD(0, 2); }
  __syncthreads();
  if (trail) __syncthreads();
  int bV = 0, bK = 0, bN = BUFB, bNN = 2 * BUFB;
#define PHASE_M(j) do { SBAR(); __builtin_amdgcn_s_setprio(2); if ((j) > 0) pv_d0(o, vb0 + bV, pa0, pa1, pa2, pa3); qkt(p0, p1, Kb + bK, qr, negm, r32, hi); __builtin_amdgcn_s_setprio(0); SBAR(); __syncthreads(); } while (0)
#define PHASE_V(j, slot) do { softmaxT(p0, p1, mref, negm, l_reg, alpha, pa0, pa1, pa2, pa3); RESC(alpha); \
    { const int s_ = (j) + 1 + trail; if (s_ < NT) { asm volatile("s_waitcnt vmcnt(3)" ::: "memory"); SWRITE_AT(trail ? bNN : bN, slot); const int s2_ = s_ + 2; SLOAD(slot, s2_ < NT ? s2_ : NT - 1); } } \
    __syncthreads(); bV = bK; bK = bN; bN = bNN; bNN = bV; } while (0)
  for (int j = 0; j < NT; j += 2) {
    PHASE_M(j); PHASE_V(j, 1);
    PHASE_M(j + 1); PHASE_V(j + 1, 0);
  }
  SBAR(); pv_d0(o, vb0 + bV, pa0, pa1, pa2, pa3);
  if (!trail) __syncthreads();
#undef PHASE_M
#undef PHASE_V
  { auto rr_ = __builtin_amdgcn_permlane32_swap(__float_as_uint(l_reg), __float_as_uint(l_reg), false, false); l_reg = __uint_as_float(rr_[0]) + __uint_as_float(rr_[1]); }
  if (hi == 0) al_l[32 + r32] = l_reg; asm volatile("s_waitcnt lgkmcnt(0)" ::: "memory");
  float rli[16];
#pragma unroll
  for (int r = 0; r < 16; ++r) rli[r] = __builtin_amdgcn_rcpf(al_l[32 + crow(r, hi)]);
  bf16_t* Ow = Ob + (long)(wid * QBLK) * 1024;
#pragma unroll
  for (int r = 0; r < 16; ++r) { const int orow = crow(r, hi);
#pragma unroll
    for (int d0 = 0; d0 < 2; ++d0) Ow[(long)orow * 1024 + d0 * 32 + r32] = f2bf(o[d0][r] * rli[r]); }
  __syncthreads();
#undef KROW
#undef SLOAD
#undef SWRITE_AT
#undef RESC
}
}

constexpr int NLAT = 32768, NCTX = 1024, MTOT = 33792, DM = 1024, ZW = 1792, INW = 1696, SEQL = 8192, CTXL = 256, DFF = 4096;
constexpr float EPSN = 1e-6f;
constexpr size_t MiB = 1u << 20;
constexpr size_t WS_MOD = 1 * MiB;
constexpr size_t WS_W = 2 * MiB, W_LAYER = 23 * MiB;
constexpr size_t W_IN = 0, W_Q = 3584 * 1024, W_KV = 4 * MiB, W_O = 4608 * 1024, W_UP = 7 * MiB, W_DN = 15 * MiB;
constexpr size_t WS_A = 48 * MiB;
constexpr size_t WS_B = 114 * MiB;
constexpr size_t WS_Z = WS_B, WS_Q = WS_B + 116 * MiB, WS_KV = WS_B + 166 * MiB, WS_QN = WS_B + 232 * MiB, WS_KVN = WS_B + 249 * MiB, WS_KR = WS_B + 258 * MiB;
constexpr size_t WS_D = 378 * MiB;
constexpr size_t WS_XSC = 444 * MiB;
constexpr size_t WS_PART = 448 * MiB;
constexpr size_t WS_END = 512 * MiB;
static_assert((size_t)MTOT * ZW * 2 <= 116 * MiB && (size_t)MTOT * 768 * 2 <= 50 * MiB && (size_t)MTOT * 1024 * 2 <= 66 * MiB && (size_t)MTOT * 256 * 2 <= 17 * MiB && (size_t)MTOT * 128 * 2 <= 9 * MiB && WS_KR + (size_t)MTOT * 64 <= WS_B + 264 * MiB, "ws map");
constexpr int LDS_BYTES = 147456;

struct Params { const float* in[24]; float* out; unsigned char* ws; };
enum { I_X = 0, I_C, I_CTX, I_CCTX, I_WMOD, I_BMOD, I_GPREMIX, I_GPOSTMIX, I_GPREMLP, I_GPOSTMLP, I_WIN, I_GQ, I_WQB, I_GKV, I_WKVB, I_CDWW, I_CDWB, I_CLNG, I_CLNB, I_SDWW, I_GBR, I_WO, I_WUP, I_WDN };

__device__ __forceinline__ void transpose_item(const float* __restrict__ W, int K, int N, bf16_t* __restrict__ WT, LAS float* scr, int item, int lane) {
    const int nblk = N / 32, kb = item / nblk, nb = item % nblk, k0 = 64 * kb, n0 = 32 * nb;
#pragma unroll 8
    for (int i = 0; i < 32; ++i) { const int kk = 2 * i + (lane >> 5); scr[kk * 33 + (lane & 31)] = W[(size_t)(k0 + kk) * N + n0 + (lane & 31)]; }
    asm volatile("s_waitcnt lgkmcnt(0)" ::: "memory");
    const int c = lane & 7;
#pragma unroll
    for (int j = 0; j < 4; ++j) { const int n = (lane >> 3) + 8 * j; const LAS float* s = scr + (8 * c) * 33 + n;
        u32x4 o; o.x = cvtpk(s[0 * 33], s[1 * 33]); o.y = cvtpk(s[2 * 33], s[3 * 33]); o.z = cvtpk(s[4 * 33], s[5 * 33]); o.w = cvtpk(s[6 * 33], s[7 * 33]);
        *(u32x4*)(WT + (size_t)(n0 + n) * K + k0 + 8 * c) = o; }
    asm volatile("s_waitcnt lgkmcnt(0)" ::: "memory");
}
__device__ __forceinline__ void load16(const float* row, int lane, f32x4 (&v)[4]) {
#pragma unroll
    for (int j = 0; j < 4; ++j) v[j] = __builtin_nontemporal_load((const f32x4*)row + lane + 64 * j);
}
__device__ __forceinline__ void load16bf(const bf16_t* row, int lane, f32x4 (&v)[4]) {
#pragma unroll
    for (int j = 0; j < 4; ++j) { const u32x2 w = __builtin_nontemporal_load((const u32x2*)row + lane + 64 * j); v[j] = (f32x4){bflo(w.x), bfhi(w.x), bflo(w.y), bfhi(w.y)}; }
}
template <int NS> __device__ __forceinline__ void load16part(const float* P, int rowrel, int lane, f32x4 (&v)[4]) {
#pragma unroll
    for (int j = 0; j < 4; ++j) v[j] = (f32x4){0.f, 0.f, 0.f, 0.f};
#pragma unroll
    for (int s0 = 0; s0 < NS; s0 += 4) { f32x4 t[4][4];
#pragma unroll
        for (int s = 0; s < 4; ++s) { const f32x4* q = (const f32x4*)(P + ((size_t)(s0 + s) * 1024 + rowrel) * 1024);
#pragma unroll
            for (int j = 0; j < 4; ++j) t[s][j] = q[lane + 64 * j]; }
#pragma unroll
        for (int s = 0; s < 4; ++s)
#pragma unroll
            for (int j = 0; j < 4; ++j) v[j] += t[s][j]; }
}
__device__ __forceinline__ float ssq16(const f32x4 (&v)[4]) {
    float s = 0.f;
#pragma unroll
    for (int j = 0; j < 4; ++j) s += (v[j].x * v[j].x + v[j].y * v[j].y) + (v[j].z * v[j].z + v[j].w * v[j].w);
    return wave_sum(s);
}
__device__ __forceinline__ void prenorm_store(const f32x4 (&v)[4], float rinv, const float* g, const float* shift, const float* scale, bf16_t* orow, int lane) {
#pragma unroll
    for (int j = 0; j < 4; ++j) { const int q = lane + 64 * j; const f32x4 gg = ((const f32x4*)g)[q], sh = ((const f32x4*)shift)[q], sc = ((const f32x4*)scale)[q];
        const f32x4 h = (v[j] * rinv * gg) * (sc + 1.0f) + sh; u32x2 w; w.x = cvtpk(h.x, h.y); w.y = cvtpk(h.z, h.w); ((u32x2*)orow)[q] = w; }
}

#define XB_TMO      128
#define XB_XCNT(j)  (256  + 64 * (j))
#define XB_XSUB(j)  (1280 + 64 * (j))
#define XB_XGEN(j)  (2304 + 64 * (j))
#define XB_TOP      3328
#define XB_TOPGEN   3392
#define XCD_BAR_WORDS 3456
#define XB_SPIN_CAP (1u << 18)

__device__ __forceinline__ unsigned xb_ld(unsigned* p)              { return __hip_atomic_load(p, __ATOMIC_RELAXED, __HIP_MEMORY_SCOPE_AGENT); }
__device__ __forceinline__ unsigned xb_add(unsigned* p, unsigned v) { return __hip_atomic_fetch_add(p, v, __ATOMIC_RELAXED, __HIP_MEMORY_SCOPE_AGENT); }
__device__ __forceinline__ unsigned xb_xcc_id() { return (unsigned)__builtin_amdgcn_s_getreg((3 << 11) | 20) & 0xFu; }
#define XB_SPIN(cond, bar) do { unsigned _sp = 0; while (cond) { __builtin_amdgcn_s_sleep(1); \
    if ((++_sp & 255u) == 0u) { if (xb_ld(&(bar)[XB_TMO])) break; if (_sp > XB_SPIN_CAP) { atomicAdd(&(bar)[XB_TMO], 1u); break; } } } } while (0)

struct XcdBarrier { unsigned* bar; unsigned x; volatile LAS unsigned* st; };
__device__ __forceinline__ XcdBarrier xcd_barrier_post(unsigned* bar, volatile LAS unsigned* st, bool leader) {
    XcdBarrier b; b.bar = bar; b.x = xb_xcc_id(); b.st = st;
    if (leader) (void)xb_add(&bar[XB_XCNT(b.x)], 1u);
    return b;
}
__device__ __forceinline__ void xcd_barrier_complete(unsigned* bar, unsigned x, unsigned& nloc, unsigned& nx) {
    const unsigned G = gridDim.x * gridDim.y * gridDim.z;
    unsigned sum, cnt, mine, sp = 0u;
    for (;;) {
        sum = 0u; cnt = 0u; mine = 0u;
#pragma unroll
        for (unsigned j = 0; j < 16; ++j) { const unsigned c = xb_ld(&bar[XB_XCNT(j)]); sum += c; cnt += (c > 0u) ? 1u : 0u; mine = (j == x) ? c : mine; }
        if (sum == G) break;
        __builtin_amdgcn_s_sleep(1);
        if ((++sp & 255u) == 0u) { if (xb_ld(&bar[XB_TMO])) break; if (sp > XB_SPIN_CAP) { atomicAdd(&bar[XB_TMO], 1u); break; } }
    }
    nloc = mine > 0u ? mine : 1u; nx = cnt > 0u ? cnt : 1u;
}
__device__ __forceinline__ void xcd_barrier(const XcdBarrier& b, bool leader) {
    asm volatile("s_waitcnt vmcnt(0) lgkmcnt(0)" ::: "memory");
    __syncthreads();
    if (leader) {
        unsigned* bar = b.bar;
        __builtin_amdgcn_s_waitcnt(0);
        unsigned nloc = b.st[0], nx = b.st[1];
        if (nloc == 0u) { xcd_barrier_complete(bar, b.x, nloc, nx); b.st[0] = nloc; b.st[1] = nx; }
        const unsigned old = xb_add(&bar[XB_XSUB(b.x)], 1u);
        const unsigned gen = old / nloc;
        if (old + 1u == (gen + 1u) * nloc) {
            __builtin_amdgcn_fence(__ATOMIC_RELEASE, "agent");
            asm volatile("s_waitcnt vmcnt(0)" ::: "memory");
            const unsigned og = xb_add(&bar[XB_TOP], 1u);
            const unsigned tg = og / nx;
            if (og + 1u == (tg + 1u) * nx) xb_add(&bar[XB_TOPGEN], 1u);
            else XB_SPIN(xb_ld(&bar[XB_TOPGEN]) == tg, bar);
            __builtin_amdgcn_fence(__ATOMIC_ACQUIRE, "agent");
            xb_add(&bar[XB_XGEN(b.x)], 1u);
            asm volatile("s_waitcnt vmcnt(0)" ::: "memory");
        } else {
            XB_SPIN(xb_ld(&bar[XB_XGEN(b.x)]) == gen, bar);
            __builtin_amdgcn_fence(__ATOMIC_ACQUIRE, "agent");
            asm volatile("s_waitcnt vmcnt(0)" ::: "memory");
        }
    }
    __syncthreads();
}
#ifndef PROBE_R1_REPS
#define PROBE_R1_REPS 1
#endif
#ifndef PROBE_P1_REPS
#define PROBE_P1_REPS 1
#endif
#ifndef PROBE_P0_REPS
#define PROBE_P0_REPS 1
#endif
#ifndef PROBE_BAR_REPS
#define PROBE_BAR_REPS 1
#endif
#ifndef PROBE_GEMM_REPS
#define PROBE_GEMM_REPS 1
#endif
#ifndef PROBE_ATT_REPS
#define PROBE_ATT_REPS 1
#endif

__global__ void __launch_bounds__(512, 2) fwd_megakernel(Params p) {
    extern __shared__ __attribute__((aligned(16))) unsigned char lds_raw[];
    LAS unsigned char* lds = (LAS unsigned char*)lds_raw;
    const int wave = __builtin_amdgcn_readfirstlane(threadIdx.x >> 6);
    typedef const __attribute__((address_space(4))) Params* KP;
#define PHASE_IDS() int tid = wave * 64 + lane_id(); asm volatile("" : "+v"(tid)); int G = gridDim.x, blk = blockIdx.x; asm volatile("" : "+s"(G), "+s"(blk)); const int NGW = G * 8; const int lane = tid & 63; const int gw = blk * 8 + wave; (void)lane; (void)gw; (void)NGW; \
    KP pp = (KP)__builtin_amdgcn_kernarg_segment_ptr(); asm volatile("" : "+s"(pp)); unsigned char* ws = pp->ws; (void)ws;
#define PIN(i) (pp->in[i])
#define LOADY(m, y, ns) do { if ((m) >= NLAT) load16part<ns>(WSP(float, WS_PART), (m) - NLAT, lane, y); else load16bf(BY + (size_t)(m) * DM, lane, y); } while (0)
#define XBAR_WORDS ((unsigned*)((KP)__builtin_amdgcn_kernarg_segment_ptr())->ws)
#define XBAR_ST ((volatile LAS unsigned*)(lds + 131072 + 256))
#define GBAR() do { XcdBarrier xb_; xb_.bar = XBAR_WORDS; xb_.x = xb_xcc_id(); xb_.st = XBAR_ST; xcd_barrier(xb_, wave == 0 && lane_id() == 0); } while (0)
#define WSP(T, off) ((T*)(ws + (off)))
#define MOD WSP(float, WS_MOD)
#define BA WSP(bf16_t, WS_A)
#define BH WSP(bf16_t, WS_B)
#define BZ WSP(bf16_t, WS_Z)
#define BQ WSP(bf16_t, WS_Q)
#define BKV WSP(bf16_t, WS_KV)
#define BQN WSP(bf16_t, WS_QN)
#define BKVN WSP(bf16_t, WS_KVN)
#define BKR WSP(bf16_t, WS_KR)
#define BY WSP(bf16_t, WS_D)
#define XSC WSP(float, WS_XSC)
#define XS_ROW(m) ((m) < NLAT ? pp->out + (size_t)(m) * DM : XSC + (size_t)((m) - NLAT) * DM)
#define MOD_ROW(l, m) (MOD + ((l) * 5 + ((m) < NLAT ? (m) / SEQL : 4)) * 6144)

    for (int rp0_ = 0; rp0_ < PROBE_P0_REPS; ++rp0_) {
        PHASE_IDS();
        if (blk == 0) for (int i = tid; i < XCD_BAR_WORDS; i += 512) ((unsigned*)ws)[i] = 0u;
        if (tid < 2) ((LAS unsigned*)(lds + 131072 + 256))[tid] = 0u;
        LAS float* sil = (LAS float*)lds;
        LAS float* part = sil + 5 * 1024;
        for (int it = blk; it < 192; it += G) {
            const int l = it / 96, j0 = (it % 96) * 64;
            for (int i = tid; i < 5 * 1024; i += 512) { const int r = i >> 10, k = i & 1023; const float cv = r < 4 ? PIN(I_C)[r * 1024 + k] : PIN(I_CCTX)[k]; sil[i] = cv * sigmoidf_(cv); }
            __syncthreads();
            const int kg = tid >> 6, jc = tid & 63; const float* wm = PIN(I_WMOD) + (size_t)l * 1024 * 6144 + j0 + jc;
            float a0 = 0.f, a1 = 0.f, a2 = 0.f, a3 = 0.f, a4 = 0.f;
#pragma unroll 8
            for (int k = kg; k < 1024; k += 8) { const float w = wm[(size_t)k * 6144]; a0 += sil[k] * w; a1 += sil[1024 + k] * w; a2 += sil[2048 + k] * w; a3 += sil[3072 + k] * w; a4 += sil[4096 + k] * w; }
            part[(kg * 5 + 0) * 64 + jc] = a0; part[(kg * 5 + 1) * 64 + jc] = a1; part[(kg * 5 + 2) * 64 + jc] = a2; part[(kg * 5 + 3) * 64 + jc] = a3; part[(kg * 5 + 4) * 64 + jc] = a4;
            __syncthreads();
            if (tid < 320) { const int r = tid >> 6; float s = 0.f;
#pragma unroll
                for (int q = 0; q < 8; ++q) s += part[(q * 5 + r) * 64 + jc];
                MOD[(l * 5 + r) * 6144 + j0 + jc] = s + PIN(I_BMOD)[l * 6144 + j0 + jc]; }
            __syncthreads();
        }
        LAS float* scr = (LAS float*)(lds + 32768 + wave * 8704);
        constexpr int T_IN = 16 * 53, T_Q = 4 * 24, T_KV = 2 * 32, T_O = 16 * 32, T_UP = 16 * 128, T_DN = 64 * 32, T_L = T_IN + T_Q + T_KV + T_O + T_UP + T_DN;
        for (int it = gw; it < 2 * T_L; it += NGW) {
            const int l = it / T_L; int r = it % T_L; bf16_t* wl = (bf16_t*)(ws + WS_W + (size_t)l * W_LAYER);
            if (r < T_IN) { transpose_item(PIN(I_WIN) + (size_t)l * 1024 * INW, 1024, INW, (bf16_t*)((unsigned char*)wl + W_IN), scr, r, lane); continue; } r -= T_IN;
            if (r < T_Q) { transpose_item(PIN(I_WQB) + (size_t)l * 256 * 768, 256, 768, (bf16_t*)((unsigned char*)wl + W_Q), scr, r, lane); continue; } r -= T_Q;
            if (r < T_KV) { transpose_item(PIN(I_WKVB) + (size_t)l * 128 * 1024, 128, 1024, (bf16_t*)((unsigned char*)wl + W_KV), scr, r, lane); continue; } r -= T_KV;
            if (r < T_O) { transpose_item(PIN(I_WO) + (size_t)l * 1024 * 1024, 1024, 1024, (bf16_t*)((unsigned char*)wl + W_O), scr, r, lane); continue; } r -= T_O;
            if (r < T_UP) { transpose_item(PIN(I_WUP) + (size_t)l * 1024 * DFF, 1024, DFF, (bf16_t*)((unsigned char*)wl + W_UP), scr, r, lane); continue; } r -= T_UP;
            transpose_item(PIN(I_WDN) + (size_t)l * DFF * 1024, DFF, 1024, (bf16_t*)((unsigned char*)wl + W_DN), scr, r, lane);
        }
        for (int i = blk * 512 + tid; i < 2 * 96 * 128; i += G * 512) { const int l = i / (96 * 128), q = i % (96 * 128);
            ((u32x4*)(ws + WS_W + (size_t)l * W_LAYER + W_IN + (size_t)INW * 2048))[q] = (u32x4){0u, 0u, 0u, 0u}; }
    }
    cg::this_grid().sync();
    (void)xcd_barrier_post(XBAR_WORDS, XBAR_ST, wave == 0 && lane_id() == 0);
    { PHASE_IDS();
#define P1_SRC(m) ((m) < NLAT ? PIN(I_X) + (size_t)(m) * DM : PIN(I_CTX) + (size_t)((m) - NLAT) * DM)
#define P1_ROW(m, v) do { const float* mod = MOD_ROW(0, m); const float rinv = rsqrtf(ssq16(v) * (1.f / DM) + EPSN); prenorm_store(v, rinv, PIN(I_GPREMIX), mod, mod + 1024, BA + (size_t)(m) * DM, lane); } while (0)
    if (NGW == 2048) {
    for (int m0 = gw; m0 < MTOT; m0 += 4 * NGW) { f32x4 vb[4][4]; const float* mod = MOD_ROW(0, m0);
#pragma unroll
        for (int i = 0; i < 4; ++i) { const int mi = m0 + i * NGW; load16(P1_SRC(mi < MTOT ? mi : m0), lane, vb[i]); }
        f32x4 gv[4], sh[4], sc[4];
#pragma unroll
        for (int j = 0; j < 4; ++j) { gv[j] = ((const f32x4*)PIN(I_GPREMIX))[lane + 64 * j]; sh[j] = ((const f32x4*)mod)[lane + 64 * j]; sc[j] = ((const f32x4*)(mod + 1024))[lane + 64 * j] + 1.0f; }
#pragma unroll
        for (int i = 0; i < 4; ++i) { const int mi = m0 + i * NGW; if (mi < MTOT) { const float rinv = rsqrtf(ssq16(vb[i]) * (1.f / DM) + EPSN); bf16_t* orow = BA + (size_t)mi * DM;
#pragma unroll
            for (int j = 0; j < 4; ++j) { const f32x4 h = (vb[i][j] * rinv * gv[j]) * sc[j] + sh[j]; u32x2 w; w.x = cvtpk(h.x, h.y); w.y = cvtpk(h.z, h.w); ((u32x2*)orow)[lane + 64 * j] = w; } } } }
    } else
    for (int m0 = gw; m0 < MTOT; m0 += 4 * NGW) { f32x4 vb[4][4];
#pragma unroll
        for (int i = 0; i < 4; ++i) { const int mi = m0 + i * NGW; load16(P1_SRC(mi < MTOT ? mi : m0), lane, vb[i]); }
#pragma unroll
        for (int i = 0; i < 4; ++i) { const int mi = m0 + i * NGW; if (mi < MTOT) P1_ROW(mi, vb[i]); } } }
    GBAR();

    for (int l = 0; l < 2; ++l) {
        const bool last = (l == 1);
#define WL (ws + WS_W + (size_t)l * W_LAYER)
        const int Mact = last ? NLAT : MTOT;
        for (int rep_ = 0; rep_ < PROBE_GEMM_REPS; ++rep_) { PHASE_IDS(); pg8::Gemm g{BA, (const bf16_t*)(WL + W_IN), MTOT, ZW, 1024, 1024}; pg8::StaticOrder S; S.init(MTOT, ZW, G, blk); pg8::EpiBf16<0> E{BZ, ZW};
          pg8::gemm_phase<pg8::EpiBf16<0>, pg8::StaticOrder, true, true>(lds, g, S, E, wave); }
        GBAR();
        for (int rr1_ = 0; rr1_ < PROBE_R1_REPS; ++rr1_) {
            PHASE_IDS();
            const float* gq = PIN(I_GQ) + l * 256; const float* gkv = PIN(I_GKV) + l * 128; const float* gbr = PIN(I_GBR) + l * 1024;
            const float* cw = PIN(I_CDWW) + l * 31 * 256; const float* cb = PIN(I_CDWB) + l * 256; const float* lng = PIN(I_CLNG) + l * 256; const float* lnb = PIN(I_CLNB) + l * 256;
            const float* sw = PIN(I_SDWW) + l * 3 * 256;
            LAS float* U = (LAS float*)lds;
            LAS float* WL_ = (LAS float*)(lds + 96256);
            for (int i = tid; i < 31 * 64; i += 512) *(LAS f32x4*)(WL_ + 4 * i) = ((const f32x4*)cw)[i];
            __syncthreads();
            const int lane_o = lane, tid_o = tid;
            for (int ti = blk; ti < 544; ti += G) {
                int tid = tid_o; asm volatile("" : "+v"(tid)); const int lane = tid & 63;
                int seq_base, seq_len, t0; bool is_lat;
                if (ti < 512) { seq_base = (ti >> 7) * SEQL; seq_len = SEQL; t0 = (ti & 127) * 64; is_lat = true; }
                else { const int tc = ti - 512; seq_base = NLAT + (tc >> 3) * CTXL; seq_len = CTXL; t0 = (tc & 7) * 32; is_lat = false; }
                const int TT = is_lat ? 64 : 32; const bool dead = last && !is_lat;
                const int urows = dead ? 0 : (TT + 30) * 32; const bool wact = wave * 8 < TT;
                if (!dead) { u32x4 ua[6], ug[6];
#pragma unroll
                  for (int i = 0; i < 6; ++i) { const int it = tid + 512 * i, rr = it >> 5, c8 = it & 31, t = t0 - 15 + rr; const bool ok = it < urows && t >= 0 && t < seq_len;
                      const bf16_t* zr = BZ + (size_t)(seq_base + (ok ? t : t0)) * ZW; ua[i] = *(const u32x4*)(zr + 416 + 8 * c8); ug[i] = *(const u32x4*)(zr + 672 + 8 * c8); if (!ok) ua[i] = (u32x4){0u, 0u, 0u, 0u}; }
#pragma unroll
                  for (int i = 0; i < 6; ++i) { const int it = tid + 512 * i, rr = it >> 5, c8 = it & 31; const u32x4 a = ua[i], gg = ug[i];
                      if (it < urows) {
                        const f32x4 u0 = {bflo(a.x) * sigmoidf_(bflo(gg.x)), bfhi(a.x) * sigmoidf_(bfhi(gg.x)), bflo(a.y) * sigmoidf_(bflo(gg.y)), bfhi(a.y) * sigmoidf_(bfhi(gg.y))};
                        const f32x4 u1 = {bflo(a.z) * sigmoidf_(bflo(gg.z)), bfhi(a.z) * sigmoidf_(bfhi(gg.z)), bflo(a.w) * sigmoidf_(bflo(gg.w)), bfhi(a.w) * sigmoidf_(bfhi(gg.w))};
                        *(LAS f32x4*)(U + rr * 256 + 8 * c8) = u0; *(LAS f32x4*)(U + rr * 256 + 8 * c8 + 4) = u1; } } }
                if (wact) { const int tw = t0 + wave * 8; const size_t mw = (size_t)seq_base + tw; const bf16_t* zw = BZ + mw * ZW;
                  u32x2 zq[8], bgt[8], cgt[10], hht[10]; unsigned kvv[8]; unsigned short krv[8];
#pragma unroll
                  for (int k8 = 0; k8 < 8; ++k8) { const bf16_t* zr = zw + (size_t)k8 * ZW; zq[k8] = *(const u32x2*)(zr + 4 * lane); kvv[k8] = *(const unsigned*)(zr + 256 + 2 * lane); krv[k8] = zr[384 + (lane & 31)];
                      bgt[k8] = *(const u32x2*)(zr + 928 + 4 * lane); }
#pragma unroll
                  for (int j = 0; j < 10; ++j) { const int tt = tw - 1 + j; const bool ok = tt >= 0 && tt < seq_len; const bf16_t* z2 = BZ + (size_t)(seq_base + (ok ? tt : tw)) * ZW;
                      cgt[j] = *(const u32x2*)(z2 + 1184 + 4 * lane); hht[j] = *(const u32x2*)(z2 + 1440 + 4 * lane); if (!ok) { cgt[j] = (u32x2){0u, 0u}; } }
                  const f32x4 gqv = ((const f32x4*)gq)[lane]; const float gk0 = gkv[2 * lane], gk1 = gkv[2 * lane + 1]; const f32x4 gsc = ((const f32x4*)(gbr + 768))[lane];
                  const f32x4 sw0 = ((const f32x4*)sw)[lane], sw1 = ((const f32x4*)(sw + 256))[lane], sw2 = ((const f32x4*)(sw + 512))[lane];
                  f32x4 pr[10];
#pragma unroll
                  for (int j = 0; j < 10; ++j) pr[j] = (f32x4){bflo(cgt[j].x) * bflo(hht[j].x), bfhi(cgt[j].x) * bfhi(hht[j].x), bflo(cgt[j].y) * bflo(hht[j].y), bfhi(cgt[j].y) * bfhi(hht[j].y)};
#pragma unroll
                  for (int k8 = 0; k8 < 8; ++k8) { const int t = tw + k8; const size_t m = mw + k8;
                    { const u32x2 w = zq[k8]; const f32x4 v = {bflo(w.x), bfhi(w.x), bflo(w.y), bfhi(w.y)};
                      const float ri = rsqrtf(wave_sum((v.x * v.x + v.y * v.y) + (v.z * v.z + v.w * v.w)) * (1.f / 256.f) + EPSN); const f32x4 o = v * ri * gqv;
                      u32x2 ow; ow.x = cvtpk(o.x, o.y); ow.y = cvtpk(o.z, o.w); *(u32x2*)(BQN + m * 256 + 4 * lane) = ow; }
                    { const unsigned w = kvv[k8]; const float v0 = bflo(w), v1 = bfhi(w);
                      const float ri = rsqrtf(wave_sum(v0 * v0 + v1 * v1) * (1.f / 128.f) + EPSN); *(unsigned*)(BKVN + m * 128 + 2 * lane) = cvtpk(v0 * ri * gk0, v1 * ri * gk1); }
                    { const int e = lane & 31; const float v = bf2f(krv[k8]); const float prn = swz_xor<8>(v); float o = v;
                      if (is_lat) { const int a = e >> 4, i = e & 15; const float pos = (float)(a == 0 ? (t >> 6) : (t & 63)); const float ang = pos * rope_inv(i & 7), c = __cosf(ang), s = __sinf(ang);
                          o = (i < 8) ? (v * c - prn * s) : (v * c + prn * s); }
                      if (lane < 32) BKR[m * 32 + e] = f2bf(o); }
                    { const f32x4 acc = pr[k8] * sw0 + pr[k8 + 1] * sw1 + pr[k8 + 2] * sw2; const u32x2 bg = bgt[k8];
                      const f32x4 s = {bflo(bg.x) * acc.x, bfhi(bg.x) * acc.y, bflo(bg.y) * acc.z, bfhi(bg.y) * acc.w};
                      const float ri = rsqrtf(wave_sum((s.x * s.x + s.y * s.y) + (s.z * s.z + s.w * s.w)) * (1.f / 256.f) + EPSN); const f32x4 o = s * ri * gsc;
                      u32x2 ow; ow.x = cvtpk(o.x, o.y); ow.y = cvtpk(o.z, o.w); *(u32x2*)(BA + m * DM + 768 + 4 * lane) = ow; }
                  }
                }
                __syncthreads();
                if (wact && !dead) { int lane = lane_o; asm volatile("" : "+v"(lane)); f32x4 wv[31];
#pragma unroll
                  for (int j = 0; j < 31; ++j) wv[j] = *(const LAS f32x4*)(WL_ + j * 256 + 4 * lane);
                  const f32x4 bias = ((const f32x4*)cb)[lane]; f32x4 acc[8];
#pragma unroll
                  for (int k = 0; k < 8; ++k) acc[k] = bias;
                  const LAS float* Ub = U + (wave * 8) * 256 + 4 * lane;
#pragma unroll
                  for (int i = 0; i < 38; ++i) { const f32x4 u = *(const LAS f32x4*)(Ub + i * 256);
#pragma unroll
                      for (int k = 0; k < 8; ++k) { const int j = i - k; if (j >= 0 && j < 31) acc[k] += u * wv[j]; } }
                  const f32x4 lg = ((const f32x4*)lng)[lane], lb = ((const f32x4*)lnb)[lane], gb = ((const f32x4*)(gbr + 512))[lane];
#pragma unroll
                  for (int k = 0; k < 8; ++k) { const f32x4 a = acc[k]; const float mean = wave_sum((a.x + a.y) + (a.z + a.w)) * (1.f / 256.f); const f32x4 d = a - mean;
                      const float rstd = rsqrtf(wave_sum((d.x * d.x + d.y * d.y) + (d.z * d.z + d.w * d.w)) * (1.f / 256.f) + EPSN); f32x4 y = d * rstd * lg + lb;
                      y = (f32x4){y.x * sigmoidf_(y.x), y.y * sigmoidf_(y.y), y.z * sigmoidf_(y.z), y.w * sigmoidf_(y.w)};
                      const float ri = rsqrtf(wave_sum((y.x * y.x + y.y * y.y) + (y.z * y.z + y.w * y.w)) * (1.f / 256.f) + EPSN); const f32x4 o = y * ri * gb;
                      u32x2 ow; ow.x = cvtpk(o.x, o.y); ow.y = cvtpk(o.z, o.w); *(u32x2*)(BA + ((size_t)seq_base + t0 + wave * 8 + k) * DM + 512 + 4 * lane) = ow; } }
                __syncthreads();
            }
        }
        GBAR();
        for (int rep_ = 0; rep_ < PROBE_GEMM_REPS; ++rep_) { PHASE_IDS(); pg8::Gemm g{BQN, (const bf16_t*)(WL + W_Q), MTOT, 768, 256, 256}; pg8::StaticOrder S; S.init(MTOT, 768, G, blk); pg8::EpiBf16<0> E{BQ, 768};
          pg8::gemm_phase<pg8::EpiBf16<0>, pg8::StaticOrder, true, true>(lds, g, S, E, wave); }
        for (int rep_ = 0; rep_ < PROBE_GEMM_REPS; ++rep_) { PHASE_IDS(); pg8::Gemm g{BKVN, (const bf16_t*)(WL + W_KV), MTOT, 1024, 128, 128}; pg8::StaticOrder S; S.init(MTOT, 1024, G, blk); pg8::EpiBf16<0> E{BKV, 1024};
          pg8::gemm_phase<pg8::EpiBf16<0>, pg8::StaticOrder, true, true>(lds, g, S, E, wave); }
        GBAR();
        {
            PHASE_IDS();
            const int nunits = last ? 1024 : 1056;
            for (int rep_ = 0; rep_ < PROBE_ATT_REPS; ++rep_)
            for (int u = blk; u < nunits; u += G) {
                if (u < 1024) { const int bh = (u & 7) + 8 * (u >> 8), qb = (u >> 3) & 31, b = bh >> 3, h = bh & 7; const int q0 = b * SEQL + qb * 256;
                    att::attn_unit(BQ + (size_t)q0 * 768 + h * 96, true, qb * 256, BKV + h * 128, BKR, NLAT + b * CTXL, b * SEQL, 132, BA + (size_t)q0 * DM + h * 64, lds, wave); }
                else { const int uc = u - 1024, b = uc >> 3, h = uc & 7; const int q0 = NLAT + b * CTXL;
                    att::attn_unit(BQ + (size_t)q0 * 768 + h * 96, false, 0, BKV + h * 128, BKR, q0, 0, 4, BA + (size_t)q0 * DM + h * 64, lds, wave); }
            }
        }
        GBAR();
        { PHASE_IDS(); const float* gbr = PIN(I_GBR) + l * 1024; const f32x4 g0 = ((const f32x4*)gbr)[2 * lane], g1 = ((const f32x4*)gbr)[2 * lane + 1];
          for (int m0 = gw; m0 < Mact; m0 += 4 * NGW) { u32x4 w[4];
#pragma unroll
              for (int i = 0; i < 4; ++i) { const int m = m0 + i * NGW; w[i] = ((const u32x4*)(BA + (size_t)(m < Mact ? m : m0) * DM))[lane]; }
#pragma unroll
              for (int i = 0; i < 4; ++i) { const int m = m0 + i * NGW; if (m < Mact) {
                  const float v[8] = {bflo(w[i].x), bfhi(w[i].x), bflo(w[i].y), bfhi(w[i].y), bflo(w[i].z), bfhi(w[i].z), bflo(w[i].w), bfhi(w[i].w)}; float s = 0.f;
#pragma unroll
                  for (int q = 0; q < 8; ++q) s += v[q] * v[q];
                  const float ri = rsqrtf(wave_sum(s) * (1.f / 512.f) + EPSN);
                  u32x4 o; o.x = cvtpk(v[0] * ri * g0.x, v[1] * ri * g0.y); o.y = cvtpk(v[2] * ri * g0.z, v[3] * ri * g0.w); o.z = cvtpk(v[4] * ri * g1.x, v[5] * ri * g1.y); o.w = cvtpk(v[6] * ri * g1.z, v[7] * ri * g1.w);
                  ((u32x4*)(BA + (size_t)m * DM))[lane] = o; } } } }
        GBAR();
        { PHASE_IDS(); pg8::Gemm g{BA, (const bf16_t*)(WL + W_O), NLAT, 1024, 1024, 1024}; pg8::StaticOrder S; S.init(NLAT, 1024, G, blk); pg8::EpiBf16<0> E{BY, 1024};
          pg8::gemm_phase<pg8::EpiBf16<0>, pg8::StaticOrder, true, true>(lds, g, S, E, wave); }
        if (!last) { PHASE_IDS(); pg8::Gemm g{BA, (const bf16_t*)(WL + W_O), MTOT, 1024, 256, 1024}; pg8::SplitOrder S; S.init(4, 4, 4, 128, G, blk); pg8::EpiF32Part E{WSP(float, WS_PART), 1024, 128, (size_t)1024 * 1024};
          pg8::gemm_phase<pg8::EpiF32Part, pg8::SplitOrder, true, true>(lds, g, S, E, wave); }
        GBAR();
        { PHASE_IDS(); const float* gp = PIN(I_GPOSTMIX) + l * DM; const float* gm = PIN(I_GPREMLP) + l * DM;
#define R3_SRC(m) ((l == 0) ? ((m) < NLAT ? PIN(I_X) + (size_t)(m) * DM : PIN(I_CTX) + (size_t)((m) - NLAT) * DM) : (const float*)XS_ROW(m))
#define R3_ROW(m, y, x) do { const float* mod = MOD_ROW(l, m); float* dst = XS_ROW(m); const float ry = rsqrtf(ssq16(y) * (1.f / DM) + EPSN); \
            _Pragma("unroll") for (int j = 0; j < 4; ++j) { const int q = lane + 64 * j; x[j] = x[j] + ((const f32x4*)(mod + 2048))[q] * (y[j] * ry * ((const f32x4*)gp)[q]); __builtin_nontemporal_store(x[j], (f32x4*)dst + q); } \
            const float r1 = rsqrtf(ssq16(x) * (1.f / DM) + EPSN); prenorm_store(x, r1, gm, mod + 3072, mod + 4096, BA + (size_t)(m) * DM, lane); } while (0)
        if (NGW == 2048) {
        for (int m0 = gw; m0 < Mact; m0 += 4 * NGW) { f32x4 yb[4][4], xb[4][4]; const float* mod = MOD_ROW(l, m0);
#pragma unroll
            for (int i = 0; i < 4; ++i) { const int mi = m0 + i * NGW, mc = mi < Mact ? mi : m0; LOADY(mc, yb[i], 4); load16(R3_SRC(mc), lane, xb[i]); }
            float r1[4];
            { f32x4 gt[4], gv[4];
#pragma unroll
              for (int j = 0; j < 4; ++j) { gt[j] = ((const f32x4*)(mod + 2048))[lane + 64 * j]; gv[j] = ((const f32x4*)gp)[lane + 64 * j]; }
#pragma unroll
              for (int i = 0; i < 4; ++i) { const int mi = m0 + i * NGW; r1[i] = 0.f; if (mi < Mact) { float* dst = XS_ROW(mi); const float ry = rsqrtf(ssq16(yb[i]) * (1.f / DM) + EPSN);
#pragma unroll
                  for (int j = 0; j < 4; ++j) { xb[i][j] = xb[i][j] + gt[j] * (yb[i][j] * ry * gv[j]); __builtin_nontemporal_store(xb[i][j], (f32x4*)dst + lane + 64 * j); }
                  r1[i] = rsqrtf(ssq16(xb[i]) * (1.f / DM) + EPSN); } } }
            { f32x4 gv[4], sh[4], sc[4];
#pragma unroll
              for (int j = 0; j < 4; ++j) { gv[j] = ((const f32x4*)gm)[lane + 64 * j]; sh[j] = ((const f32x4*)(mod + 3072))[lane + 64 * j]; sc[j] = ((const f32x4*)(mod + 4096))[lane + 64 * j] + 1.0f; }
#pragma unroll
              for (int i = 0; i < 4; ++i) { const int mi = m0 + i * NGW; if (mi < Mact) { bf16_t* orow = BA + (size_t)mi * DM;
#pragma unroll
                  for (int j = 0; j < 4; ++j) { const f32x4 h = (xb[i][j] * r1[i] * gv[j]) * sc[j] + sh[j]; u32x2 w; w.x = cvtpk(h.x, h.y); w.y = cvtpk(h.z, h.w); ((u32x2*)orow)[lane + 64 * j] = w; } } } } }
        } else
        for (int m0 = gw; m0 < Mact; m0 += 4 * NGW) { f32x4 yb[4][4], xb[4][4];
#pragma unroll
            for (int i = 0; i < 4; ++i) { const int mi = m0 + i * NGW, mc = mi < Mact ? mi : m0; LOADY(mc, yb[i], 4); load16(R3_SRC(mc), lane, xb[i]); }
#pragma unroll
            for (int i = 0; i < 4; ++i) { const int mi = m0 + i * NGW; if (mi < Mact) R3_ROW(mi, yb[i], xb[i]); } } }
        GBAR();
        for (int rep_ = 0; rep_ < PROBE_GEMM_REPS; ++rep_) { PHASE_IDS(); pg8::Gemm g{BA, (const bf16_t*)(WL + W_UP), Mact, DFF, 1024, 1024}; pg8::StaticOrder S; S.init(Mact, DFF, G, blk); pg8::EpiBf16<2> E{BH, DFF};
          pg8::gemm_phase<pg8::EpiBf16<2>, pg8::StaticOrder, true, true>(lds, g, S, E, wave); }
        GBAR();
        { PHASE_IDS(); pg8::Gemm g{BH, (const bf16_t*)(WL + W_DN), NLAT, 1024, DFF, DFF}; pg8::StaticOrder S; S.init(NLAT, 1024, G, blk); S.rev = true; pg8::EpiBf16<0> E{BY, 1024};
          pg8::gemm_phase<pg8::EpiBf16<0>, pg8::StaticOrder, true, true>(lds, g, S, E, wave); }
        if (!last) { PHASE_IDS(); pg8::Gemm g{BH, (const bf16_t*)(WL + W_DN), MTOT, 1024, 256, DFF}; pg8::SplitOrder S; S.init(4, 4, 16, 128, G, blk); pg8::EpiF32Part E{WSP(float, WS_PART), 1024, 128, (size_t)1024 * 1024};
          pg8::gemm_phase<pg8::EpiF32Part, pg8::SplitOrder, true, true>(lds, g, S, E, wave); }
        GBAR();
        { PHASE_IDS(); const float* gp = PIN(I_GPOSTMLP) + l * DM; const float* gn = PIN(I_GPREMIX) + (last ? 0 : (l + 1) * DM);
#define R4_ROW(m, y, x) do { const float* mod = MOD_ROW(l, m); float* xr = XS_ROW(m); const float ry = rsqrtf(ssq16(y) * (1.f / DM) + EPSN); \
            _Pragma("unroll") for (int j = 0; j < 4; ++j) { const int q = lane + 64 * j; x[j] = x[j] + ((const f32x4*)(mod + 5120))[q] * (y[j] * ry * ((const f32x4*)gp)[q]); __builtin_nontemporal_store(x[j], (f32x4*)xr + q); } \
            if (!last) { const float* mod1 = MOD_ROW(l + 1, m); const float r1 = rsqrtf(ssq16(x) * (1.f / DM) + EPSN); prenorm_store(x, r1, gn, mod1, mod1 + 1024, BA + (size_t)(m) * DM, lane); } } while (0)
        if (NGW == 2048) {
        for (int m0 = gw; m0 < Mact; m0 += 4 * NGW) { f32x4 yb[4][4], xb[4][4]; const float* mod = MOD_ROW(l, m0);
#pragma unroll
            for (int i = 0; i < 4; ++i) { const int mi = m0 + i * NGW, mc = mi < Mact ? mi : m0; LOADY(mc, yb[i], 16); load16(XS_ROW(mc), lane, xb[i]); }
            float r1[4];
            { f32x4 gt[4], gv[4];
#pragma unroll
              for (int j = 0; j < 4; ++j) { gt[j] = ((const f32x4*)(mod + 5120))[lane + 64 * j]; gv[j] = ((const f32x4*)gp)[lane + 64 * j]; }
#pragma unroll
              for (int i = 0; i < 4; ++i) { const int mi = m0 + i * NGW; r1[i] = 0.f; if (mi < Mact) { float* xr = XS_ROW(mi); const float ry = rsqrtf(ssq16(yb[i]) * (1.f / DM) + EPSN);
#pragma unroll
                  for (int j = 0; j < 4; ++j) { xb[i][j] = xb[i][j] + gt[j] * (yb[i][j] * ry * gv[j]); __builtin_nontemporal_store(xb[i][j], (f32x4*)xr + lane + 64 * j); }
                  if (!last) r1[i] = rsqrtf(ssq16(xb[i]) * (1.f / DM) + EPSN); } } }
            if (!last) { const float* mod1 = MOD_ROW(l + 1, m0); f32x4 gv[4], sh[4], sc[4];
#pragma unroll
              for (int j = 0; j < 4; ++j) { gv[j] = ((const f32x4*)gn)[lane + 64 * j]; sh[j] = ((const f32x4*)mod1)[lane + 64 * j]; sc[j] = ((const f32x4*)(mod1 + 1024))[lane + 64 * j] + 1.0f; }
#pragma unroll
              for (int i = 0; i < 4; ++i) { const int mi = m0 + i * NGW; if (mi < Mact) { bf16_t* orow = BA + (size_t)mi * DM;
#pragma unroll
                  for (int j = 0; j < 4; ++j) { const f32x4 h = (xb[i][j] * r1[i] * gv[j]) * sc[j] + sh[j]; u32x2 w; w.x = cvtpk(h.x, h.y); w.y = cvtpk(h.z, h.w); ((u32x2*)orow)[lane + 64 * j] = w; } } } } }
        } else
        for (int m0 = gw; m0 < Mact; m0 += 4 * NGW) { f32x4 yb[4][4], xb[4][4];
#pragma unroll
            for (int i = 0; i < 4; ++i) { const int mi = m0 + i * NGW, mc = mi < Mact ? mi : m0; LOADY(mc, yb[i], 16); load16(XS_ROW(mc), lane, xb[i]); }
#pragma unroll
            for (int i = 0; i < 4; ++i) { const int mi = m0 + i * NGW; if (mi < Mact) R4_ROW(mi, yb[i], xb[i]); } } }
        if (!last) GBAR();
    }
}

extern "C" void kernel_launch(void* const* d_in, const int* in_sizes, int n_in, void* d_out, int out_size, void* d_ws, size_t ws_size, hipStream_t stream) {
    static int grid_blocks = 0;
    if (grid_blocks == 0) {
        if (n_in != 24 || out_size != NLAT * DM || ws_size < WS_END) { fprintf(stderr, "kernel_launch: unexpected shapes n_in %d out %d ws %zu\n", n_in, out_size, ws_size); grid_blocks = -1; return; }
        int dev = 0, cus = 0, per_cu = 0;
        hipGetDevice(&dev); hipDeviceGetAttribute(&cus, hipDeviceAttributeMultiprocessorCount, dev);
        if (hipFuncSetAttribute((const void*)fwd_megakernel, hipFuncAttributeMaxDynamicSharedMemorySize, LDS_BYTES) != hipSuccess) { fprintf(stderr, "kernel_launch: hipFuncSetAttribute failed\n"); grid_blocks = -1; return; }
        if (hipOccupancyMaxActiveBlocksPerMultiprocessor(&per_cu, (const void*)fwd_megakernel, 512, LDS_BYTES) != hipSuccess || per_cu < 1) { fprintf(stderr, "kernel_launch: occupancy query says %d\n", per_cu); per_cu = 1; (void)hipGetLastError(); }
        grid_blocks = cus * per_cu;
    }
    if (grid_blocks < 0) return;
    Params p{};
    for (int i = 0; i < 24; ++i) p.in[i] = (const float*)d_in[i];
    p.out = (float*)d_out; p.ws = (unsigned char*)d_ws;
    void* args[] = {&p};
    hipError_t e = hipLaunchCooperativeKernel((const void*)fwd_megakernel, dim3(grid_blocks), dim3(512), args, LDS_BYTES, stream);
    if (e != hipSuccess) fprintf(stderr, "cooperative launch failed: %s (grid %d)\n", hipGetErrorString(e), grid_blocks);
}
```

```cpp
#include <hip/hip_runtime.h>
#include <hip/hip_cooperative_groups.h>
#include <cstdio>
#include <cstdint>
namespace cg = cooperative_groups;
namespace pg8 {
#define PG8_LAS __attribute__((address_space(3)))
typedef unsigned short bf16_t;
typedef short bf16x8 __attribute__((ext_vector_type(8)));
typedef float f32x4 __attribute__((ext_vector_type(4)));
typedef unsigned u32x4 __attribute__((ext_vector_type(4)));
constexpr int BM = 256, BK = 64, HALF = 128, HTB = HALF * BK * 2  , STAGE_BYTES = 8 * HTB, NXCD = 8, WGM = 8;

__host__ __device__ __forceinline__ int lds_byte(int r, int c) { const int st = (r >> 4) * 2 + (c >> 5), rr = r & 15, cc = c & 31, ob = rr * 64 + cc * 2; return st * 1024 + (ob ^ (((ob >> 9) & 1) << 5)); }
__host__ __device__ __forceinline__ void stage_rc(int b, int& R, int& C) { const int st = b / 1024, sb = b % 1024, swz = sb ^ (((sb >> 9) & 1) << 5); R = (st >> 1) * 16 + swz / 64; C = (st & 1) * 32 + (swz % 64) / 2; }
__host__ __device__ __forceinline__ int perm32(int rho) { const int n = rho >> 4, i = rho & 15; return 8 * (i >> 2) + 4 * n + (i & 3); }

struct Unit { int pm, pn, kq; };
struct Gemm { const bf16_t* A; const bf16_t* Bt; int M, N, K, ld; };

struct StaticOrder {
    int nM, nN, nwg, G, c; bool rev = false;
    __host__ __device__ void init(int M, int N, int G_, int c_) { nM = M / BM; nN = N / BM; nwg = nM * nN; G = G_; c = c_; }
    __host__ __device__ bool next(int i, Unit& u) const {
        const long L = (long)i * G + c; if (L >= nwg) return false;
        int wgid = (int)L; { const int q = nwg / NXCD, r = nwg % NXCD, xcd = wgid % NXCD, off = wgid / NXCD; wgid = (xcd < r ? xcd * (q + 1) : r * (q + 1) + (xcd - r) * q) + off; }
        const int nig = WGM * nN, gid = wgid / nig, fm = gid * WGM, gsz = (nM - fm) < WGM ? (nM - fm) : WGM;
        u.pm = fm + ((wgid % nig) % gsz); u.pn = (wgid % nig) / gsz; u.kq = 0; if (rev) u.pm = nM - 1 - u.pm; return true;
    }
    __device__ __forceinline__ void a_ready(const Unit&) const {}
    __device__ __forceinline__ void done(const Unit&) const {}
};
struct SplitOrder {
    int nN, nsplit, mt0, total, G, c;
    __host__ __device__ void init(int nMt, int nN_, int nsplit_, int mt0_, int G_, int c_) { nN = nN_; nsplit = nsplit_; mt0 = mt0_; total = nMt * nN_ * nsplit_; G = G_; c = c_; }
    __host__ __device__ bool next(int i, Unit& u) const { const int L = i * G + c; if (L >= total) return false; u.kq = L % nsplit; const int t = L / nsplit; u.pn = t % nN; u.pm = mt0 + t / nN; return true; }
    __device__ __forceinline__ void a_ready(const Unit&) const {}
    __device__ __forceinline__ void done(const Unit&) const {}
};

__device__ __forceinline__ unsigned cvt_pk_bf16(float lo, float hi) { unsigned r; asm volatile("v_cvt_pk_bf16_f32 %0, %1, %2" : "=v"(r) : "v"(lo), "v"(hi)); return r; }
typedef float f32x2 __attribute__((ext_vector_type(2)));
template <int ACT> struct EpiBf16 {
    static constexpr bool PERM = true, AFTER_DRAIN = false;
    bf16_t* O; int ldc;
    __device__ __forceinline__ void operator()(const f32x4 (&acc)[2][2][4][2], const Unit& u, int wr, int wc, int fr, int fq) const {
        const int row0 = u.pm * BM + wr * 64 + fr; const int col0 = u.pn * BM + wc * 32 + 8 * fq;
#pragma unroll
        for (int ai = 0; ai < 2; ++ai)
#pragma unroll
            for (int m = 0; m < 4; ++m) { bf16_t* rowp = O + (size_t)(row0 + ai * HALF + m * 16) * ldc + col0;
#pragma unroll
                for (int bj = 0; bj < 2; ++bj) { f32x4 v0 = acc[ai][bj][m][0], v1 = acc[ai][bj][m][1];
                    if (ACT == 2) {
#pragma unroll
                        for (int e = 0; e < 4; ++e) { float a = fmaxf(v0[e], 0.f), b = fmaxf(v1[e], 0.f); v0[e] = a * a; v1[e] = b * b; } }
                    u32x4 w; w.x = cvt_pk_bf16(v0[0], v0[1]); w.y = cvt_pk_bf16(v0[2], v0[3]); w.z = cvt_pk_bf16(v1[0], v1[1]); w.w = cvt_pk_bf16(v1[2], v1[3]);
                    *(u32x4*)(rowp + bj * HALF) = w; } }
    }
};
struct EpiF32Part {
    static constexpr bool PERM = true, AFTER_DRAIN = false;
    float* P; int ldc; int mt0; size_t slice;
    __device__ __forceinline__ void operator()(const f32x4 (&acc)[2][2][4][2], const Unit& u, int wr, int wc, int fr, int fq) const {
        const int row0 = (u.pm - mt0) * BM + wr * 64 + fr; const int col0 = u.pn * BM + wc * 32 + 8 * fq; float* base = P + (size_t)u.kq * slice;
#pragma unroll
        for (int ai = 0; ai < 2; ++ai)
#pragma unroll
            for (int m = 0; m < 4; ++m) { float* rowp = base + (size_t)(row0 + ai * HALF + m * 16) * ldc + col0;
#pragma unroll
                for (int bj = 0; bj < 2; ++bj) { *(f32x4*)(rowp + bj * HALF) = acc[ai][bj][m][0]; *(f32x4*)(rowp + bj * HALF + 4) = acc[ai][bj][m][1]; } }
    }
};
template <class Epi, class Sched, bool ALIGN_EPI = false, bool SP2 = false>
__device__ __forceinline__ void gemm_phase(PG8_LAS unsigned char* lds, const Gemm g, const Sched& S, const Epi& E, int wave_s) {
    int tid = wave_s * 64 + (int)__builtin_amdgcn_mbcnt_hi(~0u, __builtin_amdgcn_mbcnt_lo(~0u, 0u)); asm volatile("" : "+v"(tid));
    const int wid = __builtin_amdgcn_readfirstlane(tid >> 6), lane = tid & 63, wr = wid >> 2, wc = wid & 3, fr = lane & 15, fq = lane >> 4;
    const int K = g.K, LD = g.ld, nt = K / BK;
    unsigned voffA[2], voffB[2];
#pragma unroll
    for (int i = 0; i < 2; ++i) { int R, C; stage_rc(tid * 16 + i * 8192, R, C); const int Rb = Epi::PERM ? ((R & ~31) + perm32(R & 31)) : R;
        voffA[i] = (unsigned)(R * LD + C) * 2u; voffB[i] = (unsigned)(Rb * LD + C) * 2u; }
    const size_t kstep = (size_t)(BK * 2);
    const size_t hstep = (size_t)HALF * LD * 2;
    const size_t tstep = 2 * hstep;
    const unsigned ldsw = (unsigned)wid * 1024u;
    const int aoff = lds_byte(wr * 64 + fr, fq * 8), boff = lds_byte(wc * 32 + fr, fq * 8);
#define PG8_SA(b, h) (((b) * 2 + (h)) * HTB)
#define PG8_SB(b, h) ((4 + (b) * 2 + (h)) * HTB)
#define PG8_STAGE(bufoff, gbase, voff) do { _Pragma("unroll") for (int _i = 0; _i < 2; ++_i) \
        __builtin_amdgcn_global_load_lds((const unsigned*)((const char*)(gbase) + (voff)[_i]), (PG8_LAS unsigned*)(lds + (bufoff) + ldsw + _i * 8192), 16, 0, 0); } while (0)
#define PG8_LDA(dst, b, h) do { _Pragma("unroll") for (int m = 0; m < 4; ++m) _Pragma("unroll") for (int k = 0; k < 2; ++k) dst[m][k] = *(const PG8_LAS bf16x8*)(lds + PG8_SA(b, h) + aoff + m * 2048 + k * 1024); } while (0)
#define PG8_LDB(dst, b, h) do { _Pragma("unroll") for (int n = 0; n < 2; ++n) _Pragma("unroll") for (int k = 0; k < 2; ++k) dst[n][k] = *(const PG8_LAS bf16x8*)(lds + PG8_SB(b, h) + boff + n * 2048 + k * 1024); } while (0)
#define PG8_MMA(ai, bj, At, Bt) do { __builtin_amdgcn_s_setprio(1); _Pragma("unroll") for (int m = 0; m < 4; ++m) _Pragma("unroll") for (int n = 0; n < 2; ++n) _Pragma("unroll") for (int k = 0; k < 2; ++k) \
        acc[ai][bj][m][n] = __builtin_amdgcn_mfma_f32_16x16x32_bf16(Bt[n][k], At[m][k], acc[ai][bj][m][n], 0, 0, 0); __builtin_amdgcn_s_setprio(0); } while (0)
#define PG8_WAIT_V(n) asm volatile("s_waitcnt vmcnt(" #n ")" ::: "memory")
#define PG8_WAIT_L(n) asm volatile("s_waitcnt lgkmcnt(" #n ")" ::: "memory")
#define PG8_BAR __builtin_amdgcn_s_barrier()
#define PG8_SCHED __builtin_amdgcn_sched_barrier(0)
    Unit cur, nxt; int ui = 0;
    if (!S.next(0, cur)) return;
    f32x4 acc[2][2][4][2];
#pragma unroll
    for (int a = 0; a < 2; ++a)
#pragma unroll
        for (int b = 0; b < 2; ++b)
#pragma unroll
            for (int m = 0; m < 4; ++m)
#pragma unroll
                for (int n = 0; n < 2; ++n) acc[a][b][m][n] = (f32x4){0.f, 0.f, 0.f, 0.f};
    bf16x8 At[4][2], B0[2][2], B1[2][2];
    const size_t kqstep = (size_t)K * 2;
    const char* cA = (const char*)g.A + (size_t)cur.pm * tstep + (size_t)cur.kq * kqstep; const char* cB = (const char*)g.Bt + (size_t)cur.pn * tstep + (size_t)cur.kq * kqstep;
    S.a_ready(cur);
    if constexpr (SP2) {
        PG8_STAGE(PG8_SB(0, 0), cB, voffB); PG8_STAGE(PG8_SB(0, 1), cB + hstep, voffB); PG8_STAGE(PG8_SA(0, 0), cA, voffA); PG8_STAGE(PG8_SA(0, 1), cA + hstep, voffA);
        if (wr == 1) PG8_BAR;
        PG8_WAIT_V(2); PG8_BAR;
        PG8_STAGE(PG8_SB(1, 0), cB + kstep, voffB); PG8_STAGE(PG8_SA(1, 0), cA + kstep, voffA); PG8_STAGE(PG8_SB(1, 1), cB + hstep + kstep, voffB);
        PG8_WAIT_V(6); PG8_BAR;
    } else {
        PG8_STAGE(PG8_SB(0, 0), cB, voffB); PG8_STAGE(PG8_SA(0, 0), cA, voffA); PG8_STAGE(PG8_SB(0, 1), cB + hstep, voffB); PG8_STAGE(PG8_SA(0, 1), cA + hstep, voffA);
        if (wr == 1) PG8_BAR;
        PG8_WAIT_V(4); PG8_BAR;
        PG8_STAGE(PG8_SB(1, 0), cB + kstep, voffB); PG8_STAGE(PG8_SA(1, 0), cA + kstep, voffA); PG8_STAGE(PG8_SB(1, 1), cB + hstep + kstep, voffB);
        PG8_WAIT_V(6); PG8_BAR;
    }
    for (;;) {
        const bool has_next = S.next(ui + 1, nxt);
        const char* nA = has_next ? (const char*)g.A + (size_t)nxt.pm * tstep + (size_t)nxt.kq * kqstep : cA; const char* nB = has_next ? (const char*)g.Bt + (size_t)nxt.pn * tstep + (size_t)nxt.kq * kqstep : cB;
        for (int t = 0; t < nt; t += 2) {
            const bool last = (t == nt - 2);
            const char* a1 = cA + (size_t)(t + 1) * kstep;
            const char* a2 = last ? nA : cA + (size_t)(t + 2) * kstep; const char* b2 = last ? nB : cB + (size_t)(t + 2) * kstep;
            const char* a3 = a2 + kstep; const char* b3 = b2 + kstep;
            if (last && has_next) S.a_ready(nxt);
            if constexpr (SP2) {
            PG8_LDB(B0, 0, 0); PG8_LDB(B1, 0, 1); PG8_SCHED; PG8_LDA(At, 0, 0); PG8_STAGE(PG8_SA(1, 1), a1 + hstep, voffA);
            PG8_WAIT_V(8); PG8_WAIT_L(0); PG8_BAR; PG8_MMA(0, 0, At, B0); PG8_MMA(0, 1, At, B1); PG8_BAR; PG8_SCHED;
            PG8_LDA(At, 0, 1); PG8_STAGE(PG8_SB(0, 0), b2, voffB); PG8_STAGE(PG8_SB(0, 1), b2 + hstep, voffB); PG8_STAGE(PG8_SA(0, 0), a2, voffA);
            PG8_WAIT_V(8); PG8_WAIT_L(0); PG8_BAR; PG8_MMA(1, 0, At, B0); PG8_MMA(1, 1, At, B1); PG8_BAR; PG8_SCHED;
            PG8_LDB(B0, 1, 0); PG8_LDB(B1, 1, 1); PG8_SCHED; PG8_LDA(At, 1, 0); PG8_STAGE(PG8_SA(0, 1), a2 + hstep, voffA);
            PG8_WAIT_V(8); PG8_WAIT_L(0); PG8_BAR; PG8_MMA(0, 0, At, B0); PG8_MMA(0, 1, At, B1); PG8_BAR; PG8_SCHED;
            PG8_LDA(At, 1, 1); PG8_STAGE(PG8_SB(1, 0), b3, voffB); PG8_STAGE(PG8_SB(1, 1), b3 + hstep, voffB); PG8_STAGE(PG8_SA(1, 0), a3, voffA);
            PG8_WAIT_V(8); PG8_WAIT_L(0); PG8_BAR; PG8_MMA(1, 0, At, B0); PG8_MMA(1, 1, At, B1); PG8_BAR; PG8_SCHED;
            } else {
            PG8_LDB(B0, 0, 0); PG8_SCHED; PG8_LDA(At, 0, 0); PG8_STAGE(PG8_SA(1, 1), a1 + hstep, voffA);
            PG8_WAIT_L(8); PG8_BAR; PG8_WAIT_L(0); PG8_MMA(0, 0, At, B0); PG8_BAR; PG8_SCHED;
            PG8_LDB(B1, 0, 1); PG8_STAGE(PG8_SB(0, 0), b2, voffB);
            PG8_BAR; PG8_WAIT_L(0); PG8_MMA(0, 1, At, B1); PG8_BAR;
            PG8_LDA(At, 0, 1); PG8_STAGE(PG8_SA(0, 0), a2, voffA);
            PG8_BAR; PG8_WAIT_L(0); PG8_MMA(1, 0, At, B0); PG8_BAR; PG8_SCHED;
            PG8_STAGE(PG8_SB(0, 1), b2 + hstep, voffB);
            PG8_WAIT_V(6); PG8_BAR; PG8_MMA(1, 1, At, B1); PG8_BAR;
            PG8_LDB(B0, 1, 0); PG8_SCHED; PG8_LDA(At, 1, 0); PG8_STAGE(PG8_SA(0, 1), a2 + hstep, voffA);
            PG8_WAIT_L(8); PG8_BAR; PG8_WAIT_L(0); PG8_MMA(0, 0, At, B0); PG8_BAR; PG8_SCHED;
            PG8_LDB(B1, 1, 1); PG8_STAGE(PG8_SB(1, 0), b3, voffB);
            PG8_BAR; PG8_WAIT_L(0); PG8_MMA(0, 1, At, B1); PG8_BAR;
            PG8_LDA(At, 1, 1); PG8_STAGE(PG8_SA(1, 0), a3, voffA);
            PG8_BAR; PG8_WAIT_L(0); PG8_MMA(1, 0, At, B0); PG8_BAR; PG8_SCHED;
            PG8_STAGE(PG8_SB(1, 1), b3 + hstep, voffB);
            PG8_WAIT_V(6); PG8_BAR; PG8_MMA(1, 1, At, B1); PG8_BAR;
            }
        }
        if constexpr (ALIGN_EPI) { if (wr == 0) PG8_BAR; }
        if constexpr (!Epi::AFTER_DRAIN) { E(acc, cur, wr, wc, fr, fq); S.done(cur); }
        if (!has_next) break;
#pragma unroll
        for (int a = 0; a < 2; ++a)
#pragma unroll
            for (int b = 0; b < 2; ++b)
#pragma unroll
                for (int m = 0; m < 4; ++m)
#pragma unroll
                    for (int n = 0; n < 2; ++n) acc[a][b][m][n] = (f32x4){0.f, 0.f, 0.f, 0.f};
        cur = nxt; cA = nA; cB = nB; ++ui;
        if constexpr (ALIGN_EPI) { if (wr == 1) PG8_BAR; }
    }
    PG8_WAIT_V(0);
    if constexpr (!ALIGN_EPI) { if (wr == 0) PG8_BAR; }
    PG8_BAR;
    if constexpr (Epi::AFTER_DRAIN) { E.fused(acc, cur, wr, wc, fr, fq, lds, wid, lane); S.done(cur); }
#undef PG8_SA
#undef PG8_SB
#undef PG8_STAGE
#undef PG8_LDA
#undef PG8_LDB
#undef PG8_MMA
#undef PG8_WAIT_V
#undef PG8_WAIT_L
#undef PG8_BAR
#undef PG8_SCHED
}
}

#define LAS __attribute__((address_space(3)))
typedef unsigned short bf16_t;
typedef short bf16x8 __attribute__((ext_vector_type(8)));
typedef short s16x4 __attribute__((ext_vector_type(4)));
typedef float f32x4 __attribute__((ext_vector_type(4)));
typedef float f32x16 __attribute__((ext_vector_type(16)));
typedef unsigned u32x2 __attribute__((ext_vector_type(2)));
typedef unsigned u32x4 __attribute__((ext_vector_type(4)));
__device__ __forceinline__ unsigned cvtpk(float lo, float hi) { unsigned r; asm volatile("v_cvt_pk_bf16_f32 %0, %1, %2" : "=v"(r) : "v"(lo), "v"(hi)); return r; }
__device__ __forceinline__ float bflo(unsigned w) { return __uint_as_float(w << 16); }
__device__ __forceinline__ float bfhi(unsigned w) { return __uint_as_float(w & 0xffff0000u); }
__device__ __forceinline__ float bf2f(unsigned short h) { return __uint_as_float((unsigned)h << 16); }
__device__ __forceinline__ unsigned short f2bf(float f) { unsigned u = __float_as_uint(f); return (unsigned short)((u + 0x7fffu + ((u >> 16) & 1u)) >> 16); }
__device__ __forceinline__ int lane_id() { return (int)__builtin_amdgcn_mbcnt_hi(~0u, __builtin_amdgcn_mbcnt_lo(~0u, 0u)); }
template <int X> __device__ __forceinline__ float swz_xor(float v) { return __int_as_float(__builtin_amdgcn_ds_swizzle(__float_as_int(v), (X << 10) | 0x1f)); }
template <int CTRL, int ROWMASK> __device__ __forceinline__ float dpp_f(float v) { return __int_as_float(__builtin_amdgcn_update_dpp(0, __float_as_int(v), CTRL, ROWMASK, 0xF, false)); }
__device__ __forceinline__ float wave_sum(float v) {
    v += dpp_f<0xB1, 0xF>(v);
    v += dpp_f<0x4E, 0xF>(v);
    v += dpp_f<0x141, 0xF>(v);
    v += dpp_f<0x140, 0xF>(v);
    v += dpp_f<0x142, 0xA>(v);
    v += dpp_f<0x143, 0xC>(v);
    return __builtin_amdgcn_readlane(v, 63);
}
__device__ __forceinline__ float sigmoidf_(float x) { return __builtin_amdgcn_rcpf(1.f + __expf(-x)); }
__device__ __forceinline__ float rope_inv(int i) { return exp2f(-1.6609640474436813f * (float)i); }

namespace att {
constexpr int NW = 8, QBLK = 32, KVBLK = 64;
constexpr float SCALE = 0.10206207261596575f;
constexpr float THR = 8.f;
constexpr int BUFB = 16384;
constexpr int NRING = 3, OFF_V = 0, OFF_K = NRING * BUFB, OFF_WS = 2 * NRING * BUFB, LDS_BYTES = OFF_WS + NW * 64 * 4;
#define KSWZ(row, colB) ((row) * 256 + ((colB) ^ (((row) & 15) << 4)))
#define SBAR() __builtin_amdgcn_sched_barrier(0)
__device__ __forceinline__ int crow(int r, int hi) { return (r & 3) + 8 * (r >> 2) + 4 * hi; }
constexpr float C2 = SCALE * 1.4426950408889634f;
constexpr float THR2 = THR * 1.4426950408889634f;
#define MX3(a, b, c) __builtin_fmaxf(__builtin_fmaxf((a), (b)), (c))
__device__ __forceinline__ void softmaxT(f32x16& p0, f32x16& p1, float& mref, f32x16& negm, float& l_reg, float& alpha, bf16x8& pa0, bf16x8& pa1, bf16x8& pa2, bf16x8& pa3) {
  float a = MX3(p0[0], p0[1], p1[0]), b = MX3(p0[2], p0[3], p1[1]); a = MX3(a, p1[2], p1[3]);
#pragma unroll
  for (int r = 4; r < 16; r += 4) { a = MX3(a, p0[r], p0[r + 1]); b = MX3(b, p0[r + 2], p0[r + 3]); a = MX3(a, p1[r], p1[r + 1]); b = MX3(b, p1[r + 2], p1[r + 3]); }
  float pmax = __builtin_fmaxf(a, b);
  { auto rr = __builtin_amdgcn_permlane32_swap(__float_as_uint(pmax), __float_as_uint(pmax), false, false);
    pmax = __builtin_fmaxf(__uint_as_float(rr[0]), __uint_as_float(rr[1])); }
  if (__builtin_expect(__all(pmax <= THR2), 1)) { alpha = 1.f; }
  else { const float dl = __builtin_fmaxf(pmax, 0.f); mref += dl; alpha = __builtin_amdgcn_exp2f(-dl); l_reg *= alpha;
#pragma unroll
    for (int r = 0; r < 16; ++r) { p0[r] -= dl; p1[r] -= dl; negm[r] = -mref; }
    asm volatile("" : "+v"(negm)); }
#pragma unroll
  for (int r = 0; r < 16; ++r) { p0[r] = __builtin_amdgcn_exp2f(p0[r]); p1[r] = __builtin_amdgcn_exp2f(p1[r]); }
  { float s0 = p0[0] + p1[0], s1 = p0[1] + p1[1], s2 = p0[2] + p1[2], s3 = p0[3] + p1[3];
#pragma unroll
    for (int r = 4; r < 16; r += 4) { s0 += p0[r] + p1[r]; s1 += p0[r + 1] + p1[r + 1]; s2 += p0[r + 2] + p1[r + 2]; s3 += p0[r + 3] + p1[r + 3]; }
    l_reg += (s0 + s1) + (s2 + s3); }
#define PK4(P, BASE, OUT) do { unsigned a0 = cvtpk(P[BASE + 0], P[BASE + 1]), a1 = cvtpk(P[BASE + 2], P[BASE + 3]);   \
    unsigned b0 = cvtpk(P[BASE + 4], P[BASE + 5]), b1 = cvtpk(P[BASE + 6], P[BASE + 7]);                              \
    auto r0 = __builtin_amdgcn_permlane32_swap(a0, b0, false, false); auto r1 = __builtin_amdgcn_permlane32_swap(a1, b1, false, false); \
    u32x4 w = {r0[0], r1[0], r0[1], r1[1]}; OUT = __builtin_bit_cast(bf16x8, w); } while (0)
  PK4(p0, 0, pa0); PK4(p0, 8, pa1); PK4(p1, 0, pa2); PK4(p1, 8, pa3);
#undef PK4
}
__device__ __forceinline__ void partialSM(f32x16& p0, f32x16& p1, float& mref, f32x16& negm, float& alpha) {
  float a = MX3(p0[0], p0[1], p1[0]), b = MX3(p0[2], p0[3], p1[1]); a = MX3(a, p1[2], p1[3]);
#pragma unroll
  for (int r = 4; r < 16; r += 4) { a = MX3(a, p0[r], p0[r + 1]); b = MX3(b, p0[r + 2], p0[r + 3]); a = MX3(a, p1[r], p1[r + 1]); b = MX3(b, p1[r + 2], p1[r + 3]); }
  float pmax = __builtin_fmaxf(a, b);
  { auto rr = __builtin_amdgcn_permlane32_swap(__float_as_uint(pmax), __float_as_uint(pmax), false, false);
    pmax = __builtin_fmaxf(__uint_as_float(rr[0]), __uint_as_float(rr[1])); }
  if (__builtin_expect(__all(pmax <= THR2), 1)) { alpha = 1.f; }
  else { const float dl = __builtin_fmaxf(pmax, 0.f); mref += dl; alpha = __builtin_amdgcn_exp2f(-dl);
#pragma unroll
    for (int r = 0; r < 16; ++r) { p0[r] -= dl; p1[r] -= dl; negm[r] = -mref; }
    asm volatile("" : "+v"(negm)); }
#pragma unroll
  for (int r = 0; r < 16; ++r) p0[r] = __builtin_amdgcn_exp2f(p0[r]);
}
__device__ __forceinline__ void finishSM(f32x16& p0, f32x16& p1, float& l_reg, bf16x8& pa0, bf16x8& pa1, bf16x8& pa2, bf16x8& pa3) {
#pragma unroll
  for (int r = 0; r < 16; ++r) p1[r] = __builtin_amdgcn_exp2f(p1[r]);
  { float s0 = p0[0] + p1[0], s1 = p0[1] + p1[1], s2 = p0[2] + p1[2], s3 = p0[3] + p1[3];
#pragma unroll
    for (int r = 4; r < 16; r += 4) { s0 += p0[r] + p1[r]; s1 += p0[r + 1] + p1[r + 1]; s2 += p0[r + 2] + p1[r + 2]; s3 += p0[r + 3] + p1[r + 3]; }
    l_reg += (s0 + s1) + (s2 + s3); }
#define PK4(P, BASE, OUT) do { unsigned a0 = cvtpk(P[BASE + 0], P[BASE + 1]), a1 = cvtpk(P[BASE + 2], P[BASE + 3]);   \
    unsigned b0 = cvtpk(P[BASE + 4], P[BASE + 5]), b1 = cvtpk(P[BASE + 6], P[BASE + 7]);                              \
    auto r0 = __builtin_amdgcn_permlane32_swap(a0, b0, false, false); auto r1 = __builtin_amdgcn_permlane32_swap(a1, b1, false, false); \
    u32x4 w = {r0[0], r1[0], r0[1], r1[1]}; OUT = __builtin_bit_cast(bf16x8, w); } while (0)
  PK4(p0, 0, pa0); PK4(p0, 8, pa1); PK4(p1, 0, pa2); PK4(p1, 8, pa3);
#undef PK4
}
__device__ __forceinline__ void qkt(f32x16& p0, f32x16& p1, const LAS unsigned char* Ks, const bf16x8* qr, const f32x16& negm, int r32, int hi) {
  bf16x8 kf[12];
#pragma unroll
  for (int d0 = 0; d0 < 6; ++d0) { const int cb = (d0 * 16 + hi * 8) * 2;
    kf[2 * d0] = *(const LAS bf16x8*)(Ks + KSWZ(r32, cb)); kf[2 * d0 + 1] = *(const LAS bf16x8*)(Ks + KSWZ(32 + r32, cb)); }
  SBAR();
  p0 = __builtin_amdgcn_mfma_f32_32x32x16_bf16(kf[0], qr[0], negm, 0, 0, 0); p1 = __builtin_amdgcn_mfma_f32_32x32x16_bf16(kf[1], qr[0], negm, 0, 0, 0);
#pragma unroll
  for (int d0 = 1; d0 < 6; ++d0) { p0 = __builtin_amdgcn_mfma_f32_32x32x16_bf16(kf[2 * d0], qr[d0], p0, 0, 0, 0); p1 = __builtin_amdgcn_mfma_f32_32x32x16_bf16(kf[2 * d0 + 1], qr[d0], p1, 0, 0, 0); }
}
__device__ __forceinline__ int v_st(int k, int c) { const int kk = (k & ~0xC) | ((k & 4) << 1) | ((k & 8) >> 1); return ((kk >> 3) * 4 + (c >> 5)) * 512 + ((kk & 7) * 32 + (c & 31)) * 2; }
__device__ __forceinline__ int v_rd_base(int lane) { return ((lane & 3) << 3) | (((lane >> 2) & 3) << 6) | (((lane >> 4) & 1) << 5) | (((lane >> 5) & 1) << 8); }
constexpr int v_rd_off(int d0, int ks, int half) { return d0 * 512 + ks * 4096 + half * 2048; }
template <int OFF> __device__ __forceinline__ s16x4 tr_read(int vb) {
  s16x4 r; asm volatile("ds_read_b64_tr_b16 %0, %1 offset:%2" : "=&v"(r) : "v"(vb), "i"(OFF) : "memory"); return r;
}
__device__ __forceinline__ void pv_d0(f32x16* o, int vb, bf16x8 pa0, bf16x8 pa1, bf16x8 pa2, bf16x8 pa3) {
  const s16x4 a0 = tr_read<v_rd_off(0, 0, 0)>(vb), b0 = tr_read<v_rd_off(0, 0, 1)>(vb), a1 = tr_read<v_rd_off(0, 1, 0)>(vb), b1 = tr_read<v_rd_off(0, 1, 1)>(vb);
  const s16x4 a2 = tr_read<v_rd_off(0, 2, 0)>(vb), b2 = tr_read<v_rd_off(0, 2, 1)>(vb), a3 = tr_read<v_rd_off(0, 3, 0)>(vb), b3 = tr_read<v_rd_off(0, 3, 1)>(vb);
  const s16x4 c0 = tr_read<v_rd_off(1, 0, 0)>(vb), d0 = tr_read<v_rd_off(1, 0, 1)>(vb), c1 = tr_read<v_rd_off(1, 1, 0)>(vb), d1 = tr_read<v_rd_off(1, 1, 1)>(vb);
  const s16x4 c2 = tr_read<v_rd_off(1, 2, 0)>(vb), d2 = tr_read<v_rd_off(1, 2, 1)>(vb), c3 = tr_read<v_rd_off(1, 3, 0)>(vb), d3 = tr_read<v_rd_off(1, 3, 1)>(vb);
  asm volatile("s_waitcnt lgkmcnt(0)" ::: "memory"); SBAR();
#define PK(L, H) (bf16x8){L[0], L[1], L[2], L[3], H[0], H[1], H[2], H[3]}
  o[0] = __builtin_amdgcn_mfma_f32_32x32x16_bf16(pa0, PK(a0, b0), o[0], 0, 0, 0); o[1] = __builtin_amdgcn_mfma_f32_32x32x16_bf16(pa0, PK(c0, d0), o[1], 0, 0, 0);
  o[0] = __builtin_amdgcn_mfma_f32_32x32x16_bf16(pa1, PK(a1, b1), o[0], 0, 0, 0); o[1] = __builtin_amdgcn_mfma_f32_32x32x16_bf16(pa1, PK(c1, d1), o[1], 0, 0, 0);
  o[0] = __builtin_amdgcn_mfma_f32_32x32x16_bf16(pa2, PK(a2, b2), o[0], 0, 0, 0); o[1] = __builtin_amdgcn_mfma_f32_32x32x16_bf16(pa2, PK(c2, d2), o[1], 0, 0, 0);
  o[0] = __builtin_amdgcn_mfma_f32_32x32x16_bf16(pa3, PK(a3, b3), o[0], 0, 0, 0); o[1] = __builtin_amdgcn_mfma_f32_32x32x16_bf16(pa3, PK(c3, d3), o[1], 0, 0, 0);
#undef PK
}
__device__ __forceinline__ void attn_unit(const bf16_t* __restrict__ Qb, bool rope_q, int tq0, const bf16_t* __restrict__ KVh, const bf16_t* __restrict__ KR,
                                          int ctx_row0, int lat_row0, int NT, bf16_t* __restrict__ Ob, LAS unsigned char* lds, int wave_s) {
  int tid = wave_s * 64 + lane_id(); asm volatile("" : "+v"(tid));
  const int wid = tid >> 6, lane = tid & 63, r32 = lane & 31, hi = lane >> 5;
  LAS float* al_l = (LAS float*)(lds + OFF_WS) + wid * 64;
  float mref = 0.f, l_reg = 0.f; f32x16 o[2] = {}; f32x16 negm = {}; asm volatile("" : "+v"(negm)); bf16x8 qr[6];
  { const bf16_t* Qw = Qb + (long)(wid * QBLK + r32) * 768;
#pragma unroll
    for (int d0 = 0; d0 < 4; ++d0) { const u32x4 w = *(const u32x4*)(Qw + d0 * 16 + hi * 8);
      u32x4 s = {cvtpk(bflo(w.x) * C2, bfhi(w.x) * C2), cvtpk(bflo(w.y) * C2, bfhi(w.y) * C2), cvtpk(bflo(w.z) * C2, bfhi(w.z) * C2), cvtpk(bflo(w.w) * C2, bfhi(w.w) * C2)};
      qr[d0] = __builtin_bit_cast(bf16x8, s); }
    const int t = tq0 + wid * QBLK + r32;
#pragma unroll
    for (int a = 0; a < 2; ++a) {
      const u32x4 lo = *(const u32x4*)(Qw + 64 + a * 16), hh = *(const u32x4*)(Qw + 64 + a * 16 + 8);
      const float pos = (float)(a == 0 ? (t >> 6) : (t & 63)); float ov[8];
#pragma unroll
      for (int i = 0; i < 8; ++i) { const float ang = rope_q ? pos * rope_inv(i) : 0.f, c = __cosf(ang) * C2, s = __sinf(ang) * C2;
        const float l = (i & 1) ? bfhi(lo[i >> 1]) : bflo(lo[i >> 1]), h = (i & 1) ? bfhi(hh[i >> 1]) : bflo(hh[i >> 1]);
        ov[i] = hi ? (h * c + l * s) : (l * c - h * s); }
      u32x4 w = {cvtpk(ov[0], ov[1]), cvtpk(ov[2], ov[3]), cvtpk(ov[4], ov[5]), cvtpk(ov[6], ov[7])}; qr[4 + a] = __builtin_bit_cast(bf16x8, w);
    }
  }
  const int sr = tid >> 4, sc = (tid & 15) * 8, rr = (tid & 255) >> 2, rc = (tid & 3) * 8;
  const int st0 = (sc < 64) ? OFF_K + KSWZ(sr, sc * 2) : OFF_V + v_st(sr, sc - 64);
  const int st1 = (sc < 64) ? OFF_K + KSWZ(32 + sr, sc * 2) : OFF_V + v_st(32 + sr, sc - 64);
  const int st2 = OFF_K + KSWZ(rr, (64 + rc) * 2);
  const int vb0 = (int)(size_t)(lds + OFF_V) + v_rd_base(lane);
  struct { bf16x8 a0, a1, rp; } sg[2];
#define KROW(t) ((t) < 4 ? ctx_row0 + (t) * KVBLK : lat_row0 + ((t) - 4) * KVBLK)
#define SLOAD(i, t) do { const long k0_ = KROW(t); sg[i].a0 = *(const bf16x8*)(KVh + (k0_ + sr) * 1024 + sc); sg[i].a1 = *(const bf16x8*)(KVh + (k0_ + 32 + sr) * 1024 + sc); \
    sg[i].rp = *(const bf16x8*)(KR + (k0_ + rr) * 32 + rc); } while (0)
#define SWRITE_AT(boff, i) do { *(LAS bf16x8*)(lds + (boff) + st0) = sg[i].a0; *(LAS bf16x8*)(lds + (boff) + st1) = sg[i].a1; *(LAS bf16x8*)(lds + (boff) + st2) = sg[i].rp; } while (0)
#define RESC(a) do { if (__any((a) < 1.f)) { if (hi == 0) al_l[r32] = (a); asm volatile("s_waitcnt lgkmcnt(0)" ::: "memory"); \
    _Pragma("unroll") for (int r = 0; r < 16; ++r) { const float f_ = al_l[crow(r, hi)]; o[0][r] *= f_; o[1][r] *= f_; } } } while (0)
  const int trail = (wave_s >= 4) ? 1 : 0;
  const LAS unsigned char* Kb = lds + OFF_K;
  f32x16 p0, p1; float alpha; bf16x8 pa0, pa1, pa2, pa3;
  SLOAD(0, 0); SLOAD(1, 1);
  asm volatile("s_waitcnt vmcnt(3)" ::: "memory"); SWRITE_AT(0, 0);
  if (trail) { asm volatile("s_waitcnt vmcnt(0)" ::: "memory"); SWRITE_AT(BUFB, 1); SLOAD(1, 2); SLOAD(0, 3); }
  else { SLOAD(0, 2); }
  __syncthreads();
  if (trail) __syncthreads();
  int bV = 0, bK = 0, bN = BUFB, bNN = 2 * BUFB;
#define PHASE_M(j) do { SBAR(); __builtin_amdgcn_s_setprio(2); if ((j) > 0) pv_d0(o, vb0 + bV, pa0, pa1, pa2, pa3); qkt(p0, p1, Kb + bK, qr, negm, r32, hi); __builtin_amdgcn_s_setprio(0); SBAR(); __syncthreads(); } while (0)
#define PHASE_V(j, slot) do { softmaxT(p0, p1, mref, negm, l_reg, alpha, pa0, pa1, pa2, pa3); RESC(alpha); \
    { const int s_ = (j) + 1 + trail; if (s_ < NT) { asm volatile("s_waitcnt vmcnt(3)" ::: "memory"); SWRITE_AT(trail ? bNN : bN, slot); const int s2_ = s_ + 2; SLOAD(slot, s2_ < NT ? s2_ : NT - 1); } } \
    __syncthreads(); bV = bK; bK = bN; bN = bNN; bNN = bV; } while (0)
  for (int j = 0; j < NT; j += 2) {
    PHASE_M(j); PHASE_V(j, 1);
    PHASE_M(j + 1); PHASE_V(j + 1, 0);
  }
  SBAR(); pv_d0(o, vb0 + bV, pa0, pa1, pa2, pa3);
  if (!trail) __syncthreads();
#undef PHASE_M
#undef PHASE_V
  { auto rr_ = __builtin_amdgcn_permlane32_swap(__float_as_uint(l_reg), __float_as_uint(l_reg), false, false); l_reg = __uint_as_float(rr_[0]) + __uint_as_float(rr_[1]); }
  if (hi == 0) al_l[32 + r32] = l_reg; asm volatile("s_waitcnt lgkmcnt(0)" ::: "memory");
  float rli[16];
#pragma unroll
  for (int r = 0; r < 16; ++r) rli[r] = __builtin_amdgcn_rcpf(al_l[32 + crow(r, hi)]);
  bf16_t* Ow = Ob + (long)(wid * QBLK) * 1024;
#pragma unroll
  for (int r = 0; r < 16; ++r) { const int orow = crow(r, hi);
#pragma unroll
    for (int d0 = 0; d0 < 2; ++d0) Ow[(long)orow * 1024 + d0 * 32 + r32] = f2bf(o[d0][r] * rli[r]); }
  __syncthreads();
#undef KROW
#undef SLOAD
#undef SWRITE_AT
#undef RESC
}
}

constexpr int NLAT = 32768, NCTX = 1024, MTOT = 33792, DM = 1024, ZW = 1792, INW = 1696, SEQL = 8192, CTXL = 256, DFF = 4096;
constexpr float EPSN = 1e-6f;
constexpr size_t MiB = 1u << 20;
constexpr size_t WS_MOD = 1 * MiB;
constexpr size_t WS_W = 2 * MiB, W_LAYER = 23 * MiB;
constexpr size_t W_IN = 0, W_Q = 3584 * 1024, W_KV = 4 * MiB, W_O = 4608 * 1024, W_UP = 7 * MiB, W_DN = 15 * MiB;
constexpr size_t WS_A = 48 * MiB;
constexpr size_t WS_B = 114 * MiB;
constexpr size_t WS_Z = WS_B, WS_Q = WS_B + 116 * MiB, WS_KV = WS_B + 166 * MiB, WS_QN = WS_B + 232 * MiB, WS_KVN = WS_B + 249 * MiB, WS_KR = WS_B + 258 * MiB;
constexpr size_t WS_D = 378 * MiB;
constexpr size_t WS_XSC = 444 * MiB;
constexpr size_t WS_PART = 448 * MiB;
constexpr size_t WS_END = 512 * MiB;
static_assert((size_t)MTOT * ZW * 2 <= 116 * MiB && (size_t)MTOT * 768 * 2 <= 50 * MiB && (size_t)MTOT * 1024 * 2 <= 66 * MiB && (size_t)MTOT * 256 * 2 <= 17 * MiB && (size_t)MTOT * 128 * 2 <= 9 * MiB && WS_KR + (size_t)MTOT * 64 <= WS_B + 264 * MiB, "ws map");
constexpr int LDS_BYTES = 147456;

struct Params { const float* in[24]; float* out; unsigned char* ws; };
enum { I_X = 0, I_C, I_CTX, I_CCTX, I_WMOD, I_BMOD, I_GPREMIX, I_GPOSTMIX, I_GPREMLP, I_GPOSTMLP, I_WIN, I_GQ, I_WQB, I_GKV, I_WKVB, I_CDWW, I_CDWB, I_CLNG, I_CLNB, I_SDWW, I_GBR, I_WO, I_WUP, I_WDN };

__device__ __forceinline__ void transpose_item(const float* __restrict__ W, int K, int N, bf16_t* __restrict__ WT, LAS float* scr, int item, int lane) {
    const int nblk = N / 32, kb = item / nblk, nb = item % nblk, k0 = 64 * kb, n0 = 32 * nb;
#pragma unroll 8
    for (int i = 0; i < 32; ++i) { const int kk = 2 * i + (lane >> 5); scr[kk * 33 + (lane & 31)] = W[(size_t)(k0 + kk) * N + n0 + (lane & 31)]; }
    asm volatile("s_waitcnt lgkmcnt(0)" ::: "memory");
    const int c = lane & 7;
#pragma unroll
    for (int j = 0; j < 4; ++j) { const int n = (lane >> 3) + 8 * j; const LAS float* s = scr + (8 * c) * 33 + n;
        u32x4 o; o.x = cvtpk(s[0 * 33], s[1 * 33]); o.y = cvtpk(s[2 * 33], s[3 * 33]); o.z = cvtpk(s[4 * 33], s[5 * 33]); o.w = cvtpk(s[6 * 33], s[7 * 33]);
        *(u32x4*)(WT + (size_t)(n0 + n) * K + k0 + 8 * c) = o; }
    asm volatile("s_waitcnt lgkmcnt(0)" ::: "memory");
}
__device__ __forceinline__ void load16(const float* row, int lane, f32x4 (&v)[4]) {
#pragma unroll
    for (int j = 0; j < 4; ++j) v[j] = __builtin_nontemporal_load((const f32x4*)row + lane + 64 * j);
}
__device__ __forceinline__ void load16bf(const bf16_t* row, int lane, f32x4 (&v)[4]) {
#pragma unroll
    for (int j = 0; j < 4; ++j) { const u32x2 w = __builtin_nontemporal_load((const u32x2*)row + lane + 64 * j); v[j] = (f32x4){bflo(w.x), bfhi(w.x), bflo(w.y), bfhi(w.y)}; }
}
template <int NS> __device__ __forceinline__ void load16part(const float* P, int rowrel, int lane, f32x4 (&v)[4]) {
#pragma unroll
    for (int j = 0; j < 4; ++j) v[j] = (f32x4){0.f, 0.f, 0.f, 0.f};
#pragma unroll
    for (int s0 = 0; s0 < NS; s0 += 4) { f32x4 t[4][4];
#pragma unroll
        for (int s = 0; s < 4; ++s) { const f32x4* q = (const f32x4*)(P + ((size_t)(s0 + s) * 1024 + rowrel) * 1024);
#pragma unroll
            for (int j = 0; j < 4; ++j) t[s][j] = q[lane + 64 * j]; }
#pragma unroll
        for (int s = 0; s < 4; ++s)
#pragma unroll
            for (int j = 0; j < 4; ++j) v[j] += t[s][j]; }
}
__device__ __forceinline__ float ssq16(const f32x4 (&v)[4]) {
    float s = 0.f;
#pragma unroll
    for (int j = 0; j < 4; ++j) s += (v[j].x * v[j].x + v[j].y * v[j].y) + (v[j].z * v[j].z + v[j].w * v[j].w);
    return wave_sum(s);
}
__device__ __forceinline__ void prenorm_store(const f32x4 (&v)[4], float rinv, const float* g, const float* shift, const float* scale, bf16_t* orow, int lane) {
#pragma unroll
    for (int j = 0; j < 4; ++j) { const int q = lane + 64 * j; const f32x4 gg = ((const f32x4*)g)[q], sh = ((const f32x4*)shift)[q], sc = ((const f32x4*)scale)[q];
        const f32x4 h = (v[j] * rinv * gg) * (sc + 1.0f) + sh; u32x2 w; w.x = cvtpk(h.x, h.y); w.y = cvtpk(h.z, h.w); ((u32x2*)orow)[q] = w; }
}

#define XB_TMO      128
#define XB_XCNT(j)  (256  + 64 * (j))
#define XB_XSUB(j)  (1280 + 64 * (j))
#define XB_XGEN(j)  (2304 + 64 * (j))
#define XB_TOP      3328
#define XB_TOPGEN   3392
#define XCD_BAR_WORDS 3456
#define XB_SPIN_CAP (1u << 18)

__device__ __forceinline__ unsigned xb_ld(unsigned* p)              { return __hip_atomic_load(p, __ATOMIC_RELAXED, __HIP_MEMORY_SCOPE_AGENT); }
__device__ __forceinline__ unsigned xb_add(unsigned* p, unsigned v) { return __hip_atomic_fetch_add(p, v, __ATOMIC_RELAXED, __HIP_MEMORY_SCOPE_AGENT); }
__device__ __forceinline__ unsigned xb_xcc_id() { return (unsigned)__builtin_amdgcn_s_getreg((3 << 11) | 20) & 0xFu; }
#define XB_SPIN(cond, bar) do { unsigned _sp = 0; while (cond) { __builtin_amdgcn_s_sleep(1); \
    if ((++_sp & 255u) == 0u) { if (xb_ld(&(bar)[XB_TMO])) break; if (_sp > XB_SPIN_CAP) { atomicAdd(&(bar)[XB_TMO], 1u); break; } } } } while (0)

struct XcdBarrier { unsigned* bar; unsigned x; volatile LAS unsigned* st; };
__device__ __forceinline__ XcdBarrier xcd_barrier_post(unsigned* bar, volatile LAS unsigned* st, bool leader) {
    XcdBarrier b; b.bar = bar; b.x = xb_xcc_id(); b.st = st;
    if (leader) (void)xb_add(&bar[XB_XCNT(b.x)], 1u);
    return b;
}
__device__ __forceinline__ void xcd_barrier_complete(unsigned* bar, unsigned x, unsigned& nloc, unsigned& nx) {
    const unsigned G = gridDim.x * gridDim.y * gridDim.z;
    unsigned sum, cnt, mine, sp = 0u;
    for (;;) {
        sum = 0u; cnt = 0u; mine = 0u;
#pragma unroll
        for (unsigned j = 0; j < 16; ++j) { const unsigned c = xb_ld(&bar[XB_XCNT(j)]); sum += c; cnt += (c > 0u) ? 1u : 0u; mine = (j == x) ? c : mine; }
        if (sum == G) break;
        __builtin_amdgcn_s_sleep(1);
        if ((++sp & 255u) == 0u) { if (xb_ld(&bar[XB_TMO])) break; if (sp > XB_SPIN_CAP) { atomicAdd(&bar[XB_TMO], 1u); break; } }
    }
    nloc = mine > 0u ? mine : 1u; nx = cnt > 0u ? cnt : 1u;
}
__device__ __forceinline__ void xcd_barrier(const XcdBarrier& b, bool leader) {
    asm volatile("s_waitcnt vmcnt(0) lgkmcnt(0)" ::: "memory");
    __syncthreads();
    if (leader) {
        unsigned* bar = b.bar;
        __builtin_amdgcn_s_waitcnt(0);
        unsigned nloc = b.st[0], nx = b.st[1];
        if (nloc == 0u) { xcd_barrier_complete(bar, b.x, nloc, nx); b.st[0] = nloc; b.st[1] = nx; }
        const unsigned old = xb_add(&bar[XB_XSUB(b.x)], 1u);
        const unsigned gen = old / nloc;
        if (old + 1u == (gen + 1u) * nloc) {
            __builtin_amdgcn_fence(__ATOMIC_RELEASE, "agent");
            asm volatile("s_waitcnt vmcnt(0)" ::: "memory");
            const unsigned og = xb_add(&bar[XB_TOP], 1u);
            const unsigned tg = og / nx;
            if (og + 1u == (tg + 1u) * nx) xb_add(&bar[XB_TOPGEN], 1u);
            else XB_SPIN(xb_ld(&bar[XB_TOPGEN]) == tg, bar);
            __builtin_amdgcn_fence(__ATOMIC_ACQUIRE, "agent");
            xb_add(&bar[XB_XGEN(b.x)], 1u);
            asm volatile("s_waitcnt vmcnt(0)" ::: "memory");
        } else {
            XB_SPIN(xb_ld(&bar[XB_XGEN(b.x)]) == gen, bar);
            __builtin_amdgcn_fence(__ATOMIC_ACQUIRE, "agent");
            asm volatile("s_waitcnt vmcnt(0)" ::: "memory");
        }
    }
    __syncthreads();
}
#ifndef PROBE_R1_REPS
#define PROBE_R1_REPS 1
#endif
#ifndef PROBE_P1_REPS
#define PROBE_P1_REPS 1
#endif
#ifndef PROBE_P0_REPS
#define PROBE_P0_REPS 1
#endif
#ifndef PROBE_BAR_REPS
#define PROBE_BAR_REPS 1
#endif
#ifndef PROBE_GEMM_REPS
#define PROBE_GEMM_REPS 1
#endif
#ifndef PROBE_ATT_REPS
#define PROBE_ATT_REPS 1
#endif

__global__ void __launch_bounds__(512, 2) fwd_megakernel(Params p) {
    extern __shared__ __attribute__((aligned(16))) unsigned char lds_raw[];
    LAS unsigned char* lds = (LAS unsigned char*)lds_raw;
    const int wave = __builtin_amdgcn_readfirstlane(threadIdx.x >> 6);
    typedef const __attribute__((address_space(4))) Params* KP;
#define PHASE_IDS() int tid = wave * 64 + lane_id(); asm volatile("" : "+v"(tid)); int G = gridDim.x, blk = blockIdx.x; asm volatile("" : "+s"(G), "+s"(blk)); const int NGW = G * 8; const int lane = tid & 63; const int gw = blk * 8 + wave; (void)lane; (void)gw; (void)NGW; \
    KP pp = (KP)__builtin_amdgcn_kernarg_segment_ptr(); asm volatile("" : "+s"(pp)); unsigned char* ws = pp->ws; (void)ws;
#define PIN(i) (pp->in[i])
#define LOADY(m, y, ns) do { if ((m) >= NLAT) load16part<ns>(WSP(float, WS_PART), (m) - NLAT, lane, y); else load16bf(BY + (size_t)(m) * DM, lane, y); } while (0)
#define XBAR_WORDS ((unsigned*)((KP)__builtin_amdgcn_kernarg_segment_ptr())->ws)
#define XBAR_ST ((volatile LAS unsigned*)(lds + 131072 + 256))
#define GBAR() do { XcdBarrier xb_; xb_.bar = XBAR_WORDS; xb_.x = xb_xcc_id(); xb_.st = XBAR_ST; xcd_barrier(xb_, wave == 0 && lane_id() == 0); } while (0)
#define WSP(T, off) ((T*)(ws + (off)))
#define MOD WSP(float, WS_MOD)
#define BA WSP(bf16_t, WS_A)
#define BH WSP(bf16_t, WS_B)
#define BZ WSP(bf16_t, WS_Z)
#define BQ WSP(bf16_t, WS_Q)
#define BKV WSP(bf16_t, WS_KV)
#define BQN WSP(bf16_t, WS_QN)
#define BKVN WSP(bf16_t, WS_KVN)
#define BKR WSP(bf16_t, WS_KR)
#define BY WSP(bf16_t, WS_D)
#define XSC WSP(float, WS_XSC)
#define XS_ROW(m) ((m) < NLAT ? pp->out + (size_t)(m) * DM : XSC + (size_t)((m) - NLAT) * DM)
#define MOD_ROW(l, m) (MOD + ((l) * 5 + ((m) < NLAT ? (m) / SEQL : 4)) * 6144)

    for (int rp0_ = 0; rp0_ < PROBE_P0_REPS; ++rp0_) {
        PHASE_IDS();
        if (blk == 0) for (int i = tid; i < XCD_BAR_WORDS; i += 512) ((unsigned*)ws)[i] = 0u;
        if (tid < 2) ((LAS unsigned*)(lds + 131072 + 256))[tid] = 0u;
        LAS float* sil = (LAS float*)lds;
        LAS float* part = sil + 5 * 1024;
        for (int it = blk; it < 192; it += G) {
            const int l = it / 96, j0 = (it % 96) * 64;
            for (int i = tid; i < 5 * 1024; i += 512) { const int r = i >> 10, k = i & 1023; const float cv = r < 4 ? PIN(I_C)[r * 1024 + k] : PIN(I_CCTX)[k]; sil[i] = cv * sigmoidf_(cv); }
            __syncthreads();
            const int kg = tid >> 6, jc = tid & 63; const float* wm = PIN(I_WMOD) + (size_t)l * 1024 * 6144 + j0 + jc;
            float a0 = 0.f, a1 = 0.f, a2 = 0.f, a3 = 0.f, a4 = 0.f;
#pragma unroll 8
            for (int k = kg; k < 1024; k += 8) { const float w = wm[(size_t)k * 6144]; a0 += sil[k] * w; a1 += sil[1024 + k] * w; a2 += sil[2048 + k] * w; a3 += sil[3072 + k] * w; a4 += sil[4096 + k] * w; }
            part[(kg * 5 + 0) * 64 + jc] = a0; part[(kg * 5 + 1) * 64 + jc] = a1; part[(kg * 5 + 2) * 64 + jc] = a2; part[(kg * 5 + 3) * 64 + jc] = a3; part[(kg * 5 + 4) * 64 + jc] = a4;
            __syncthreads();
            if (tid < 320) { const int r = tid >> 6; float s = 0.f;
#pragma unroll
                for (int q = 0; q < 8; ++q) s += part[(q * 5 + r) * 64 + jc];
                MOD[(l * 5 + r) * 6144 + j0 + jc] = s + PIN(I_BMOD)[l * 6144 + j0 + jc]; }
            __syncthreads();
        }
        LAS float* scr = (LAS float*)(lds + 32768 + wave * 8704);
        constexpr int T_IN = 16 * 53, T_Q = 4 * 24, T_KV = 2 * 32, T_O = 16 * 32, T_UP = 16 * 128, T_DN = 64 * 32, T_L = T_IN + T_Q + T_KV + T_O + T_UP + T_DN;
        for (int it = gw; it < 2 * T_L; it += NGW) {
            const int l = it / T_L; int r = it % T_L; bf16_t* wl = (bf16_t*)(ws + WS_W + (size_t)l * W_LAYER);
            if (r < T_IN) { transpose_item(PIN(I_WIN) + (size_t)l * 1024 * INW, 1024, INW, (bf16_t*)((unsigned char*)wl + W_IN), scr, r, lane); continue; } r -= T_IN;
            if (r < T_Q) { transpose_item(PIN(I_WQB) + (size_t)l * 256 * 768, 256, 768, (bf16_t*)((unsigned char*)wl + W_Q), scr, r, lane); continue; } r -= T_Q;
            if (r < T_KV) { transpose_item(PIN(I_WKVB) + (size_t)l * 128 * 1024, 128, 1024, (bf16_t*)((unsigned char*)wl + W_KV), scr, r, lane); continue; } r -= T_KV;
            if (r < T_O) { transpose_item(PIN(I_WO) + (size_t)l * 1024 * 1024, 1024, 1024, (bf16_t*)((unsigned char*)wl + W_O), scr, r, lane); continue; } r -= T_O;
            if (r < T_UP) { transpose_item(PIN(I_WUP) + (size_t)l * 1024 * DFF, 1024, DFF, (bf16_t*)((unsigned char*)wl + W_UP), scr, r, lane); continue; } r -= T_UP;
            transpose_item(PIN(I_WDN) + (size_t)l * DFF * 1024, DFF, 1024, (bf16_t*)((unsigned char*)wl + W_DN), scr, r, lane);
        }
        for (int i = blk * 512 + tid; i < 2 * 96 * 128; i += G * 512) { const int l = i / (96 * 128), q = i % (96 * 128);
            ((u32x4*)(ws + WS_W + (size_t)l * W_LAYER + W_IN + (size_t)INW * 2048))[q] = (u32x4){0u, 0u, 0u, 0u}; }
    }
    cg::this_grid().sync();
    (void)xcd_barrier_post(XBAR_WORDS, XBAR_ST, wave == 0 && lane_id() == 0);
    { PHASE_IDS();
#define P1_SRC(m) ((m) < NLAT ? PIN(I_X) + (size_t)(m) * DM : PIN(I_CTX) + (size_t)((m) - NLAT) * DM)
#define P1_ROW(m, v) do { const float* mod = MOD_ROW(0, m); const float rinv = rsqrtf(ssq16(v) * (1.f / DM) + EPSN); prenorm_store(v, rinv, PIN(I_GPREMIX), mod, mod + 1024, BA + (size_t)(m) * DM, lane); } while (0)
    if (NGW == 2048) {
    for (int m0 = gw; m0 < MTOT; m0 += 4 * NGW) { f32x4 vb[4][4]; const float* mod = MOD_ROW(0, m0);
#pragma unroll
        for (int i = 0; i < 4; ++i) { const int mi = m0 + i * NGW; load16(P1_SRC(mi < MTOT ? mi : m0), lane, vb[i]); }
        f32x4 gv[4], sh[4], sc[4];
#pragma unroll
        for (int j = 0; j < 4; ++j) { gv[j] = ((const f32x4*)PIN(I_GPREMIX))[lane + 64 * j]; sh[j] = ((const f32x4*)mod)[lane + 64 * j]; sc[j] = ((const f32x4*)(mod + 1024))[lane + 64 * j] + 1.0f; }
#pragma unroll
        for (int i = 0; i < 4; ++i) { const int mi = m0 + i * NGW; if (mi < MTOT) { const float rinv = rsqrtf(ssq16(vb[i]) * (1.f / DM) + EPSN); bf16_t* orow = BA + (size_t)mi * DM;
#pragma unroll
            for (int j = 0; j < 4; ++j) { const f32x4 h = (vb[i][j] * rinv * gv[j]) * sc[j] + sh[j]; u32x2 w; w.x = cvtpk(h.x, h.y); w.y = cvtpk(h.z, h.w); ((u32x2*)orow)[lane + 64 * j] = w; } } } }
    } else
    for (int m0 = gw; m0 < MTOT; m0 += 4 * NGW) { f32x4 vb[4][4];
#pragma unroll
        for (int i = 0; i < 4; ++i) { const int mi = m0 + i * NGW; load16(P1_SRC(mi < MTOT ? mi : m0), lane, vb[i]); }
#pragma unroll
        for (int i = 0; i < 4; ++i) { const int mi = m0 + i * NGW; if (mi < MTOT) P1_ROW(mi, vb[i]); } } }
    GBAR();

    for (int l = 0; l < 2; ++l) {
        const bool last = (l == 1);
#define WL (ws + WS_W + (size_t)l * W_LAYER)
        const int Mact = last ? NLAT : MTOT;
        for (int rep_ = 0; rep_ < PROBE_GEMM_REPS; ++rep_) { PHASE_IDS(); pg8::Gemm g{BA, (const bf16_t*)(WL + W_IN), MTOT, ZW, 1024, 1024}; pg8::StaticOrder S; S.init(MTOT, ZW, G, blk); pg8::EpiBf16<0> E{BZ, ZW};
          pg8::gemm_phase<pg8::EpiBf16<0>, pg8::StaticOrder, true, true>(lds, g, S, E, wave); }
        GBAR();
        for (int rr1_ = 0; rr1_ < PROBE_R1_REPS; ++rr1_) {
            PHASE_IDS();
            const float* gq = PIN(I_GQ) + l * 256; const float* gkv = PIN(I_GKV) + l * 128; const float* gbr = PIN(I_GBR) + l * 1024;
            const float* cw = PIN(I_CDWW) + l * 31 * 256; const float* cb = PIN(I_CDWB) + l * 256; const float* lng = PIN(I_CLNG) + l * 256; const float* lnb = PIN(I_CLNB) + l * 256;
            const float* sw = PIN(I_SDWW) + l * 3 * 256;
            LAS float* U = (LAS float*)lds;
            LAS float* WL_ = (LAS float*)(lds + 96256);
            for (int i = tid; i < 31 * 64; i += 512) *(LAS f32x4*)(WL_ + 4 * i) = ((const f32x4*)cw)[i];
            __syncthreads();
            const int lane_o = lane, tid_o = tid;
            for (int ti = blk; ti < 544; ti += G) {
                int tid = tid_o; asm volatile("" : "+v"(tid)); const int lane = tid & 63;
                int seq_base, seq_len, t0; bool is_lat;
                if (ti < 512) { seq_base = (ti >> 7) * SEQL; seq_len = SEQL; t0 = (ti & 127) * 64; is_lat = true; }
                else { const int tc = ti - 512; seq_base = NLAT + (tc >> 3) * CTXL; seq_len = CTXL; t0 = (tc & 7) * 32; is_lat = false; }
                const int TT = is_lat ? 64 : 32; const bool dead = last && !is_lat;
                const int urows = dead ? 0 : (TT + 30) * 32; const bool wact = wave * 8 < TT;
                if (!dead) { u32x4 ua[6], ug[6];
#pragma unroll
                  for (int i = 0; i < 6; ++i) { const int it = tid + 512 * i, rr = it >> 5, c8 = it & 31, t = t0 - 15 + rr; const bool ok = it < urows && t >= 0 && t < seq_len;
                      const bf16_t* zr = BZ + (size_t)(seq_base + (ok ? t : t0)) * ZW; ua[i] = *(const u32x4*)(zr + 416 + 8 * c8); ug[i] = *(const u32x4*)(zr + 672 + 8 * c8); if (!ok) ua[i] = (u32x4){0u, 0u, 0u, 0u}; }
#pragma unroll
                  for (int i = 0; i < 6; ++i) { const int it = tid + 512 * i, rr = it >> 5, c8 = it & 31; const u32x4 a = ua[i], gg = ug[i];
                      if (it < urows) {
                        const f32x4 u0 = {bflo(a.x) * sigmoidf_(bflo(gg.x)), bfhi(a.x) * sigmoidf_(bfhi(gg.x)), bflo(a.y) * sigmoidf_(bflo(gg.y)), bfhi(a.y) * sigmoidf_(bfhi(gg.y))};
                        const f32x4 u1 = {bflo(a.z) * sigmoidf_(bflo(gg.z)), bfhi(a.z) * sigmoidf_(bfhi(gg.z)), bflo(a.w) * sigmoidf_(bflo(gg.w)), bfhi(a.w) * sigmoidf_(bfhi(gg.w))};
                        *(LAS f32x4*)(U + rr * 256 + 8 * c8) = u0; *(LAS f32x4*)(U + rr * 256 + 8 * c8 + 4) = u1; } } }
                if (wact) { const int tw = t0 + wave * 8; const size_t mw = (size_t)seq_base + tw; const bf16_t* zw = BZ + mw * ZW;
                  u32x2 zq[8], bgt[8], cgt[10], hht[10]; unsigned kvv[8]; unsigned short krv[8];
#pragma unroll
                  for (int k8 = 0; k8 < 8; ++k8) { const bf16_t* zr = zw + (size_t)k8 * ZW; zq[k8] = *(const u32x2*)(zr + 4 * lane); kvv[k8] = *(const unsigned*)(zr + 256 + 2 * lane); krv[k8] = zr[384 + (lane & 31)];
                      bgt[k8] = *(const u32x2*)(zr + 928 + 4 * lane); }
#pragma unroll
                  for (int j = 0; j < 10; ++j) { const int tt = tw - 1 + j; const bool ok = tt >= 0 && tt < seq_len; const bf16_t* z2 = BZ + (size_t)(seq_base + (ok ? tt : tw)) * ZW;
                      cgt[j] = *(const u32x2*)(z2 + 1184 + 4 * lane); hht[j] = *(const u32x2*)(z2 + 1440 + 4 * lane); if (!ok) { cgt[j] = (u32x2){0u, 0u}; } }
                  const f32x4 gqv = ((const f32x4*)gq)[lane]; const float gk0 = gkv[2 * lane], gk1 = gkv[2 * lane + 1]; const f32x4 gsc = ((const f32x4*)(gbr + 768))[lane];
                  const f32x4 sw0 = ((const f32x4*)sw)[lane], sw1 = ((const f32x4*)(sw + 256))[lane], sw2 = ((const f32x4*)(sw + 512))[lane];
                  f32x4 pr[10];
#pragma unroll
                  for (int j = 0; j < 10; ++j) pr[j] = (f32x4){bflo(cgt[j].x) * bflo(hht[j].x), bfhi(cgt[j].x) * bfhi(hht[j].x), bflo(cgt[j].y) * bflo(hht[j].y), bfhi(cgt[j].y) * bfhi(hht[j].y)};
#pragma unroll
                  for (int k8 = 0; k8 < 8; ++k8) { const int t = tw + k8; const size_t m = mw + k8;
                    { const u32x2 w = zq[k8]; const f32x4 v = {bflo(w.x), bfhi(w.x), bflo(w.y), bfhi(w.y)};
                      const float ri = rsqrtf(wave_sum((v.x * v.x + v.y * v.y) + (v.z * v.z + v.w * v.w)) * (1.f / 256.f) + EPSN); const f32x4 o = v * ri * gqv;
                      u32x2 ow; ow.x = cvtpk(o.x, o.y); ow.y = cvtpk(o.z, o.w); *(u32x2*)(BQN + m * 256 + 4 * lane) = ow; }
                    { const unsigned w = kvv[k8]; const float v0 = bflo(w), v1 = bfhi(w);
                      const float ri = rsqrtf(wave_sum(v0 * v0 + v1 * v1) * (1.f / 128.f) + EPSN); *(unsigned*)(BKVN + m * 128 + 2 * lane) = cvtpk(v0 * ri * gk0, v1 * ri * gk1); }
                    { const int e = lane & 31; const float v = bf2f(krv[k8]); const float prn = swz_xor<8>(v); float o = v;
                      if (is_lat) { const int a = e >> 4, i = e & 15; const float pos = (float)(a == 0 ? (t >> 6) : (t & 63)); const float ang = pos * rope_inv(i & 7), c = __cosf(ang), s = __sinf(ang);
                          o = (i < 8) ? (v * c - prn * s) : (v * c + prn * s); }
                      if (lane < 32) BKR[m * 32 + e] = f2bf(o); }
                    { const f32x4 acc = pr[k8] * sw0 + pr[k8 + 1] * sw1 + pr[k8 + 2] * sw2; const u32x2 bg = bgt[k8];
                      const f32x4 s = {bflo(bg.x) * acc.x, bfhi(bg.x) * acc.y, bflo(bg.y) * acc.z, bfhi(bg.y) * acc.w};
                      const float ri = rsqrtf(wave_sum((s.x * s.x + s.y * s.y) + (s.z * s.z + s.w * s.w)) * (1.f / 256.f) + EPSN); const f32x4 o = s * ri * gsc;
                      u32x2 ow; ow.x = cvtpk(o.x, o.y); ow.y = cvtpk(o.z, o.w); *(u32x2*)(BA + m * DM + 768 + 4 * lane) = ow; }
                  }
                }
                __syncthreads();
                if (wact && !dead) { int lane = lane_o; asm volatile("" : "+v"(lane)); f32x4 wv[31];
#pragma unroll
                  for (int j = 0; j < 31; ++j) wv[j] = *(const LAS f32x4*)(WL_ + j * 256 + 4 * lane);
                  const f32x4 bias = ((const f32x4*)cb)[lane]; f32x4 acc[8];
#pragma unroll
                  for (int k = 0; k < 8; ++k) acc[k] = bias;
                  const LAS float* Ub = U + (wave * 8) * 256 + 4 * lane;
#pragma unroll
                  for (int i = 0; i < 38; ++i) { const f32x4 u = *(const LAS f32x4*)(Ub + i * 256);
#pragma unroll
                      for (int k = 0; k < 8; ++k) { const int j = i - k; if (j >= 0 && j < 31) acc[k] += u * wv[j]; } }
                  const f32x4 lg = ((const f32x4*)lng)[lane], lb = ((const f32x4*)lnb)[lane], gb = ((const f32x4*)(gbr + 512))[lane];
#pragma unroll
                  for (int k = 0; k < 8; ++k) { const f32x4 a = acc[k]; const float mean = wave_sum((a.x + a.y) + (a.z + a.w)) * (1.f / 256.f); const f32x4 d = a - mean;
                      const float rstd = rsqrtf(wave_sum((d.x * d.x + d.y * d.y) + (d.z * d.z + d.w * d.w)) * (1.f / 256.f) + EPSN); f32x4 y = d * rstd * lg + lb;
                      y = (f32x4){y.x * sigmoidf_(y.x), y.y * sigmoidf_(y.y), y.z * sigmoidf_(y.z), y.w * sigmoidf_(y.w)};
                      const float ri = rsqrtf(wave_sum((y.x * y.x + y.y * y.y) + (y.z * y.z + y.w * y.w)) * (1.f / 256.f) + EPSN); const f32x4 o = y * ri * gb;
                      u32x2 ow; ow.x = cvtpk(o.x, o.y); ow.y = cvtpk(o.z, o.w); *(u32x2*)(BA + ((size_t)seq_base + t0 + wave * 8 + k) * DM + 512 + 4 * lane) = ow; } }
                __syncthreads();
            }
        }
        GBAR();
        for (int rep_ = 0; rep_ < PROBE_GEMM_REPS; ++rep_) { PHASE_IDS(); pg8::Gemm g{BQN, (const bf16_t*)(WL + W_Q), MTOT, 768, 256, 256}; pg8::StaticOrder S; S.init(MTOT, 768, G, blk); pg8::EpiBf16<0> E{BQ, 768};
          pg8::gemm_phase<pg8::EpiBf16<0>, pg8::StaticOrder, true, true>(lds, g, S, E, wave); }
        for (int rep_ = 0; rep_ < PROBE_GEMM_REPS; ++rep_) { PHASE_IDS(); pg8::Gemm g{BKVN, (const bf16_t*)(WL + W_KV), MTOT, 1024, 128, 128}; pg8::StaticOrder S; S.init(MTOT, 1024, G, blk); pg8::EpiBf16<0> E{BKV, 1024};
          pg8::gemm_phase<pg8::EpiBf16<0>, pg8::StaticOrder, true, true>(lds, g, S, E, wave); }
        GBAR();
        {
            PHASE_IDS();
            const int nunits = last ? 1024 : 1056;
            for (int rep_ = 0; rep_ < PROBE_ATT_REPS; ++rep_)
            for (int u = blk; u < nunits; u += G) {
                if (u < 1024) { const int bh = (u & 7) + 8 * (u >> 8), qb = (u >> 3) & 31, b = bh >> 3, h = bh & 7; const int q0 = b * SEQL + qb * 256;
                    att::attn_unit(BQ + (size_t)q0 * 768 + h * 96, true, qb * 256, BKV + h * 128, BKR, NLAT + b * CTXL, b * SEQL, 132, BA + (size_t)q0 * DM + h * 64, lds, wave); }
                else { const int uc = u - 1024, b = uc >> 3, h = uc & 7; const int q0 = NLAT + b * CTXL;
                    att::attn_unit(BQ + (size_t)q0 * 768 + h * 96, false, 0, BKV + h * 128, BKR, q0, 0, 4, BA + (size_t)q0 * DM + h * 64, lds, wave); }
            }
        }
        GBAR();
        { PHASE_IDS(); const float* gbr = PIN(I_GBR) + l * 1024; const f32x4 g0 = ((const f32x4*)gbr)[2 * lane], g1 = ((const f32x4*)gbr)[2 * lane + 1];
          for (int m0 = gw; m0 < Mact; m0 += 8 * NGW) { u32x4 w[8];
#pragma unroll
              for (int i = 0; i < 8; ++i) { const int m = m0 + i * NGW; w[i] = ((const u32x4*)(BA + (size_t)(m < Mact ? m : m0) * DM))[lane]; }
#pragma unroll
              for (int i = 0; i < 8; ++i) { const int m = m0 + i * NGW; if (m < Mact) {
                  const float v[8] = {bflo(w[i].x), bfhi(w[i].x), bflo(w[i].y), bfhi(w[i].y), bflo(w[i].z), bfhi(w[i].z), bflo(w[i].w), bfhi(w[i].w)}; float s = 0.f;
#pragma unroll
                  for (int q = 0; q < 8; ++q) s += v[q] * v[q];
                  const float ri = rsqrtf(wave_sum(s) * (1.f / 512.f) + EPSN);
                  u32x4 o; o.x = cvtpk(v[0] * ri * g0.x, v[1] * ri * g0.y); o.y = cvtpk(v[2] * ri * g0.z, v[3] * ri * g0.w); o.z = cvtpk(v[4] * ri * g1.x, v[5] * ri * g1.y); o.w = cvtpk(v[6] * ri * g1.z, v[7] * ri * g1.w);
                  ((u32x4*)(BA + (size_t)m * DM))[lane] = o; } } } }
        GBAR();
        { PHASE_IDS(); pg8::Gemm g{BA, (const bf16_t*)(WL + W_O), NLAT, 1024, 1024, 1024}; pg8::StaticOrder S; S.init(NLAT, 1024, G, blk); pg8::EpiBf16<0> E{BY, 1024};
          pg8::gemm_phase<pg8::EpiBf16<0>, pg8::StaticOrder, true, true>(lds, g, S, E, wave); }
        if (!last) { PHASE_IDS(); pg8::Gemm g{BA, (const bf16_t*)(WL + W_O), MTOT, 1024, 256, 1024}; pg8::SplitOrder S; S.init(4, 4, 4, 128, G, blk); pg8::EpiF32Part E{WSP(float, WS_PART), 1024, 128, (size_t)1024 * 1024};
          pg8::gemm_phase<pg8::EpiF32Part, pg8::SplitOrder, true, true>(lds, g, S, E, wave); }
        GBAR();
        { PHASE_IDS(); const float* gp = PIN(I_GPOSTMIX) + l * DM; const float* gm = PIN(I_GPREMLP) + l * DM;
#define R3_SRC(m) ((l == 0) ? ((m) < NLAT ? PIN(I_X) + (size_t)(m) * DM : PIN(I_CTX) + (size_t)((m) - NLAT) * DM) : (const float*)XS_ROW(m))
#define R3_ROW(m, y, x) do { const float* mod = MOD_ROW(l, m); float* dst = XS_ROW(m); const float ry = rsqrtf(ssq16(y) * (1.f / DM) + EPSN); \
            _Pragma("unroll") for (int j = 0; j < 4; ++j) { const int q = lane + 64 * j; x[j] = x[j] + ((const f32x4*)(mod + 2048))[q] * (y[j] * ry * ((const f32x4*)gp)[q]); __builtin_nontemporal_store(x[j], (f32x4*)dst + q); } \
            const float r1 = rsqrtf(ssq16(x) * (1.f / DM) + EPSN); prenorm_store(x, r1, gm, mod + 3072, mod + 4096, BA + (size_t)(m) * DM, lane); } while (0)
        if (NGW == 2048) {
        for (int m0 = gw; m0 < Mact; m0 += 4 * NGW) { f32x4 yb[4][4], xb[4][4]; const float* mod = MOD_ROW(l, m0);
#pragma unroll
            for (int i = 0; i < 4; ++i) { const int mi = m0 + i * NGW, mc = mi < Mact ? mi : m0; LOADY(mc, yb[i], 4); load16(R3_SRC(mc), lane, xb[i]); }
            float r1[4];
            { f32x4 gt[4], gv[4];
#pragma unroll
              for (int j = 0; j < 4; ++j) { gt[j] = ((const f32x4*)(mod + 2048))[lane + 64 * j]; gv[j] = ((const f32x4*)gp)[lane + 64 * j]; }
#pragma unroll
              for (int i = 0; i < 4; ++i) { const int mi = m0 + i * NGW; r1[i] = 0.f; if (mi < Mact) { float* dst = XS_ROW(mi); const float ry = rsqrtf(ssq16(yb[i]) * (1.f / DM) + EPSN);
#pragma unroll
                  for (int j = 0; j < 4; ++j) { xb[i][j] = xb[i][j] + gt[j] * (yb[i][j] * ry * gv[j]); __builtin_nontemporal_store(xb[i][j], (f32x4*)dst + lane + 64 * j); }
                  r1[i] = rsqrtf(ssq16(xb[i]) * (1.f / DM) + EPSN); } } }
            { f32x4 gv[4], sh[4], sc[4];
#pragma unroll
              for (int j = 0; j < 4; ++j) { gv[j] = ((const f32x4*)gm)[lane + 64 * j]; sh[j] = ((const f32x4*)(mod + 3072))[lane + 64 * j]; sc[j] = ((const f32x4*)(mod + 4096))[lane + 64 * j] + 1.0f; }
#pragma unroll
              for (int i = 0; i < 4; ++i) { const int mi = m0 + i * NGW; if (mi < Mact) { bf16_t* orow = BA + (size_t)mi * DM;
#pragma unroll
                  for (int j = 0; j < 4; ++j) { const f32x4 h = (xb[i][j] * r1[i] * gv[j]) * sc[j] + sh[j]; u32x2 w; w.x = cvtpk(h.x, h.y); w.y = cvtpk(h.z, h.w); ((u32x2*)orow)[lane + 64 * j] = w; } } } } }
        } else
        for (int m0 = gw; m0 < Mact; m0 += 4 * NGW) { f32x4 yb[4][4], xb[4][4];
#pragma unroll
            for (int i = 0; i < 4; ++i) { const int mi = m0 + i * NGW, mc = mi < Mact ? mi : m0; LOADY(mc, yb[i], 4); load16(R3_SRC(mc), lane, xb[i]); }
#pragma unroll
            for (int i = 0; i < 4; ++i) { const int mi = m0 + i * NGW; if (mi < Mact) R3_ROW(mi, yb[i], xb[i]); } } }
        GBAR();
        for (int rep_ = 0; rep_ < PROBE_GEMM_REPS; ++rep_) { PHASE_IDS(); pg8::Gemm g{BA, (const bf16_t*)(WL + W_UP), Mact, DFF, 1024, 1024}; pg8::StaticOrder S; S.init(Mact, DFF, G, blk); pg8::EpiBf16<2> E{BH, DFF};
          pg8::gemm_phase<pg8::EpiBf16<2>, pg8::StaticOrder, true, true>(lds, g, S, E, wave); }
        GBAR();
        { PHASE_IDS(); pg8::Gemm g{BH, (const bf16_t*)(WL + W_DN), NLAT, 1024, DFF, DFF}; pg8::StaticOrder S; S.init(NLAT, 1024, G, blk); S.rev = true; pg8::EpiBf16<0> E{BY, 1024};
          pg8::gemm_phase<pg8::EpiBf16<0>, pg8::StaticOrder, true, true>(lds, g, S, E, wave); }
        if (!last) { PHASE_IDS(); pg8::Gemm g{BH, (const bf16_t*)(WL + W_DN), MTOT, 1024, 256, DFF}; pg8::SplitOrder S; S.init(4, 4, 16, 128, G, blk); pg8::EpiF32Part E{WSP(float, WS_PART), 1024, 128, (size_t)1024 * 1024};
          pg8::gemm_phase<pg8::EpiF32Part, pg8::SplitOrder, true, true>(lds, g, S, E, wave); }
        GBAR();
        { PHASE_IDS(); const float* gp = PIN(I_GPOSTMLP) + l * DM; const float* gn = PIN(I_GPREMIX) + (last ? 0 : (l + 1) * DM);
#define R4_ROW(m, y, x) do { const float* mod = MOD_ROW(l, m); float* xr = XS_ROW(m); const float ry = rsqrtf(ssq16(y) * (1.f / DM) + EPSN); \
            _Pragma("unroll") for (int j = 0; j < 4; ++j) { const int q = lane + 64 * j; x[j] = x[j] + ((const f32x4*)(mod + 5120))[q] * (y[j] * ry * ((const f32x4*)gp)[q]); __builtin_nontemporal_store(x[j], (f32x4*)xr + q); } \
            if (!last) { const float* mod1 = MOD_ROW(l + 1, m); const float r1 = rsqrtf(ssq16(x) * (1.f / DM) + EPSN); prenorm_store(x, r1, gn, mod1, mod1 + 1024, BA + (size_t)(m) * DM, lane); } } while (0)
        if (NGW == 2048) {
        for (int m0 = gw; m0 < Mact; m0 += 4 * NGW) { f32x4 yb[4][4], xb[4][4]; const float* mod = MOD_ROW(l, m0);
#pragma unroll
            for (int i = 0; i < 4; ++i) { const int mi = m0 + i * NGW, mc = mi < Mact ? mi : m0; LOADY(mc, yb[i], 16); load16(XS_ROW(mc), lane, xb[i]); }
            float r1[4];
            { f32x4 gt[4], gv[4];
#pragma unroll
              for (int j = 0; j < 4; ++j) { gt[j] = ((const f32x4*)(mod + 5120))[lane + 64 * j]; gv[j] = ((const f32x4*)gp)[lane + 64 * j]; }
#pragma unroll
              for (int i = 0; i < 4; ++i) { const int mi = m0 + i * NGW; r1[i] = 0.f; if (mi < Mact) { float* xr = XS_ROW(mi); const float ry = rsqrtf(ssq16(yb[i]) * (1.f / DM) + EPSN);
#pragma unroll
                  for (int j = 0; j < 4; ++j) { xb[i][j] = xb[i][j] + gt[j] * (yb[i][j] * ry * gv[j]); __builtin_nontemporal_store(xb[i][j], (f32x4*)xr + lane + 64 * j); }
                  if (!last) r1[i] = rsqrtf(ssq16(xb[i]) * (1.f / DM) + EPSN); } } }
            if (!last) { const float* mod1 = MOD_ROW(l + 1, m0); f32x4 gv[4], sh[4], sc[4];
#pragma unroll
              for (int j = 0; j < 4; ++j) { gv[j] = ((const f32x4*)gn)[lane + 64 * j]; sh[j] = ((const f32x4*)mod1)[lane + 64 * j]; sc[j] = ((const f32x4*)(mod1 + 1024))[lane + 64 * j] + 1.0f; }
#pragma unroll
              for (int i = 0; i < 4; ++i) { const int mi = m0 + i * NGW; if (mi < Mact) { bf16_t* orow = BA + (size_t)mi * DM;
#pragma unroll
                  for (int j = 0; j < 4; ++j) { const f32x4 h = (xb[i][j] * r1[i] * gv[j]) * sc[j] + sh[j]; u32x2 w; w.x = cvtpk(h.x, h.y); w.y = cvtpk(h.z, h.w); ((u32x2*)orow)[lane + 64 * j] = w; } } } } }
        } else
        for (int m0 = gw; m0 < Mact; m0 += 4 * NGW) { f32x4 yb[4][4], xb[4][4];
#pragma unroll
            for (int i = 0; i < 4; ++i) { const int mi = m0 + i * NGW, mc = mi < Mact ? mi : m0; LOADY(mc, yb[i], 16); load16(XS_ROW(mc), lane, xb[i]); }
#pragma unroll
            for (int i = 0; i < 4; ++i) { const int mi = m0 + i * NGW; if (mi < Mact) R4_ROW(mi, yb[i], xb[i]); } } }
        if (!last) GBAR();
    }
}

extern "C" void kernel_launch(void* const* d_in, const int* in_sizes, int n_in, void* d_out, int out_size, void* d_ws, size_t ws_size, hipStream_t stream) {
    static int grid_blocks = 0;
    if (grid_blocks == 0) {
        if (n_in != 24 || out_size != NLAT * DM || ws_size < WS_END) { fprintf(stderr, "kernel_launch: unexpected shapes n_in %d out %d ws %zu\n", n_in, out_size, ws_size); grid_blocks = -1; return; }
        int dev = 0, cus = 0, per_cu = 0;
        hipGetDevice(&dev); hipDeviceGetAttribute(&cus, hipDeviceAttributeMultiprocessorCount, dev);
        if (hipFuncSetAttribute((const void*)fwd_megakernel, hipFuncAttributeMaxDynamicSharedMemorySize, LDS_BYTES) != hipSuccess) { fprintf(stderr, "kernel_launch: hipFuncSetAttribute failed\n"); grid_blocks = -1; return; }
        if (hipOccupancyMaxActiveBlocksPerMultiprocessor(&per_cu, (const void*)fwd_megakernel, 512, LDS_BYTES) != hipSuccess || per_cu < 1) { fprintf(stderr, "kernel_launch: occupancy query says %d\n", per_cu); per_cu = 1; (void)hipGetLastError(); }
        grid_blocks = cus * per_cu;
    }
    if (grid_blocks < 0) return;
    Params p{};
    for (int i = 0; i < 24; ++i) p.in[i] = (const float*)d_in[i];
    p.out = (float*)d_out; p.ws = (unsigned char*)d_ws;
    void* args[] = {&p};
    hipError_t e = hipLaunchCooperativeKernel((const void*)fwd_megakernel, dim3(grid_blocks), dim3(512), args, LDS_BYTES, stream);
    if (e != hipSuccess) fprintf(stderr, "cooperative launch failed: %s (grid %d)\n", hipGetErrorString(e), grid_blocks);
}
```
